# Optimizing an MI355X kernel written in HIP

```python
import math
import jax, jax.numpy as jnp
from jax import lax
import numpy as np

D_MODEL = 1024
BATCH = 8
SEQ = 4096
DEPTH = 2

CHUNK = 64
HEAD_DIM = 64
HEAD_UNIT = D_MODEL // (4 * HEAD_DIM)
SB_HEADS = HEAD_UNIT
DIFF_HEADS = HEAD_UNIT
CA_HEADS = HEAD_UNIT
SB_WIDTH = SB_HEADS * HEAD_DIM
DIFF_WIDTH = DIFF_HEADS * 2 * HEAD_DIM
CA_WIDTH = CA_HEADS * HEAD_DIM
MIX_WIDTH = SB_WIDTH + DIFF_WIDTH + CA_WIDTH
QKV_WIDTH = 3 * MIX_WIDTH
Q_BLOCK = 128
CA_LEFT_CHUNKS = 8
CA_BAND = (CA_LEFT_CHUNKS + 1) * CHUNK
CA_REL_CLIP = 128
T5_BUCKETS = 32
T5_MAX_DIST = 256
N_GROUPS = 4
EXPERTS_PER_GROUP = 8
N_EXPERTS = N_GROUPS * EXPERTS_PER_GROUP
TOP_K_INNER = 2
D_EXPERT = 512
MOE_BLOCK = 128
EPS = 1e-6

kernel_name = "hybrid_sb_diff_chunk_hmoe"


def rmsnorm(x, gain):
    x32 = x.astype(jnp.float32)
    y = x32 * lax.rsqrt(jnp.mean(x32 * x32, axis=-1, keepdims=True) + EPS)
    return (y * gain.astype(jnp.float32)).astype(x.dtype)


def split_heads(t, n_heads):
    b, s, _ = t.shape
    return t.reshape(b, s, n_heads, -1).transpose(0, 2, 1, 3)


def merge_heads(t):
    b, n, s, d = t.shape
    return t.transpose(0, 2, 1, 3).reshape(b, s, n * d)


def to_query_blocks(q):
    s, d = q.shape[-2], q.shape[-1]
    q = q.reshape(q.shape[:-2] + (s // Q_BLOCK, Q_BLOCK, d))
    return jnp.moveaxis(q, -3, 0)


def from_query_blocks(y):
    y = jnp.moveaxis(y, 0, -3)
    return y.reshape(y.shape[:-3] + (y.shape[-3] * y.shape[-2], y.shape[-1]))


def t5_bucket(rel):
    nb = T5_BUCKETS // 2
    max_exact = nb // 2
    ret = jnp.where(rel > 0, nb, 0)
    n = jnp.abs(rel)
    large = max_exact + (jnp.log(jnp.maximum(n, 1).astype(jnp.float32) / max_exact)
                         / math.log(T5_MAX_DIST / max_exact) * (nb - max_exact)).astype(jnp.int32)
    large = jnp.minimum(large, nb - 1)
    return ret + jnp.where(n < max_exact, n, large)


def stick_breaking_attention(q, k, v):
    s_len = q.shape[-2]
    scale = HEAD_DIM ** -0.5
    key_pos = jnp.arange(s_len)
    v32 = v.astype(jnp.float32)

    def block(args):
        qb, bi = args
        qpos = bi * Q_BLOCK + jnp.arange(Q_BLOCK)
        z = jnp.einsum('bhqd,bhkd->bhqk', qb, k, preferred_element_type=jnp.float32) * scale
        earlier = key_pos[None, :] < qpos[:, None]
        log_keep = jnp.where(earlier, jax.nn.log_sigmoid(-z), 0.0)
        between = lax.cumsum(log_keep, axis=3, reverse=True) - log_keep
        w = jnp.where(earlier, jnp.exp(jax.nn.log_sigmoid(z) + between), 0.0)
        return jnp.einsum('bhqk,bhkd->bhqd', w, v32)

    y = lax.map(block, (to_query_blocks(q), jnp.arange(s_len // Q_BLOCK)))
    return from_query_blocks(y)


def differential_attention(q, k, v, t5_bias, lam):
    s_len = q.shape[-2]
    scale = HEAD_DIM ** -0.5
    key_pos = jnp.arange(s_len)
    key_chunk = key_pos // CHUNK
    v32 = v.astype(jnp.float32)

    def block(args):
        qb, bi = args
        qpos = bi * Q_BLOCK + jnp.arange(Q_BLOCK)
        bias = t5_bias[t5_bucket(key_pos[None, :] - qpos[:, None])]
        bias = jnp.transpose(bias, (2, 0, 1)).astype(jnp.float32)
        allowed = key_chunk[None, :] <= (qpos // CHUNK)[:, None]
        logits = jnp.einsum('bhmqd,bhmkd->bhmqk', qb, k,
                            preferred_element_type=jnp.float32) * scale + bias[None, :, None]
        logits = jnp.where(allowed, logits, -jnp.inf)
        p = jax.nn.softmax(logits, axis=-1)
        w = p[:, :, 0] - lam * p[:, :, 1]
        return jnp.einsum('bhqk,bhkd->bhqd', w, v32)

    y = lax.map(block, (to_query_blocks(q), jnp.arange(s_len // Q_BLOCK)))
    return from_query_blocks(y)


def chunked_rel_attention(q, k, v, rel_bias):
    b, h, s_len, d = q.shape
    n_chunks = s_len // CHUNK
    scale = HEAD_DIM ** -0.5
    qc = q.reshape(b, h, n_chunks, CHUNK, d)
    pad = ((0, 0), (0, 0), (CA_LEFT_CHUNKS, 0), (0, 0), (0, 0))
    kp = jnp.pad(k.reshape(b, h, n_chunks, CHUNK, d), pad)
    vp = jnp.pad(v.reshape(b, h, n_chunks, CHUNK, d), pad)
    kb = jnp.concatenate([kp[:, :, j:j + n_chunks] for j in range(CA_LEFT_CHUNKS + 1)], axis=3)
    vb = jnp.concatenate([vp[:, :, j:j + n_chunks] for j in range(CA_LEFT_CHUNKS + 1)], axis=3)
    key_off = jnp.arange(CA_BAND) - CA_LEFT_CHUNKS * CHUNK
    rel = key_off[None, :] - jnp.arange(CHUNK)[:, None]
    bias = rel_bias[jnp.clip(rel, -CA_REL_CLIP, CA_REL_CLIP) + CA_REL_CLIP]
    bias = jnp.transpose(bias, (2, 0, 1)).astype(jnp.float32)
    band_chunk = jnp.arange(CA_BAND) // CHUNK
    valid = (jnp.arange(n_chunks)[:, None] - CA_LEFT_CHUNKS + band_chunk[None, :]) >= 0
    logits = jnp.einsum('bhnqd,bhnkd->bhnqk', qc, kb,
                        preferred_element_type=jnp.float32) * scale + bias[None, :, None]
    logits = jnp.where(valid[None, None, :, None, :], logits, -jnp.inf)
    p = jax.nn.softmax(logits, axis=-1)
    y = jnp.einsum('bhnqk,bhnkd->bhnqd', p, vb.astype(jnp.float32))
    return y.reshape(b, h, s_len, d)


def hybrid_mixer(a, w_in, w_out, t5_bias, diff_qk_norm, diff_lambda, diff_subln,
                 ca_qk_norm, ca_rel_bias, lam_init):
    b, s_len, _ = a.shape
    proj = a @ w_in
    sb, df, ca = jnp.split(proj, [3 * SB_WIDTH, 3 * SB_WIDTH + 3 * DIFF_WIDTH], axis=-1)

    qa, ka, va = [split_heads(t, SB_HEADS) for t in jnp.split(sb, 3, axis=-1)]
    ya = stick_breaking_attention(qa, ka, va)

    qd, kd, vd = jnp.split(df, 3, axis=-1)
    qd = rmsnorm(qd.reshape(b, s_len, DIFF_HEADS, 2, HEAD_DIM), diff_qk_norm[0]).transpose(0, 2, 3, 1, 4)
    kd = rmsnorm(kd.reshape(b, s_len, DIFF_HEADS, 2, HEAD_DIM), diff_qk_norm[1]).transpose(0, 2, 3, 1, 4)
    vd = split_heads(vd, DIFF_HEADS)
    lmb = diff_lambda.astype(jnp.float32)
    lam = jnp.exp(jnp.sum(lmb[0] * lmb[1])) - jnp.exp(jnp.sum(lmb[2] * lmb[3])) + lam_init
    yd = differential_attention(qd, kd, vd, t5_bias, lam)
    yd = rmsnorm(yd, diff_subln) * (1.0 - lam_init)

    qc, kc, vc = [split_heads(t, CA_HEADS) for t in jnp.split(ca, 3, axis=-1)]
    qc = rmsnorm(qc, ca_qk_norm[0])
    kc = rmsnorm(kc, ca_qk_norm[1])
    yc = chunked_rel_attention(qc, kc, vc, ca_rel_bias)

    merged = jnp.concatenate([merge_heads(ya), merge_heads(yd), merge_heads(yc)], axis=-1).astype(a.dtype)
    return merged @ w_out


def hierarchical_moe(f, wg_r, bg_r, we_r, be_r, w_gate, w_up, w_down):
    b, s_len, d = f.shape
    n_tok = b * s_len
    xt = f.reshape(n_tok, d)
    tok_idx = jnp.arange(n_tok)
    g_logits = (xt @ wg_r + bg_r).astype(jnp.float32)
    g_sel = jnp.argmax(g_logits, axis=-1)
    g_w = jax.nn.softmax(g_logits, axis=-1)[tok_idx, g_sel]
    e_logits = (xt @ we_r + be_r).astype(jnp.float32).reshape(n_tok, N_GROUPS, EXPERTS_PER_GROUP)
    e_prob = jax.nn.softmax(e_logits[tok_idx, g_sel], axis=-1)
    top_p, top_i = lax.top_k(e_prob, TOP_K_INNER)
    top_p = top_p / jnp.sum(top_p, axis=-1, keepdims=True)
    eid = (g_sel[:, None] * EXPERTS_PER_GROUP + top_i).reshape(-1)
    gate = (g_w[:, None] * top_p).reshape(-1)
    tok = jnp.repeat(tok_idx, TOP_K_INNER)
    n_asg = n_tok * TOP_K_INNER
    order = jnp.argsort(eid)
    eid_s, tok_s, gate_s = eid[order], tok[order], gate[order]
    counts = jnp.zeros((N_EXPERTS,), jnp.int32).at[eid].add(1)
    padded = (counts + MOE_BLOCK - 1) // MOE_BLOCK * MOE_BLOCK
    start = jnp.cumsum(counts) - counts
    pend = jnp.cumsum(padded)
    pstart = pend - padded
    dest = pstart[eid_s] + (jnp.arange(n_asg) - start[eid_s])
    n_rows = n_asg + N_EXPERTS * MOE_BLOCK
    n_blocks = n_rows // MOE_BLOCK
    row_tok = jnp.zeros((n_rows,), jnp.int32).at[dest].set(tok_s)
    row_gate = jnp.zeros((n_rows,), jnp.float32).at[dest].set(gate_s)
    blk_expert = jnp.minimum(jnp.searchsorted(pend, jnp.arange(n_blocks) * MOE_BLOCK, side='right'),
                             N_EXPERTS - 1)

    def expert_block(args):
        toks, gts, e = args
        xb = xt[toks]
        hid = jax.nn.silu(xb @ w_gate[e]) * (xb @ w_up[e])
        y = hid @ w_down[e]
        return y * gts[:, None].astype(y.dtype)

    y = lax.map(expert_block, (row_tok.reshape(n_blocks, MOE_BLOCK),
                               row_gate.reshape(n_blocks, MOE_BLOCK), blk_expert))
    y = y.reshape(n_rows, d)
    out = jnp.zeros((n_tok, d), y.dtype).at[row_tok].add(y)
    return out.reshape(b, s_len, d).astype(f.dtype)


def setup_inputs(seed: int = 0) -> dict:
    key = jax.random.key(seed)
    ks = jax.random.split(key, 20)
    f32 = jnp.float32

    def nrm(k, shape, scale):
        return jax.random.normal(k, shape, f32) * scale

    return {
        'x': nrm(ks[0], (BATCH, SEQ, D_MODEL), 1.0),
        't5_bias': nrm(ks[1], (T5_BUCKETS, DIFF_HEADS), 0.1),
        'attn_norm': 1.0 + nrm(ks[2], (DEPTH, D_MODEL), 0.02),
        'w_in': nrm(ks[3], (DEPTH, D_MODEL, QKV_WIDTH), D_MODEL ** -0.5),
        'diff_qk_norm': 1.0 + nrm(ks[4], (DEPTH, 2, HEAD_DIM), 0.02),
        'diff_lambda': nrm(ks[5], (DEPTH, 4, HEAD_DIM), 0.1),
        'diff_subln': 1.0 + nrm(ks[6], (DEPTH, 2 * HEAD_DIM), 0.02),
        'ca_qk_norm': 1.0 + nrm(ks[7], (DEPTH, 2, HEAD_DIM), 0.02),
        'ca_rel_bias': nrm(ks[8], (DEPTH, 2 * CA_REL_CLIP + 1, CA_HEADS), 0.1),
        'w_out': nrm(ks[9], (DEPTH, MIX_WIDTH, D_MODEL), MIX_WIDTH ** -0.5),
        'ffn_norm': 1.0 + nrm(ks[10], (DEPTH, D_MODEL), 0.02),
        'router_group_w': nrm(ks[11], (DEPTH, D_MODEL, N_GROUPS), D_MODEL ** -0.5),
        'router_group_b': nrm(ks[12], (DEPTH, N_GROUPS), 0.01),
        'router_expert_w': nrm(ks[13], (DEPTH, D_MODEL, N_EXPERTS), D_MODEL ** -0.5),
        'router_expert_b': nrm(ks[14], (DEPTH, N_EXPERTS), 0.01),
        'expert_w_gate': nrm(ks[15], (DEPTH, N_EXPERTS, D_MODEL, D_EXPERT), D_MODEL ** -0.5),
        'expert_w_up': nrm(ks[16], (DEPTH, N_EXPERTS, D_MODEL, D_EXPERT), D_MODEL ** -0.5),
        'expert_w_down': nrm(ks[17], (DEPTH, N_EXPERTS, D_EXPERT, D_MODEL), D_EXPERT ** -0.5),
    }


def reference(x, t5_bias, attn_norm, w_in, diff_qk_norm, diff_lambda, diff_subln, ca_qk_norm,
              ca_rel_bias, w_out, ffn_norm, router_group_w, router_group_b, router_expert_w,
              router_expert_b, expert_w_gate, expert_w_up, expert_w_down):
    h = x
    for l in range(DEPTH):
        lam_init = 0.8 - 0.6 * math.exp(-0.3 * l)
        a = rmsnorm(h, attn_norm[l])
        h = h + hybrid_mixer(a, w_in[l], w_out[l], t5_bias, diff_qk_norm[l], diff_lambda[l],
                             diff_subln[l], ca_qk_norm[l], ca_rel_bias[l], lam_init)
        f = rmsnorm(h, ffn_norm[l])
        h = h + hierarchical_moe(f, router_group_w[l], router_group_b[l], router_expert_w[l],
                                 router_expert_b[l], expert_w_gate[l], expert_w_up[l], expert_w_down[l])
    return h
```

```cpp
#include <hip/hip_runtime.h>
#include <cstdio>
#include <cstdint>

#ifndef MK_N_LAUNCHES
#define MK_N_LAUNCHES 15
#endif

#define LAS __attribute__((address_space(3)))
#define GAS __attribute__((address_space(1)))
typedef unsigned short bf16_t;
typedef short bf16x8 __attribute__((ext_vector_type(8)));
typedef short v4i16 __attribute__((ext_vector_type(4)));
typedef float f32x4 __attribute__((ext_vector_type(4)));
typedef float f32x16 __attribute__((ext_vector_type(16)));
typedef unsigned u32x4 __attribute__((ext_vector_type(4)));
typedef unsigned u32x2 __attribute__((ext_vector_type(2)));
typedef float f32x2_t __attribute__((ext_vector_type(2)));
typedef __bf16 bf16x2_t __attribute__((ext_vector_type(2)));
typedef GAS unsigned gu32;

constexpr int DM = 1024, BATCH = 8, SEQ = 4096, NTOK = BATCH * SEQ, DEPTH = 2;
constexpr int QKVW = 3072, NEXP = 32, DEXP = 512, ECAP = 32768;
constexpr int MAXROWS = 73728;
constexpr float EPS = 1e-6f;
constexpr float LOG2E = 1.4426950408889634f;
constexpr float QSCALE = 0.125f * LOG2E;
constexpr int NWAVES = 8;
constexpr int NPHASES = 1 + 7 * DEPTH;

constexpr size_t MiB = 1u << 20;
constexpr size_t WS_CTL = 0, CTL_ZERO_BYTES = 1 * MiB;
constexpr size_t WS_WIN = 1 * MiB;
constexpr size_t WS_WOUT = 13 * MiB;
constexpr size_t WS_WGU = 17 * MiB;
constexpr size_t WS_WD = 145 * MiB;
constexpr size_t WS_WRH = 209 * MiB;
constexpr size_t WS_WRL = WS_WRH + 256 * 1024;
constexpr size_t WS_RROW = 210 * MiB;
constexpr size_t WS_SLOT = WS_RROW + 256 * 1024;
constexpr size_t WS_TOK = 211 * MiB;
constexpr size_t WS_GATE = 215 * MiB;
constexpr size_t WS_RS = 219 * MiB;
constexpr size_t WS_HB = 223 * MiB;
constexpr size_t WS_R = 287 * MiB;
constexpr size_t WS_PROJ = WS_R, WS_MERGED = WS_R + 192 * MiB;
constexpr size_t WS_HID = WS_R;
constexpr size_t WS_YBUF = WS_R + 72 * MiB;
constexpr size_t WS_END = 543 * MiB;
constexpr int CW_BAR = 4096;
constexpr int CW_CNT = 16384;

constexpr int RING_BYTES = 131072;
constexpr int MISC_OFF = RING_BYTES;
constexpr int TB_OFF = RING_BYTES + 1024;
constexpr int LDS_BYTES = 147456;

__device__ __forceinline__ unsigned f2bf(float f) { unsigned u = __builtin_bit_cast(unsigned, f); return (u + 0x7fffu + ((u >> 16) & 1u)) >> 16; }
__device__ __forceinline__ unsigned pk2(float lo, float hi) { f32x2_t v = {lo, hi}; bf16x2_t b = __builtin_convertvector(v, bf16x2_t); return __builtin_bit_cast(unsigned, b); }
__device__ __forceinline__ float bflo(unsigned w) { return __builtin_bit_cast(float, w << 16); }
__device__ __forceinline__ float bfhi(unsigned w) { return __builtin_bit_cast(float, w & 0xffff0000u); }
__device__ __forceinline__ unsigned ld_agent(const unsigned* p) { return __hip_atomic_load(p, __ATOMIC_RELAXED, __HIP_MEMORY_SCOPE_AGENT); }
#define LDS_WAIT() asm volatile("s_waitcnt lgkmcnt(0)" ::: "memory")

#define XB_TMO      128
#define XB_XCNT(j)  (256  + 64 * (j))
#define XB_XSUB(j)  (1280 + 64 * (j))
#define XB_XGEN(j)  (2304 + 64 * (j))
#define XB_TOP      3328
#define XB_TOPGEN   3392
#define XCD_BAR_WORDS 3456
#define XB_SPIN_CAP (1u << 18)
__device__ __forceinline__ unsigned xb_ld(unsigned* p)              { return __hip_atomic_load(p, __ATOMIC_RELAXED, __HIP_MEMORY_SCOPE_AGENT); }
__device__ __forceinline__ unsigned xb_add(unsigned* p, unsigned v) { return __hip_atomic_fetch_add(p, v, __ATOMIC_RELAXED, __HIP_MEMORY_SCOPE_AGENT); }
__device__ __forceinline__ unsigned xb_xcc_id() { return (unsigned)__builtin_amdgcn_s_getreg((3 << 11) | 20) & 0xFu; }
#define XB_SPIN(cond, bar) do { unsigned _sp = 0; while (cond) { __builtin_amdgcn_s_sleep(1); \
    if ((++_sp & 255u) == 0u) { if (xb_ld(&(bar)[XB_TMO])) break; if (_sp > XB_SPIN_CAP) { atomicAdd(&(bar)[XB_TMO], 1u); break; } } } } while (0)
struct XcdBarrier { unsigned* bar; unsigned x; volatile LAS unsigned* st; };
__device__ __forceinline__ XcdBarrier xcd_barrier_post(unsigned* bar, volatile LAS unsigned* st) {
    XcdBarrier b; b.bar = bar; b.x = xb_xcc_id(); b.st = st;
    if (threadIdx.x == 0) (void)xb_add(&bar[XB_XCNT(b.x)], 1u);
    return b;
}
__device__ __forceinline__ void xcd_barrier_complete(unsigned* bar, unsigned x, unsigned& nloc, unsigned& nx) {
    const unsigned G = gridDim.x * gridDim.y * gridDim.z;
    unsigned sum, cnt, mine, sp = 0u;
    for (;;) {
        sum = 0u; cnt = 0u; mine = 0u;
#pragma unroll
        for (unsigned j = 0; j < 16; ++j) { const unsigned c = xb_ld(&bar[XB_XCNT(j)]); sum += c; cnt += (c > 0u) ? 1u : 0u; mine = (j == x) ? c : mine; }
        if (sum == G) break;
        __builtin_amdgcn_s_sleep(1);
        if ((++sp & 255u) == 0u) { if (xb_ld(&bar[XB_TMO])) break; if (sp > XB_SPIN_CAP) { atomicAdd(&bar[XB_TMO], 1u); break; } }
    }
    nloc = mine > 0u ? mine : 1u; nx = cnt > 0u ? cnt : 1u;
}
__device__ __forceinline__ void xcd_barrier(const XcdBarrier& b) {
    asm volatile("s_waitcnt vmcnt(0)" ::: "memory");
    __syncthreads();
    if (threadIdx.x == 0) {
        unsigned* bar = b.bar;
        __builtin_amdgcn_s_waitcnt(0);
        unsigned nloc = b.st[0], nx = b.st[1];
        if (nloc == 0u) { xcd_barrier_complete(bar, b.x, nloc, nx); b.st[0] = nloc; b.st[1] = nx; }
        const unsigned old = xb_add(&bar[XB_XSUB(b.x)], 1u);
        const unsigned gen = old / nloc;
        if (old + 1u == (gen + 1u) * nloc) {
            __builtin_amdgcn_fence(__ATOMIC_RELEASE, "agent");
            asm volatile("s_waitcnt vmcnt(0)" ::: "memory");
            const unsigned og = xb_add(&bar[XB_TOP], 1u);
            const unsigned tg = og / nx;
            if (og + 1u == (tg + 1u) * nx) xb_add(&bar[XB_TOPGEN], 1u);
            else XB_SPIN(xb_ld(&bar[XB_TOPGEN]) == tg, bar);
            __builtin_amdgcn_fence(__ATOMIC_ACQUIRE, "agent");
            xb_add(&bar[XB_XGEN(b.x)], 1u);
            asm volatile("s_waitcnt vmcnt(0)" ::: "memory");
        } else {
            XB_SPIN(xb_ld(&bar[XB_XGEN(b.x)]) == gen, bar);
            __builtin_amdgcn_fence(__ATOMIC_ACQUIRE, "agent");
            asm volatile("s_waitcnt vmcnt(0)" ::: "memory");
        }
    }
    __syncthreads();
}

namespace pg8 {
constexpr int BM = 256, BK = 64, HALF = 128, HTB = HALF * BK * 2, STAGE_BYTES = 8 * HTB, NXCD = 8, WGM = 8;
__device__ __forceinline__ int lds_byte(int r, int c) { const int st = (r >> 4) * 2 + (c >> 5), rr = r & 15, cc = c & 31, ob = rr * 64 + cc * 2; return st * 1024 + (ob ^ (((ob >> 9) & 1) << 5)); }
__device__ __forceinline__ void stage_rc(int b, int& R, int& C) { const int st = b / 1024, sb = b % 1024, swz = sb ^ (((sb >> 9) & 1) << 5); R = (st >> 1) * 16 + swz / 64; C = (st & 1) * 32 + (swz % 64) / 2; }
__device__ __forceinline__ int perm32(int rho) { const int n = rho >> 4, i = rho & 15; return 8 * (i >> 2) + 4 * n + (i & 3); }

struct Unit { int pm, pn, e, t0, cnt; };

struct DenseSched {
    static constexpr bool GATHER = false;
    int nM, nN, nwg, G, c, K; const bf16_t* Bt;
    __device__ void init(int M, int N, int K_, const bf16_t* Bt_, int G_, int c_) { nM = M / BM; nN = N / BM; nwg = nM * nN; G = G_; c = c_; K = K_; Bt = Bt_; }
    __device__ __forceinline__ bool next(int i, Unit& u) const {
        const long L = (long)i * G + c; if (L >= nwg) return false;
        int wgid = (int)L; { const int q = nwg / NXCD, r = nwg % NXCD, xcd = wgid % NXCD, off = wgid / NXCD; wgid = (xcd < r ? xcd * (q + 1) : r * (q + 1) + (xcd - r) * q) + off; }
        const int nig = WGM * nN, gid = wgid / nig, fm = gid * WGM, gsz = (nM - fm) < WGM ? (nM - fm) : WGM;
        u.pm = fm + ((wgid % nig) % gsz); u.pn = (wgid % nig) / gsz; u.e = 0; u.t0 = 0; u.cnt = 0; return true;
    }
    __device__ __forceinline__ int arow(const Unit& u, int r) const { return u.pm * BM + r; }
    __device__ __forceinline__ const bf16_t* bptr(const Unit& u) const { return Bt + (size_t)u.pn * BM * K; }
};
template <bool GATHER_> struct MoeSched {
    static constexpr bool GATHER = GATHER_;
    const volatile LAS int* pre; const unsigned* cnt; const int* tok; const bf16_t* W; int K, G, c;
    __device__ __forceinline__ bool next(int i, Unit& u) const {
        const int L = i * G + c, T = L >> 2; const int ntile = __builtin_amdgcn_readfirstlane(pre[32]);
        if (T >= ntile) return false;
        int e = 0; while (__builtin_amdgcn_readfirstlane(pre[e + 1]) <= T) ++e;
        u.e = e; u.pm = T; u.pn = L & 3; u.t0 = (T - __builtin_amdgcn_readfirstlane(pre[e])) * BM; u.cnt = __builtin_amdgcn_readfirstlane((int)ld_agent(cnt + 64 * e)); return true;
    }
    __device__ __forceinline__ int arow(const Unit& u, int r) const {
        if (GATHER_) { const int pos = u.t0 + r; return pos < u.cnt ? tok[u.e * ECAP + pos] : 0; }
        return u.pm * BM + r;
    }
    __device__ __forceinline__ const bf16_t* bptr(const Unit& u) const { return W + ((size_t)u.e * 1024 + (size_t)u.pn * BM) * K; }
};

template <class Epi, class Sched>
__device__ __forceinline__ void gemm_phase(LAS unsigned char* lds, const bf16_t* Abase_, int K, const Sched& S, const Epi& E) {
    int tid = threadIdx.x; asm volatile("" : "+v"(tid));
    const int wid = __builtin_amdgcn_readfirstlane(tid >> 6), lane = tid & 63, wr = wid >> 2, wc = wid & 3, fr = lane & 15, fq = lane >> 4;
    constexpr bool GATHER = Sched::GATHER;
    const int nt = K / BK;
    int Rs[2], Cs[2]; unsigned voffA[2], voffB[2];
#pragma unroll
    for (int i = 0; i < 2; ++i) { int R, C; stage_rc(tid * 16 + i * 8192, R, C); Rs[i] = R; Cs[i] = C; const int Rb = Epi::PERM ? ((R & ~31) + perm32(R & 31)) : R;
        voffA[i] = (unsigned)(R * K + C) * 2u; voffB[i] = (unsigned)(Rb * K + C) * 2u; }
    const size_t kstep = (size_t)(BK * 2);
    const size_t hstep = (size_t)HALF * K * 2;
    const unsigned ldsw = (unsigned)wid * 1024u;
    const char* Abase = (const char*)Abase_;
    const int aoff = lds_byte(wr * 64 + fr, fq * 8), boff = lds_byte(wc * 32 + fr, fq * 8);
#define PG8_SA(b, h) (((b) * 2 + (h)) * HTB)
#define PG8_SB(b, h) ((4 + (b) * 2 + (h)) * HTB)
#define PG8_STAGE(bufoff, gbase, v0, v1) do { \
        __builtin_amdgcn_global_load_lds((const unsigned*)((const char*)(gbase) + (v0)), (LAS unsigned*)(lds + (bufoff) + ldsw), 16, 0, 0); \
        __builtin_amdgcn_global_load_lds((const unsigned*)((const char*)(gbase) + (v1)), (LAS unsigned*)(lds + (bufoff) + ldsw + 8192), 16, 0, 0); } while (0)
#define PG8_STAGE_AC(bufoff, h, koff) do { if constexpr (GATHER) PG8_STAGE(bufoff, Abase + (koff), cA[h][0], cA[h][1]); else PG8_STAGE(bufoff, cAp + (h) * hstep + (koff), voffA[0], voffA[1]); } while (0)
#define PG8_STAGE_AX(bufoff, h, koff) do { if constexpr (GATHER) PG8_STAGE(bufoff, a2p + (koff), (h) ? x10 : x00, (h) ? x11 : x01); else PG8_STAGE(bufoff, a2p + (h) * hstep + (koff), voffA[0], voffA[1]); } while (0)
#define PG8_STAGE_B(bufoff, gbase) PG8_STAGE(bufoff, gbase, voffB[0], voffB[1])
#define PG8_LDA(dst, b, h) do { _Pragma("unroll") for (int m = 0; m < 4; ++m) _Pragma("unroll") for (int k = 0; k < 2; ++k) dst[m][k] = *(const LAS bf16x8*)(lds + PG8_SA(b, h) + aoff + m * 2048 + k * 1024); } while (0)
#define PG8_LDB(dst, b, h) do { _Pragma("unroll") for (int n = 0; n < 2; ++n) _Pragma("unroll") for (int k = 0; k < 2; ++k) dst[n][k] = *(const LAS bf16x8*)(lds + PG8_SB(b, h) + boff + n * 2048 + k * 1024); } while (0)
#define PG8_MMA(ai, bj, At, Bt) do { __builtin_amdgcn_s_setprio(1); _Pragma("unroll") for (int m = 0; m < 4; ++m) _Pragma("unroll") for (int n = 0; n < 2; ++n) _Pragma("unroll") for (int k = 0; k < 2; ++k) \
        acc[ai][bj][m][n] = __builtin_amdgcn_mfma_f32_16x16x32_bf16(Bt[n][k], At[m][k], acc[ai][bj][m][n], 0, 0, 0); __builtin_amdgcn_s_setprio(0); } while (0)
#define PG8_WAIT_V(n) asm volatile("s_waitcnt vmcnt(" #n ")" ::: "memory")
#define PG8_WAIT_L(n) asm volatile("s_waitcnt lgkmcnt(" #n ")" ::: "memory")
#define PG8_BAR __builtin_amdgcn_s_barrier()
#define PG8_SCHED __builtin_amdgcn_sched_barrier(0)
#define PG8_MKA(dst, u) do { _Pragma("unroll") for (int h_ = 0; h_ < 2; ++h_) _Pragma("unroll") for (int i_ = 0; i_ < 2; ++i_) dst[h_][i_] = ((unsigned)S.arow(u, h_ * HALF + Rs[i_]) * (unsigned)K + (unsigned)Cs[i_]) * 2u; } while (0)
    Unit cur, nxt; int ui = 0;
    if (!S.next(0, cur)) return;
    f32x4 acc[2][2][4][2];
#pragma unroll
    for (int a = 0; a < 2; ++a)
#pragma unroll
        for (int b = 0; b < 2; ++b)
#pragma unroll
            for (int m = 0; m < 4; ++m)
#pragma unroll
                for (int n = 0; n < 2; ++n) acc[a][b][m][n] = (f32x4){0.f, 0.f, 0.f, 0.f};
    bf16x8 At[4][2], B0[2][2], B1[2][2];
    unsigned cA[2][2] = {{0u, 0u}, {0u, 0u}}, nA[2][2] = {{0u, 0u}, {0u, 0u}};
    const char* cAp = Abase; const char* nAp = Abase;
    if constexpr (GATHER) { PG8_MKA(cA, cur); } else { cAp = Abase + (size_t)S.arow(cur, 0) * K * 2; }
    const char* cB = (const char*)S.bptr(cur);
    PG8_STAGE_B(PG8_SB(0, 0), cB); PG8_STAGE_B(PG8_SB(0, 1), cB + hstep); PG8_STAGE_AC(PG8_SA(0, 0), 0, 0); PG8_STAGE_AC(PG8_SA(0, 1), 1, 0);
    if (wr == 1) PG8_BAR;
    PG8_WAIT_V(2); PG8_BAR;
    PG8_STAGE_B(PG8_SB(1, 0), cB + kstep); PG8_STAGE_AC(PG8_SA(1, 0), 0, kstep); PG8_STAGE_B(PG8_SB(1, 1), cB + hstep + kstep);
    PG8_WAIT_V(6); PG8_BAR;
    for (;;) {
        const bool has_next = S.next(ui + 1, nxt);
        const char* nB = cB; nAp = cAp;
        if (has_next) { nB = (const char*)S.bptr(nxt); if constexpr (GATHER) { PG8_MKA(nA, nxt); } else { nAp = Abase + (size_t)S.arow(nxt, 0) * K * 2; } }
        else { if constexpr (GATHER) {
#pragma unroll
            for (int h_ = 0; h_ < 2; ++h_)
#pragma unroll
                for (int i_ = 0; i_ < 2; ++i_) nA[h_][i_] = cA[h_][i_]; } }
        for (int t = 0; t < nt; t += 2) {
            const bool last = (t == nt - 2);
            const size_t k1 = (size_t)(t + 1) * kstep, k2 = last ? (size_t)0 : (size_t)(t + 2) * kstep;
            const char* a2p = (GATHER ? Abase : (last ? nAp : cAp)) + k2; const char* b2 = (last ? nB : cB) + k2;
            const char* b3 = b2 + kstep;
            const unsigned x00 = last ? nA[0][0] : cA[0][0], x01 = last ? nA[0][1] : cA[0][1], x10 = last ? nA[1][0] : cA[1][0], x11 = last ? nA[1][1] : cA[1][1];
            PG8_LDB(B0, 0, 0); PG8_LDB(B1, 0, 1); PG8_SCHED; PG8_LDA(At, 0, 0); PG8_STAGE_AC(PG8_SA(1, 1), 1, k1);
            PG8_WAIT_V(8); PG8_WAIT_L(0); PG8_BAR; PG8_MMA(0, 0, At, B0); PG8_MMA(0, 1, At, B1); PG8_BAR; PG8_SCHED;
            PG8_LDA(At, 0, 1); PG8_STAGE_B(PG8_SB(0, 0), b2); PG8_STAGE_B(PG8_SB(0, 1), b2 + hstep); PG8_STAGE_AX(PG8_SA(0, 0), 0, 0);
            PG8_WAIT_V(8); PG8_WAIT_L(0); PG8_BAR; PG8_MMA(1, 0, At, B0); PG8_MMA(1, 1, At, B1); PG8_BAR; PG8_SCHED;
            PG8_LDB(B0, 1, 0); PG8_LDB(B1, 1, 1); PG8_SCHED; PG8_LDA(At, 1, 0); PG8_STAGE_AX(PG8_SA(0, 1), 1, 0);
            PG8_WAIT_V(8); PG8_WAIT_L(0); PG8_BAR; PG8_MMA(0, 0, At, B0); PG8_MMA(0, 1, At, B1); PG8_BAR; PG8_SCHED;
            PG8_LDA(At, 1, 1); PG8_STAGE_B(PG8_SB(1, 0), b3); PG8_STAGE_B(PG8_SB(1, 1), b3 + hstep); PG8_STAGE_AX(PG8_SA(1, 0), 0, kstep);
            PG8_WAIT_V(8); PG8_WAIT_L(0); PG8_BAR; PG8_MMA(1, 0, At, B0); PG8_MMA(1, 1, At, B1); PG8_BAR; PG8_SCHED;
        }
        if (wr == 0) PG8_BAR;
        E(acc, cur, wr, wc, fr, fq);
        if (!has_next) break;
#pragma unroll
        for (int a = 0; a < 2; ++a)
#pragma unroll
            for (int b = 0; b < 2; ++b)
#pragma unroll
                for (int m = 0; m < 4; ++m)
#pragma unroll
                    for (int n = 0; n < 2; ++n) acc[a][b][m][n] = (f32x4){0.f, 0.f, 0.f, 0.f};
        cur = nxt; cB = nB; cAp = nAp; ++ui;
        if constexpr (GATHER) {
#pragma unroll
        for (int h_ = 0; h_ < 2; ++h_)
#pragma unroll
            for (int i_ = 0; i_ < 2; ++i_) cA[h_][i_] = nA[h_][i_]; }
        if (wr == 1) PG8_BAR;
    }
    PG8_WAIT_V(0);
    PG8_BAR;
#undef PG8_SA
#undef PG8_SB
#undef PG8_STAGE
#undef PG8_STAGE_AC
#undef PG8_STAGE_AX
#undef PG8_STAGE_B
#undef PG8_LDA
#undef PG8_LDB
#undef PG8_MMA
#undef PG8_WAIT_V
#undef PG8_WAIT_L
#undef PG8_BAR
#undef PG8_SCHED
#undef PG8_MKA
}

struct EpiWin {
    static constexpr bool PERM = true;
    bf16_t* proj; const float* rrow; const float* dqn; const float* cqn;
    __device__ __forceinline__ void operator()(const f32x4 (&acc)[2][2][4][2], const Unit& u, int wr, int wc, int fr, int fq) const {
        const int pn = u.pn;
        const float* g = nullptr;
        if (pn == 3 || pn == 4) g = dqn; else if (pn == 5 || pn == 6) g = dqn + 64; else if (pn == 9) g = cqn; else if (pn == 10) g = cqn + 64;
        const float qs = (pn == 0 || pn == 3 || pn == 4 || pn == 9) ? QSCALE : 1.0f;
        f32x4 gv[2][2];
#pragma unroll
        for (int bj = 0; bj < 2; ++bj)
#pragma unroll
            for (int n = 0; n < 2; ++n) { f32x4 t = g ? *(const f32x4*)(g + 32 * bj + 8 * fq + 4 * n) : (f32x4){1.f, 1.f, 1.f, 1.f}; gv[bj][n] = t * qs; }
        const bool donorm = (g != nullptr);
#pragma unroll
        for (int ai = 0; ai < 2; ++ai)
#pragma unroll
            for (int m = 0; m < 4; ++m) {
                const int row = u.pm * BM + ai * HALF + wr * 64 + m * 16 + fr;
                const float rs = rrow[row];
                f32x4 v[2][2]; float ss = 0.f;
#pragma unroll
                for (int bj = 0; bj < 2; ++bj)
#pragma unroll
                    for (int n = 0; n < 2; ++n) { v[bj][n] = acc[ai][bj][m][n] * rs; const f32x4 q = v[bj][n] * v[bj][n]; ss += (q[0] + q[1]) + (q[2] + q[3]); }
                float rn = 1.0f;
                if (donorm) { ss += __shfl_xor(ss, 16); ss += __shfl_xor(ss, 32); rn = __builtin_amdgcn_rsqf(ss * (1.0f / 64.0f) + EPS); }
                bf16_t* rowp = proj + (size_t)row * QKVW + pn * BM + 64 * wc + 8 * fq;
#pragma unroll
                for (int bj = 0; bj < 2; ++bj) { const f32x4 a = v[bj][0] * rn * gv[bj][0], b = v[bj][1] * rn * gv[bj][1];
                    u32x4 w; w.x = pk2(a[0], a[1]); w.y = pk2(a[2], a[3]); w.z = pk2(b[0], b[1]); w.w = pk2(b[2], b[3]);
                    *(u32x4*)(rowp + 32 * bj) = w; }
            }
    }
};
struct EpiWout {
    static constexpr bool PERM = false;
    const float* hin; float* out;
    __device__ __forceinline__ void operator()(const f32x4 (&acc)[2][2][4][2], const Unit& u, int wr, int wc, int fr, int fq) const {
        const int col0 = u.pn * BM + wc * 32 + 4 * fq;
#pragma unroll
        for (int ai = 0; ai < 2; ++ai)
#pragma unroll
            for (int m = 0; m < 4; ++m) { const size_t off = (size_t)(u.pm * BM + ai * HALF + wr * 64 + m * 16 + fr) * DM + col0;
#pragma unroll
                for (int bj = 0; bj < 2; ++bj)
#pragma unroll
                    for (int n = 0; n < 2; ++n) { const f32x4 b = *(const f32x4*)(hin + off + bj * HALF + n * 16); *(f32x4*)(out + off + bj * HALF + n * 16) = b + acc[ai][bj][m][n]; }
                if (m & 1) asm volatile("" ::: "memory"); }
    }
};
struct EpiGU {
    static constexpr bool PERM = true;
    bf16_t* hid; const float* rsl;
    __device__ __forceinline__ void operator()(const f32x4 (&acc)[2][2][4][2], const Unit& u, int wr, int wc, int fr, int fq) const {
#pragma unroll
        for (int ai = 0; ai < 2; ++ai)
#pragma unroll
            for (int m = 0; m < 4; ++m) {
                const int rl = ai * HALF + wr * 64 + m * 16 + fr, pos = u.t0 + rl;
                const float rs = pos < u.cnt ? rsl[u.e * ECAP + pos] : 0.f;
                float o[8];
#pragma unroll
                for (int n = 0; n < 2; ++n)
#pragma unroll
                    for (int i = 0; i < 4; ++i) { const float gt = acc[ai][0][m][n][i] * rs, up = acc[ai][1][m][n][i] * rs;
                        const float sg = gt * __builtin_amdgcn_rcpf(1.0f + __builtin_amdgcn_exp2f(-gt * LOG2E)); o[n * 4 + i] = sg * up; }
                u32x4 w; w.x = pk2(o[0], o[1]); w.y = pk2(o[2], o[3]); w.z = pk2(o[4], o[5]); w.w = pk2(o[6], o[7]);
                *(u32x4*)(hid + (size_t)(u.pm * BM + rl) * DEXP + u.pn * HALF + 32 * wc + 8 * fq) = w;
            }
    }
};
struct EpiDown {
    static constexpr bool PERM = true;
    bf16_t* ybuf; const float* gl;
    __device__ __forceinline__ void operator()(const f32x4 (&acc)[2][2][4][2], const Unit& u, int wr, int wc, int fr, int fq) const {
#pragma unroll
        for (int ai = 0; ai < 2; ++ai)
#pragma unroll
            for (int m = 0; m < 4; ++m) {
                const int rl = ai * HALF + wr * 64 + m * 16 + fr, pos = u.t0 + rl;
                const float gt = pos < u.cnt ? gl[u.e * ECAP + pos] : 0.f;
                bf16_t* rowp = ybuf + (size_t)(u.pm * BM + rl) * DM + u.pn * BM + wc * 32 + 8 * fq;
#pragma unroll
                for (int bj = 0; bj < 2; ++bj) { const f32x4 a = acc[ai][bj][m][0] * gt, b = acc[ai][bj][m][1] * gt;
                    u32x4 w; w.x = pk2(a[0], a[1]); w.y = pk2(a[2], a[3]); w.z = pk2(b[0], b[1]); w.w = pk2(b[2], b[3]);
                    *(u32x4*)(rowp + bj * HALF) = w; }
            }
    }
};
}

__device__ __forceinline__ int crow(int r, int hi) { return (r & 3) + 8 * (r >> 2) + 4 * hi; }
__device__ __forceinline__ v4i16 vtr(const LAS unsigned char* p) { return __builtin_amdgcn_ds_read_tr16_b64_v4i16((LAS v4i16*)p); }
__device__ __forceinline__ bf16x8 mk8(v4i16 lo, v4i16 hi) { return (bf16x8){lo[0], lo[1], lo[2], lo[3], hi[0], hi[1], hi[2], hi[3]}; }
__device__ __forceinline__ void qk_tile(f32x16& p0, f32x16& p1, const LAS unsigned char* kt, const bf16x8* qr, int r32, int hi) {
    const LAS unsigned char* kb = kt + hi * 1024 + r32 * 16;
#pragma unroll
    for (int d0 = 0; d0 < 4; ++d0) {
        const bf16x8 a0 = *(const LAS bf16x8*)(kb + d0 * 2048), a1 = *(const LAS bf16x8*)(kb + d0 * 2048 + 512);
        p0 = __builtin_amdgcn_mfma_f32_32x32x16_bf16(a0, qr[d0], p0, 0, 0, 0);
        p1 = __builtin_amdgcn_mfma_f32_32x32x16_bf16(a1, qr[d0], p1, 0, 0, 0);
    }
}
template <int ND> __device__ __forceinline__ void pv_tile(f32x16* o, const LAS unsigned char* vt, const bf16x8* pa, int lane, int hi) {
    const LAS unsigned char* vb = vt + ((lane >> 4) & 1) * 32 + (lane & 3) * 8 + (4 * hi + ((lane & 15) >> 2)) * 64;
#pragma unroll
    for (int d0 = 0; d0 < ND; ++d0)
#pragma unroll
        for (int ks = 0; ks < 4; ++ks) {
            const v4i16 lo = vtr(vb + d0 * 4096 + ks * 1024), h2 = vtr(vb + d0 * 4096 + ks * 1024 + 512);
            o[d0] = __builtin_amdgcn_mfma_f32_32x32x16_bf16(mk8(lo, h2), pa[ks], o[d0], 0, 0, 0);
        }
}
__device__ __forceinline__ void pack_p(bf16x8* pa, const f32x16& p0, const f32x16& p1) {
    u32x4 w;
    w.x = pk2(p0[0], p0[1]); w.y = pk2(p0[2], p0[3]); w.z = pk2(p0[4], p0[5]); w.w = pk2(p0[6], p0[7]); pa[0] = __builtin_bit_cast(bf16x8, w);
    w.x = pk2(p0[8], p0[9]); w.y = pk2(p0[10], p0[11]); w.z = pk2(p0[12], p0[13]); w.w = pk2(p0[14], p0[15]); pa[1] = __builtin_bit_cast(bf16x8, w);
    w.x = pk2(p1[0], p1[1]); w.y = pk2(p1[2], p1[3]); w.z = pk2(p1[4], p1[5]); w.w = pk2(p1[6], p1[7]); pa[2] = __builtin_bit_cast(bf16x8, w);
    w.x = pk2(p1[8], p1[9]); w.y = pk2(p1[10], p1[11]); w.z = pk2(p1[12], p1[13]); w.w = pk2(p1[14], p1[15]); pa[3] = __builtin_bit_cast(bf16x8, w);
}
template <int ND> __device__ __forceinline__ void softmax_step(f32x16& p0, f32x16& p1, float& mrun, float& l, f32x16* o) {
    float mx = p0[0];
#pragma unroll
    for (int r = 1; r < 16; ++r) mx = fmaxf(mx, p0[r]);
#pragma unroll
    for (int r = 0; r < 16; ++r) mx = fmaxf(mx, p1[r]);
    mx = fmaxf(mx, __shfl_xor(mx, 32));
    const float mn = fmaxf(mrun, mx), alpha = __builtin_amdgcn_exp2f(mrun - mn);
    mrun = mn;
    float s = 0.f;
#pragma unroll
    for (int r = 0; r < 16; ++r) { p0[r] = __builtin_amdgcn_exp2f(p0[r] - mn); p1[r] = __builtin_amdgcn_exp2f(p1[r] - mn); s += p0[r] + p1[r]; }
    l = l * alpha + s;
#pragma unroll
    for (int d0 = 0; d0 < ND; ++d0)
#pragma unroll
        for (int r = 0; r < 16; ++r) o[d0][r] *= alpha;
}
__device__ __forceinline__ int t5_bucket_past_or_future(int rel) {
    const int n = rel < 0 ? -rel : rel;
    int v;
    if (n < 8) v = n;
    else v = 8 + (n >= 13) + (n >= 20) + (n >= 30) + (n >= 46) + (n >= 70) + (n >= 108) + (n >= 166);
    return (rel > 0 ? 16 : 0) + v;
}

__device__ __forceinline__ void attnB_unit(LAS unsigned char* lds, const bf16_t* proj, bf16_t* merged, const float* t5_bias, const float* dlam, const float* subln, float lam_init, int b, int h, int qb) {
    int tid = threadIdx.x; asm volatile("" : "+v"(tid)); const int lane = tid & 63, r32 = lane & 31, hi = lane >> 5; const int wid = __builtin_amdgcn_readfirstlane(tid >> 6);
    const int m = wid >> 2, s = wid & 3, q0w = qb * 128 + s * 32;
    const size_t tokbase = (size_t)b * SEQ;
    LAS float* tb = (LAS float*)(lds + TB_OFF);
    for (int i = tid; i < 320; i += NWAVES * 64) tb[i] = t5_bias[t5_bucket_past_or_future(i - 256) * 4 + h] * LOG2E;
    float lam;
    { float a = dlam[lane] * dlam[64 + lane], c = dlam[128 + lane] * dlam[192 + lane];
#pragma unroll
      for (int o_ = 1; o_ < 64; o_ <<= 1) { a += __shfl_xor(a, o_); c += __shfl_xor(c, o_); }
      lam = __expf(a) - __expf(c) + lam_init; }
    bf16x8 qr[4];
    { const bf16_t* qp = proj + (tokbase + q0w + r32) * QKVW + 768 + h * 128 + m * 64 + hi * 8;
#pragma unroll
      for (int d0 = 0; d0 < 4; ++d0) qr[d0] = *(const bf16x8*)(qp + d0 * 16); }
    const int ntiles = 2 * qb + 2, mylast = q0w >> 6;
    const int pid0 = wid, pid1 = wid + 8;
    const bf16_t* srcK1 = proj + (tokbase + lane) * QKVW + 1280 + h * 128 + 8 * wid;
    const bf16_t* srcK2 = srcK1 + 64;
    const bf16_t* srcV0 = proj + (tokbase + 16 * (pid0 & 3) + (lane >> 2)) * QKVW + 1792 + h * 128 + 32 * (pid0 >> 2) + 8 * (lane & 3);
    const bf16_t* srcV1 = proj + (tokbase + 16 * (pid1 & 3) + (lane >> 2)) * QKVW + 1792 + h * 128 + 32 * (pid1 >> 2) + 8 * (lane & 3);
    const size_t tstep = (size_t)64 * QKVW;
#define GLDS16(src, dstoff) __builtin_amdgcn_global_load_lds((const unsigned*)(src), (LAS unsigned*)(lds + (dstoff)), 16, 0, 0)
    const int uK1 = wid * 1024, uK2 = 8192 + uK1, uV0 = 16384 + pid0 * 1024, uV1 = 16384 + pid1 * 1024;
    GLDS16(srcK1, uK1); GLDS16(srcK2, uK2); GLDS16(srcV0, uV0); GLDS16(srcV1, uV1);
    __syncthreads();
    const float cb = tb[0];
    float mrun = -1e30f, l = 0.f; f32x16 o[4];
#pragma unroll
    for (int d0 = 0; d0 < 4; ++d0) o[d0] = f32x16{};
    for (int t = 0; t < ntiles; ++t) {
        if (t + 1 < ntiles) { const size_t off = (size_t)(t + 1) * tstep; const int nb = ((t + 1) & 1) * 32768; GLDS16(srcK1 + off, nb + uK1); GLDS16(srcK2 + off, nb + uK2); GLDS16(srcV0 + off, nb + uV0); GLDS16(srcV1 + off, nb + uV1); }
        if (t <= mylast) {
            const LAS unsigned char* bufp = lds + (t & 1) * 32768;
            f32x16 p0 = f32x16{}, p1 = f32x16{};
            qk_tile(p0, p1, bufp + m * 8192, qr, r32, hi);
            if (64 * t + 63 - q0w <= -166) {
#pragma unroll
                for (int r = 0; r < 16; ++r) { p0[r] += cb; p1[r] += cb; }
            } else {
                const int relbase = 64 * t - (q0w + r32) + 256;
#pragma unroll
                for (int r = 0; r < 16; ++r) { const int i0 = relbase + crow(r, hi); p0[r] += tb[i0 < 0 ? 0 : i0]; const int i1 = i0 + 32; p1[r] += tb[i1 < 0 ? 0 : i1]; }
            }
            softmax_step<4>(p0, p1, mrun, l, o);
            bf16x8 pa[4]; pack_p(pa, p0, p1);
            pv_tile<4>(o, bufp + 16384, pa, lane, hi);
        }
        asm volatile("s_waitcnt vmcnt(0)" ::: "memory");
        __syncthreads();
    }
    const float lt = l + __shfl_xor(l, 32), inv = 1.0f / lt;
    LAS float* X = (LAS float*)lds;
    if (m == 1) {
#pragma unroll
        for (int d0 = 0; d0 < 4; ++d0)
#pragma unroll
            for (int r = 0; r < 16; ++r) X[((s * 64 + d0 * 16 + r) * 64) + lane] = o[d0][r] * inv;
    }
    __syncthreads();
    if (m == 0) {
        float ss = 0.f;
#pragma unroll
        for (int d0 = 0; d0 < 4; ++d0)
#pragma unroll
            for (int r = 0; r < 16; ++r) { const float y = o[d0][r] * inv - lam * X[((s * 64 + d0 * 16 + r) * 64) + lane]; o[d0][r] = y; ss += y * y; }
        ss += __shfl_xor(ss, 32);
        const float rn = __builtin_amdgcn_rsqf(ss * (1.0f / 128.0f) + EPS) * (1.0f - lam_init);
        bf16_t* op = merged + (tokbase + q0w + r32) * DM + 256 + h * 128 + 4 * hi;
#pragma unroll
        for (int d0 = 0; d0 < 4; ++d0)
#pragma unroll
            for (int a = 0; a < 4; ++a) { const f32x4 g = *(const f32x4*)(subln + 32 * d0 + 8 * a + 4 * hi);
                u32x2 w; w.x = pk2(o[d0][4 * a] * rn * g[0], o[d0][4 * a + 1] * rn * g[1]); w.y = pk2(o[d0][4 * a + 2] * rn * g[2], o[d0][4 * a + 3] * rn * g[3]);
                *(u32x2*)(op + 32 * d0 + 8 * a) = w; }
    }
    __syncthreads();
}

__device__ __forceinline__ void attnC_unit(LAS unsigned char* lds, const bf16_t* proj, bf16_t* merged, const float* relb  , int b, int h, int qb) {
    int tid = threadIdx.x; asm volatile("" : "+v"(tid)); const int lane = tid & 63, r32 = lane & 31, hi = lane >> 5; const int wid = __builtin_amdgcn_readfirstlane(tid >> 6);
    const int c0 = 4 * qb, cw = c0 + (wid >> 1), q0w = 64 * cw + 32 * (wid & 1);
    const size_t tokbase = (size_t)b * SEQ;
    LAS float* tb = (LAS float*)(lds + TB_OFF);
    for (int i = tid; i < 257; i += NWAVES * 64) tb[i] = relb[i * 4 + h] * LOG2E;
    bf16x8 qr[4];
    { const bf16_t* qp = proj + (tokbase + q0w + r32) * QKVW + 2304 + h * 64 + hi * 8;
#pragma unroll
      for (int d0 = 0; d0 < 4; ++d0) qr[d0] = *(const bf16x8*)(qp + d0 * 16); }
    const int tlo = c0 - 8 < 0 ? 0 : c0 - 8, thi = c0 + 3;
    const bf16_t* srcK = proj + (tokbase + lane) * QKVW + 2560 + h * 64 + 8 * wid;
    const bf16_t* srcV = proj + (tokbase + 16 * (wid & 3) + (lane >> 2)) * QKVW + 2816 + h * 64 + 32 * (wid >> 2) + 8 * (lane & 3);
    const int uK = wid * 1024, uV = 8192 + uK;
    const size_t tstep = (size_t)64 * QKVW;
    GLDS16(srcK + tlo * tstep, uK); GLDS16(srcV + tlo * tstep, uV);
    __syncthreads();
    const float cb = tb[0];
    float mrun = -1e30f, l = 0.f; f32x16 o[2]; o[0] = f32x16{}; o[1] = f32x16{};
    for (int t = tlo; t <= thi; ++t) {
        const int bi = (t - tlo) & 1;
        if (t < thi) { const size_t off = (size_t)(t + 1) * tstep; const int nb = (bi ^ 1) * 16384; GLDS16(srcK + off, nb + uK); GLDS16(srcV + off, nb + uV); }
        if (t >= cw - 8 && t <= cw) {
            const LAS unsigned char* bufp = lds + bi * 16384;
            f32x16 p0 = f32x16{}, p1 = f32x16{};
            qk_tile(p0, p1, bufp, qr, r32, hi);
            if (64 * t + 63 - q0w <= -128) {
#pragma unroll
                for (int r = 0; r < 16; ++r) { p0[r] += cb; p1[r] += cb; }
            } else {
                const int relbase = 64 * t - (q0w + r32) + 128;
#pragma unroll
                for (int r = 0; r < 16; ++r) { int i0 = relbase + crow(r, hi), i1 = i0 + 32; i0 = i0 < 0 ? 0 : (i0 > 256 ? 256 : i0); i1 = i1 < 0 ? 0 : (i1 > 256 ? 256 : i1); p0[r] += tb[i0]; p1[r] += tb[i1]; }
            }
            softmax_step<2>(p0, p1, mrun, l, o);
            bf16x8 pa[4]; pack_p(pa, p0, p1);
            pv_tile<2>(o, bufp + 8192, pa, lane, hi);
        }
        asm volatile("s_waitcnt vmcnt(0)" ::: "memory");
        __syncthreads();
    }
    const float lt = l + __shfl_xor(l, 32), inv = 1.0f / lt;
    bf16_t* op = merged + (tokbase + q0w + r32) * DM + 768 + h * 64 + 4 * hi;
#pragma unroll
    for (int d0 = 0; d0 < 2; ++d0)
#pragma unroll
        for (int a = 0; a < 4; ++a) { u32x2 w; w.x = pk2(o[d0][4 * a] * inv, o[d0][4 * a + 1] * inv); w.y = pk2(o[d0][4 * a + 2] * inv, o[d0][4 * a + 3] * inv); *(u32x2*)(op + 32 * d0 + 8 * a) = w; }
}

__device__ __forceinline__ void attnA_unit(LAS unsigned char* lds, const bf16_t* proj, bf16_t* merged, int b, int h, int qb) {
    int tid = threadIdx.x; asm volatile("" : "+v"(tid)); const int lane = tid & 63, r32 = lane & 31, hi = lane >> 5; const int wid = __builtin_amdgcn_readfirstlane(tid >> 6);
    const int q0w = 256 * qb + 32 * wid, td = q0w >> 6;
    const size_t tokbase = (size_t)b * SEQ;
    LAS unsigned char* wl = lds + wid * 16384;
    bf16x8 qr[4];
    { const bf16_t* qp = proj + (tokbase + q0w + r32) * QKVW + h * 64 + hi * 8;
#pragma unroll
      for (int d0 = 0; d0 < 4; ++d0) qr[d0] = *(const bf16x8*)(qp + d0 * 16); }
    float carry = 0.f; f32x16 o[2]; o[0] = f32x16{}; o[1] = f32x16{};
    const int qpos = q0w + r32;
    for (int t = td; t >= 0; --t) {
        const bf16_t* kp = proj + (tokbase + 64 * t + lane) * QKVW + 256 + h * 64;
        const bf16_t* vp = proj + (tokbase + 64 * t + (lane >> 2)) * QKVW + 512 + h * 64 + 8 * (lane & 3);
        const int wbase = wid * 16384;
#pragma unroll
        for (int j = 0; j < 8; ++j) GLDS16(kp + 8 * j, wbase + j * 1024);
#pragma unroll
        for (int j = 0; j < 8; ++j) GLDS16(vp + (size_t)(16 * (j & 3)) * QKVW + 32 * (j >> 2), wbase + 8192 + j * 1024);
        asm volatile("s_waitcnt vmcnt(0)" ::: "memory");
        f32x16 p0 = f32x16{}, p1 = f32x16{};
        qk_tile(p0, p1, wl, qr, r32, hi);
        f32x16 k0, k1;
        const bool diag = (t == td);
#pragma unroll
        for (int r = 0; r < 16; ++r) {
            const float z0 = p0[r], z1 = p1[r];
            float a0 = -(fmaxf(z0, 0.f) + __builtin_amdgcn_logf(1.0f + __builtin_amdgcn_exp2f(-fabsf(z0))));
            float a1 = -(fmaxf(z1, 0.f) + __builtin_amdgcn_logf(1.0f + __builtin_amdgcn_exp2f(-fabsf(z1))));
            if (diag) { const int key = 64 * t + crow(r, hi); if (key >= qpos) a0 = 0.f; if (key + 32 >= qpos) a1 = 0.f; }
            k0[r] = a0; k1[r] = a1;
        }
        float G[2][4], Go[2][4];
#pragma unroll
        for (int a = 0; a < 4; ++a) { G[0][a] = (k0[4 * a] + k0[4 * a + 1]) + (k0[4 * a + 2] + k0[4 * a + 3]); G[1][a] = (k1[4 * a] + k1[4 * a + 1]) + (k1[4 * a + 2] + k1[4 * a + 3]); }
#pragma unroll
        for (int P = 0; P < 2; ++P)
#pragma unroll
            for (int a = 0; a < 4; ++a) Go[P][a] = __shfl_xor(G[P][a], 32);
        float accs = carry;
#pragma unroll
        for (int P = 1; P >= 0; --P)
#pragma unroll
            for (int a = 3; a >= 0; --a) {
                f32x16& kk_ = P ? k1 : k0; f32x16& pp = P ? p1 : p0;
                float bt = accs + (hi == 0 ? Go[P][a] : 0.f);
#pragma unroll
                for (int i = 3; i >= 0; --i) { const int r = 4 * a + i; const float lk = kk_[r]; pp[r] = __builtin_amdgcn_exp2f(pp[r] + lk + bt); bt += lk; }
                accs += G[P][a] + Go[P][a];
            }
        carry = accs;
        if (diag) {
#pragma unroll
            for (int r = 0; r < 16; ++r) { const int key = 64 * t + crow(r, hi); if (key >= qpos) p0[r] = 0.f; if (key + 32 >= qpos) p1[r] = 0.f; }
        }
        bf16x8 pa[4]; pack_p(pa, p0, p1);
        pv_tile<2>(o, wl + 8192, pa, lane, hi);
        asm volatile("s_waitcnt lgkmcnt(0)" ::: "memory");
        if (__all(carry < -150.0f)) break;
    }
    bf16_t* op = merged + (tokbase + q0w + r32) * DM + h * 64 + 4 * hi;
#pragma unroll
    for (int d0 = 0; d0 < 2; ++d0)
#pragma unroll
        for (int a = 0; a < 4; ++a) { u32x2 w; w.x = pk2(o[d0][4 * a], o[d0][4 * a + 1]); w.y = pk2(o[d0][4 * a + 2], o[d0][4 * a + 3]); *(u32x2*)(op + 32 * d0 + 8 * a) = w; }
}

struct Args { const float* in[18]; float* out; unsigned char* ws; int ph_lo, ph_hi; };
enum { I_X = 0, I_T5, I_ANORM, I_WIN, I_DQN, I_DLAM, I_DSUB, I_CQN, I_CRB, I_WOUT, I_FNORM, I_RGW, I_RGB, I_REW, I_REB, I_WG, I_WU, I_WD };

__device__ __forceinline__ int rowmap(int kind, int n) {
    if (kind == 1) return (n & ~255) + 128 * ((n & 63) >> 5) + 32 * ((n >> 6) & 3) + (n & 31);
    if (kind == 2) return 256 * (n >> 7) + (n & 127);
    if (kind == 3) return 256 * (n >> 7) + 128 + (n & 127);
    return n;
}
__device__ __forceinline__ void transpose_item(const float* W, int K, int N, const float* gain, bf16_t* WT, int kind, LAS float* scr, int item, int lane) {
    const int nblk = N / 32, kb = item / nblk, nb = item % nblk, k0 = 64 * kb, n0 = 32 * nb;
#pragma unroll 8
    for (int i = 0; i < 32; ++i) { const int kk = 2 * i + (lane >> 5); float v = W[(size_t)(k0 + kk) * N + n0 + (lane & 31)]; if (gain) v *= gain[k0 + kk]; scr[kk * 33 + (lane & 31)] = v; }
    LDS_WAIT();
    const int c = lane & 7;
#pragma unroll
    for (int j = 0; j < 4; ++j) { const int n = (lane >> 3) + 8 * j; const LAS float* s = scr + (8 * c) * 33 + n;
        u32x4 o; o.x = pk2(s[0 * 33], s[1 * 33]); o.y = pk2(s[2 * 33], s[3 * 33]); o.z = pk2(s[4 * 33], s[5 * 33]); o.w = pk2(s[6 * 33], s[7 * 33]);
        *(u32x4*)(WT + (size_t)rowmap(kind, n0 + n) * K + k0 + 8 * c) = o; }
    LDS_WAIT();
}
__device__ __forceinline__ float wave_sum(float v) {
#pragma unroll
    for (int o = 1; o < 64; o <<= 1) v += __shfl_xor(v, o);
    return v;
}

__global__ void __launch_bounds__(NWAVES * 64, 2) fwd_kernel(Args args) {
    extern __shared__ __attribute__((aligned(16))) unsigned char lds_raw[];
    LAS unsigned char* lds = (LAS unsigned char*)lds_raw;
    volatile LAS unsigned* MISC = (volatile LAS unsigned*)(lds + MISC_OFF);
    const int G = gridDim.x, bx = blockIdx.x;
    const int vcu = (G % 8 == 0) ? (bx % 8) * (G / 8) + bx / 8 : bx;
    unsigned char* ws0 = args.ws;
    gu32* ctl = (gu32*)(ws0 + WS_CTL);
#define PHASE_LOCALS() \
    unsigned long long zero_ = 0ull; asm volatile("" : "+s"(zero_)); unsigned char* ws = ws0 + zero_; \
    int tid = threadIdx.x; asm volatile("" : "+v"(tid)); \
    const int lane = tid & 63, wave = __builtin_amdgcn_readfirstlane(tid >> 6); \
    const int gw = vcu * NWAVES + wave, NGW = G * NWAVES; \
    float* out = args.out; \
    bf16_t* hb = (bf16_t*)(ws + WS_HB); bf16_t* proj = (bf16_t*)(ws + WS_PROJ); bf16_t* merged = (bf16_t*)(ws + WS_MERGED); \
    bf16_t* hid = (bf16_t*)(ws + WS_HID); bf16_t* ybuf = (bf16_t*)(ws + WS_YBUF); float* rrow = (float*)(ws + WS_RROW); \
    unsigned* slot_of = (unsigned*)(ws + WS_SLOT); int* tok_list = (int*)(ws + WS_TOK); float* gate_list = (float*)(ws + WS_GATE); float* rs_list = (float*)(ws + WS_RS); \
    (void)lane; (void)wave; (void)gw; (void)NGW; (void)out; (void)hb; (void)proj; (void)merged; (void)hid; (void)ybuf; (void)rrow; (void)slot_of; (void)tok_list; (void)gate_list; (void)rs_list;

    if (threadIdx.x < 64) MISC[threadIdx.x] = 0u;
    __syncthreads();
#if MK_N_LAUNCHES == 1
    XcdBarrier bar = xcd_barrier_post((unsigned*)(ctl + CW_BAR), MISC + 40);
#define GRID_BAR() xcd_barrier(bar)
#else
#define GRID_BAR() do {} while (0)
#endif
    const int lo = args.ph_lo, hi_ph = args.ph_hi;
#ifndef PH_MASK
#define PH_MASK 0xff
#endif
#define IN(k) (lo <= (k) && (k) < hi_ph && ((PH_MASK >> ((k) == 0 ? 0 : (((k) - 1) % 7) + 1)) & 1))
#define BOTH(k) (IN(k) && IN((k) + 1))

    if (IN(0)) {
        PHASE_LOCALS();
        LAS float* scr = (LAS float*)(lds + wave * 16384);
        constexpr int I_IN = 16 * 96, I_OUT = 16 * 32, I_E = 256;
        constexpr int N_A = DEPTH * I_IN, N_B = DEPTH * I_OUT, N_C = DEPTH * NEXP * I_E;
        constexpr int NITEMS = N_A + N_B + 3 * N_C;
        for (int it = gw; it < NITEMS; it += NGW) {
            int r = it;
            if (r < N_A) { const int l = r / I_IN; transpose_item(args.in[I_WIN] + (size_t)l * DM * QKVW, DM, QKVW, args.in[I_ANORM] + l * DM, (bf16_t*)(ws + WS_WIN) + (size_t)l * QKVW * DM, 1, scr, r % I_IN, lane); continue; } r -= N_A;
            if (r < N_B) { const int l = r / I_OUT; transpose_item(args.in[I_WOUT] + (size_t)l * DM * DM, DM, DM, nullptr, (bf16_t*)(ws + WS_WOUT) + (size_t)l * DM * DM, 0, scr, r % I_OUT, lane); continue; } r -= N_B;
            const int which = r / N_C, r2 = r % N_C, le = r2 / I_E, item = r2 % I_E, l = le / NEXP;
            if (which == 0) transpose_item(args.in[I_WG] + (size_t)le * DM * DEXP, DM, DEXP, args.in[I_FNORM] + l * DM, (bf16_t*)(ws + WS_WGU) + (size_t)le * 1024 * DM, 2, scr, item, lane);
            else if (which == 1) transpose_item(args.in[I_WU] + (size_t)le * DM * DEXP, DM, DEXP, args.in[I_FNORM] + l * DM, (bf16_t*)(ws + WS_WGU) + (size_t)le * 1024 * DM, 3, scr, item, lane);
            else transpose_item(args.in[I_WD] + (size_t)le * DEXP * DM, DEXP, DM, nullptr, (bf16_t*)(ws + WS_WD) + (size_t)le * DM * DEXP, 0, scr, item, lane);
        }
        for (int i = (vcu * NWAVES * 64 + tid); i < DEPTH * 48 * 1024; i += G * NWAVES * 64) {
            const int l = i / (48 * 1024), n = (i / 1024) % 48, k = i % 1024;
            float w = 0.f;
            if (n < 4) w = args.in[I_RGW][((size_t)l * DM + k) * 4 + n]; else if (n < 36) w = args.in[I_REW][((size_t)l * DM + k) * 32 + (n - 4)];
            w *= args.in[I_FNORM][l * DM + k];
            const unsigned hb_ = f2bf(w); const float wl = w - __builtin_bit_cast(float, hb_ << 16);
            ((bf16_t*)(ws + WS_WRH))[i] = (bf16_t)hb_; ((bf16_t*)(ws + WS_WRL))[i] = (bf16_t)f2bf(wl);
        }
        const float* x = args.in[I_X];
        for (int row = gw; row < NTOK; row += NGW) {
            const f32x4* xr = (const f32x4*)(x + (size_t)row * DM) + lane; float ss = 0.f; u32x2* o8 = (u32x2*)(hb + (size_t)row * DM) + lane;
#pragma unroll
            for (int j = 0; j < 4; ++j) { const f32x4 v = xr[64 * j]; ss += (v[0] * v[0] + v[1] * v[1]) + (v[2] * v[2] + v[3] * v[3]); u32x2 w; w.x = pk2(v[0], v[1]); w.y = pk2(v[2], v[3]); o8[64 * j] = w; }
            ss = wave_sum(ss);
            if (lane == 0) rrow[row] = __builtin_amdgcn_rsqf(ss * (1.0f / DM) + EPS);
        }
        if (BOTH(0)) GRID_BAR();
    }

    for (int l = 0; l < DEPTH; ++l) {
        const int pb = 1 + 7 * l;
        const float lam_init = 0.8f - 0.6f * __expf(-0.3f * (float)l);
        const unsigned* cntl = (const unsigned*)(ctl + CW_CNT) + l * 32 * 64;
        if (IN(pb + 0)) {
            PHASE_LOCALS();
            pg8::DenseSched S; S.init(NTOK, QKVW, DM, (const bf16_t*)(ws + WS_WIN) + (size_t)l * QKVW * DM, G, bx);
            pg8::EpiWin E{proj, rrow, args.in[I_DQN] + l * 128, args.in[I_CQN] + l * 128};
            pg8::gemm_phase<pg8::EpiWin, pg8::DenseSched>(lds, hb, DM, S, E);
            if (BOTH(pb + 0)) GRID_BAR();
        }
        if (IN(pb + 1)) {
            PHASE_LOCALS();
            for (int P = vcu; P < 512; P += G) {
                const int bh = P >> 4, s = P & 15;
                attnB_unit(lds, proj, merged, args.in[I_T5], args.in[I_DLAM] + l * 256, args.in[I_DSUB] + l * 128, lam_init, bh >> 2, bh & 3, 31 - s);
                attnB_unit(lds, proj, merged, args.in[I_T5], args.in[I_DLAM] + l * 256, args.in[I_DSUB] + l * 128, lam_init, bh >> 2, bh & 3, s);
            }
            for (int U = vcu; U < 512; U += G) { const int bh = U >> 4; attnC_unit(lds, proj, merged, args.in[I_CRB] + l * 257 * 4, bh >> 2, bh & 3, U & 15); __syncthreads(); }
            for (int U = vcu; U < 512; U += G) { const int bh = U >> 4; attnA_unit(lds, proj, merged, bh >> 2, bh & 3, U & 15); }
            __syncthreads();
            if (BOTH(pb + 1)) GRID_BAR();
        }
        if (IN(pb + 2)) {
            PHASE_LOCALS();
            pg8::DenseSched S; S.init(NTOK, DM, DM, (const bf16_t*)(ws + WS_WOUT) + (size_t)l * DM * DM, G, bx);
            pg8::EpiWout E{l == 0 ? args.in[I_X] : (const float*)out, out};
            pg8::gemm_phase<pg8::EpiWout, pg8::DenseSched>(lds, merged, DM, S, E);
            if (BOTH(pb + 2)) GRID_BAR();
        }
        if (IN(pb + 3)) {
            PHASE_LOCALS();
            LAS float* lg = (LAS float*)lds;
            LAS float* rrl = (LAS float*)(lds + 128 * 49 * 4);
            LAS int* hist = (LAS int*)(lds + 128 * 49 * 4 + 512);
            const bf16_t* wrh = (const bf16_t*)(ws + WS_WRH) + (size_t)l * 48 * 1024;
            const bf16_t* wrl = (const bf16_t*)(ws + WS_WRL) + (size_t)l * 48 * 1024;
            const float* rgb = args.in[I_RGB] + l * 4; const float* reb = args.in[I_REB] + l * 32;
            const int fr = lane & 15, fq = lane >> 4;
            for (int chunk = vcu; chunk < NTOK / 128; chunk += G) {
                if (tid < 32) hist[tid] = 0;
                const int row = chunk * 128 + wave * 16 + fr;
                const float* hp = out + (size_t)row * DM + 8 * fq;
                f32x4 acc[3]; acc[0] = acc[1] = acc[2] = (f32x4){0.f, 0.f, 0.f, 0.f};
                float ss = 0.f;
#pragma unroll 2
                for (int k0 = 0; k0 < DM; k0 += 32) {
                    const f32x4 x0 = *(const f32x4*)(hp + k0), x1 = *(const f32x4*)(hp + k0 + 4);
                    ss += (x0[0] * x0[0] + x0[1] * x0[1]) + (x0[2] * x0[2] + x0[3] * x0[3]) + (x1[0] * x1[0] + x1[1] * x1[1]) + (x1[2] * x1[2] + x1[3] * x1[3]);
                    u32x4 ah; ah.x = pk2(x0[0], x0[1]); ah.y = pk2(x0[2], x0[3]); ah.z = pk2(x1[0], x1[1]); ah.w = pk2(x1[2], x1[3]);
                    u32x4 al; al.x = pk2(x0[0] - bflo(ah.x), x0[1] - bfhi(ah.x)); al.y = pk2(x0[2] - bflo(ah.y), x0[3] - bfhi(ah.y));
                    al.z = pk2(x1[0] - bflo(ah.z), x1[1] - bfhi(ah.z)); al.w = pk2(x1[2] - bflo(ah.w), x1[3] - bfhi(ah.w));
                    *(u32x4*)(hb + (size_t)row * DM + k0 + 8 * fq) = ah;
                    const bf16x8 aH = __builtin_bit_cast(bf16x8, ah), aL = __builtin_bit_cast(bf16x8, al);
#pragma unroll
                    for (int cbk = 0; cbk < 3; ++cbk) {
                        const bf16x8 bH = *(const bf16x8*)(wrh + (size_t)(cbk * 16 + fr) * DM + k0 + 8 * fq), bL = *(const bf16x8*)(wrl + (size_t)(cbk * 16 + fr) * DM + k0 + 8 * fq);
                        acc[cbk] = __builtin_amdgcn_mfma_f32_16x16x32_bf16(aH, bH, acc[cbk], 0, 0, 0);
                        acc[cbk] = __builtin_amdgcn_mfma_f32_16x16x32_bf16(aH, bL, acc[cbk], 0, 0, 0);
                        acc[cbk] = __builtin_amdgcn_mfma_f32_16x16x32_bf16(aL, bH, acc[cbk], 0, 0, 0);
                    }
                }
                ss += __shfl_xor(ss, 16); ss += __shfl_xor(ss, 32);
                if (fq == 0) rrl[wave * 16 + fr] = __builtin_amdgcn_rsqf(ss * (1.0f / DM) + EPS);
#pragma unroll
                for (int cbk = 0; cbk < 3; ++cbk)
#pragma unroll
                    for (int rg = 0; rg < 4; ++rg) lg[(wave * 16 + 4 * fq + rg) * 49 + cbk * 16 + fr] = acc[cbk][rg];
                __syncthreads();
                int e1 = 0, e2 = 0, lr1 = 0, lr2 = 0; float g1 = 0.f, g2 = 0.f, rr = 0.f;
                if (tid < 128) {
                    rr = rrl[tid];
                    const LAS float* lp = lg + tid * 49;
                    float gl[4]; int gs = 0; float gmax = -3.0e38f;
#pragma unroll
                    for (int i = 0; i < 4; ++i) { gl[i] = lp[i] * rr + rgb[i]; if (gl[i] > gmax) { gmax = gl[i]; gs = i; } }
                    float den = 0.f;
#pragma unroll
                    for (int i = 0; i < 4; ++i) den += __expf(gl[i] - gmax);
                    const float gwt = 1.0f / den;
                    float el[8]; int i1 = 0; float m1 = -3.0e38f;
#pragma unroll
                    for (int i = 0; i < 8; ++i) { el[i] = lp[4 + gs * 8 + i] * rr + reb[gs * 8 + i]; if (el[i] > m1) { m1 = el[i]; i1 = i; } }
                    int i2 = 0; float m2 = -3.0e38f;
#pragma unroll
                    for (int i = 0; i < 8; ++i) { if (i != i1 && el[i] > m2) { m2 = el[i]; i2 = i; } }
                    const float ex = __expf(m2 - m1), p1 = 1.0f / (1.0f + ex), p2 = ex * p1;
                    g1 = gwt * p1; g2 = gwt * p2; e1 = gs * 8 + i1; e2 = gs * 8 + i2;
                    lr1 = __hip_atomic_fetch_add(&hist[e1], 1, __ATOMIC_RELAXED, __HIP_MEMORY_SCOPE_WORKGROUP); lr2 = __hip_atomic_fetch_add(&hist[e2], 1, __ATOMIC_RELAXED, __HIP_MEMORY_SCOPE_WORKGROUP);
                }
                __syncthreads();
                if (tid < 32) { const int c_ = hist[tid]; hist[32 + tid] = c_ ? (int)__hip_atomic_fetch_add((unsigned*)cntl + 64 * tid, (unsigned)c_, __ATOMIC_RELAXED, __HIP_MEMORY_SCOPE_AGENT) : 0; }
                __syncthreads();
                if (tid < 128) {
                    const int tok = chunk * 128 + tid;
                    const int pos1 = hist[32 + e1] + lr1, pos2 = hist[32 + e2] + lr2;
                    tok_list[e1 * ECAP + pos1] = tok; gate_list[e1 * ECAP + pos1] = g1; rs_list[e1 * ECAP + pos1] = rr;
                    tok_list[e2 * ECAP + pos2] = tok; gate_list[e2 * ECAP + pos2] = g2; rs_list[e2 * ECAP + pos2] = rr;
                    slot_of[tok * 2] = ((unsigned)e1 << 16) | (unsigned)pos1; slot_of[tok * 2 + 1] = ((unsigned)e2 << 16) | (unsigned)pos2;
                }
                __syncthreads();
            }
            if (BOTH(pb + 3)) GRID_BAR();
        }
        if (IN(pb + 4) || IN(pb + 5) || IN(pb + 6)) {
            if (threadIdx.x == 0) { int s_ = 0; for (int e = 0; e < 32; ++e) { MISC[e] = (unsigned)s_; s_ += ((int)ld_agent(cntl + 64 * e) + 255) >> 8; } MISC[32] = (unsigned)s_; }
            __syncthreads();
        }
        if (IN(pb + 4)) {
            PHASE_LOCALS();
            pg8::MoeSched<true> S{(const volatile LAS int*)MISC, cntl, tok_list, (const bf16_t*)(ws + WS_WGU) + (size_t)l * NEXP * 1024 * DM, DM, G, bx};
            pg8::EpiGU E{hid, rs_list};
            pg8::gemm_phase<pg8::EpiGU, pg8::MoeSched<true>>(lds, hb, DM, S, E);
            if (BOTH(pb + 4)) GRID_BAR();
        }
        if (IN(pb + 5)) {
            PHASE_LOCALS();
            pg8::MoeSched<false> S{(const volatile LAS int*)MISC, cntl, tok_list, (const bf16_t*)(ws + WS_WD) + (size_t)l * NEXP * DM * DEXP, DEXP, G, bx};
            pg8::EpiDown E{ybuf, gate_list};
            pg8::gemm_phase<pg8::EpiDown, pg8::MoeSched<false>>(lds, hid, DEXP, S, E);
            if (BOTH(pb + 5)) GRID_BAR();
        }
        if (IN(pb + 6)) {
            PHASE_LOCALS();
            for (int row = gw; row < NTOK; row += NGW) {
                const unsigned s0 = ld_agent(slot_of + row * 2), s1 = ld_agent(slot_of + row * 2 + 1);
                const size_t y0 = (size_t)(MISC[s0 >> 16] * 256u + (s0 & 0xffffu)), y1 = (size_t)(MISC[s1 >> 16] * 256u + (s1 & 0xffffu));
                f32x4* hr = (f32x4*)(out + (size_t)row * DM) + lane;
                const u32x2* ya = (const u32x2*)(ybuf + y0 * DM) + lane; const u32x2* yb = (const u32x2*)(ybuf + y1 * DM) + lane;
                u32x2* o8 = (u32x2*)(hb + (size_t)row * DM) + lane;
                float ss = 0.f;
#pragma unroll
                for (int j = 0; j < 4; ++j) { f32x4 v = hr[64 * j]; const u32x2 a = ya[64 * j], b2 = yb[64 * j];
                    v[0] += bflo(a.x) + bflo(b2.x); v[1] += bfhi(a.x) + bfhi(b2.x); v[2] += bflo(a.y) + bflo(b2.y); v[3] += bfhi(a.y) + bfhi(b2.y);
                    hr[64 * j] = v; ss += (v[0] * v[0] + v[1] * v[1]) + (v[2] * v[2] + v[3] * v[3]);
                    u32x2 w; w.x = pk2(v[0], v[1]); w.y = pk2(v[2], v[3]); o8[64 * j] = w; }
                ss = wave_sum(ss);
                if (lane == 0) rrow[row] = __builtin_amdgcn_rsqf(ss * (1.0f / DM) + EPS);
            }
            if (BOTH(pb + 6)) GRID_BAR();
        }
    }
#undef IN
#undef BOTH
}

extern "C" void kernel_launch(void* const* d_in, const int* in_sizes, int n_in, void* d_out, int out_size, void* d_ws, size_t ws_size, hipStream_t stream) {
    static int grid = 0;
    if (grid == 0) {
        if (n_in != 18 || out_size != NTOK * DM || ws_size < WS_END) { fprintf(stderr, "kernel_launch: unexpected shapes (n_in %d, out %d, ws %zu < %zu)\n", n_in, out_size, ws_size, (size_t)WS_END); grid = -1; return; }
        int dev = 0, cus = 0, per_cu = 0;
        if (hipGetDevice(&dev) != hipSuccess || hipDeviceGetAttribute(&cus, hipDeviceAttributeMultiprocessorCount, dev) != hipSuccess) { grid = -1; return; }
        if (hipFuncSetAttribute((const void*)fwd_kernel, hipFuncAttributeMaxDynamicSharedMemorySize, LDS_BYTES) != hipSuccess) { fprintf(stderr, "kernel_launch: hipFuncSetAttribute failed\n"); grid = -1; return; }
        if (hipOccupancyMaxActiveBlocksPerMultiprocessor(&per_cu, (const void*)fwd_kernel, NWAVES * 64, LDS_BYTES) != hipSuccess || per_cu < 1) fprintf(stderr, "kernel_launch: occupancy query says %d\n", per_cu);
        (void)hipGetLastError();
        grid = cus;
    }
    if (grid < 0) return;
    if (hipMemsetAsync((char*)d_ws + WS_CTL, 0, CTL_ZERO_BYTES, stream) != hipSuccess) return;
    Args a{};
    for (int i = 0; i < 18; ++i) a.in[i] = (const float*)d_in[i];
    a.out = (float*)d_out; a.ws = (unsigned char*)d_ws;
#if MK_N_LAUNCHES == 1
    a.ph_lo = 0; a.ph_hi = NPHASES;
    hipLaunchKernelGGL(fwd_kernel, dim3(grid), dim3(NWAVES * 64), LDS_BYTES, stream, a);
#else
    for (int p = 0; p < NPHASES; ++p) { a.ph_lo = p; a.ph_hi = p + 1; hipLaunchKernelGGL(fwd_kernel, dim3(grid), dim3(NWAVES * 64), LDS_BYTES, stream, a); }
#endif
}
```

```cpp
#include <hip/hip_runtime.h>
#include <cstdio>
#include <cstdint>

#ifndef MK_N_LAUNCHES
#define MK_N_LAUNCHES 1
#endif

#define LAS __attribute__((address_space(3)))
#define GAS __attribute__((address_space(1)))
typedef unsigned short bf16_t;
typedef short bf16x8 __attribute__((ext_vector_type(8)));
typedef short v4i16 __attribute__((ext_vector_type(4)));
typedef float f32x4 __attribute__((ext_vector_type(4)));
typedef float f32x16 __attribute__((ext_vector_type(16)));
typedef unsigned u32x4 __attribute__((ext_vector_type(4)));
typedef unsigned u32x2 __attribute__((ext_vector_type(2)));
typedef float f32x2_t __attribute__((ext_vector_type(2)));
typedef __bf16 bf16x2_t __attribute__((ext_vector_type(2)));
typedef GAS unsigned gu32;

constexpr int DM = 1024, BATCH = 8, SEQ = 4096, NTOK = BATCH * SEQ, DEPTH = 2;
constexpr int QKVW = 3072, NEXP = 32, DEXP = 512, ECAP = 32768;
constexpr int MAXROWS = 73728;
constexpr float EPS = 1e-6f;
constexpr float LOG2E = 1.4426950408889634f;
constexpr float QSCALE = 0.125f * LOG2E;
constexpr int NWAVES = 8;
constexpr int NPHASES = 1 + 7 * DEPTH;

constexpr size_t MiB = 1u << 20;
constexpr size_t WS_CTL = 0, CTL_ZERO_BYTES = 1 * MiB;
constexpr size_t WS_WIN = 1 * MiB;
constexpr size_t WS_WOUT = 13 * MiB;
constexpr size_t WS_WGU = 17 * MiB;
constexpr size_t WS_WD = 145 * MiB;
constexpr size_t WS_WRH = 209 * MiB;
constexpr size_t WS_WRL = WS_WRH + 256 * 1024;
constexpr size_t WS_RROW = 210 * MiB;
constexpr size_t WS_SLOT = WS_RROW + 256 * 1024;
constexpr size_t WS_TOK = 211 * MiB;
constexpr size_t WS_GATE = 215 * MiB;
constexpr size_t WS_RS = 219 * MiB;
constexpr size_t WS_HB = 223 * MiB;
constexpr size_t WS_R = 287 * MiB;
constexpr size_t WS_PROJ = WS_R, WS_MERGED = WS_R + 192 * MiB;
constexpr size_t WS_HID = WS_R;
constexpr size_t WS_YBUF = WS_R + 72 * MiB;
constexpr size_t WS_END = 543 * MiB;
constexpr int CW_BAR = 4096;
constexpr int CW_CNT = 16384;

constexpr int RING_BYTES = 131072;
constexpr int MISC_OFF = RING_BYTES;
constexpr int TB_OFF = RING_BYTES + 1024;
constexpr int LDS_BYTES = 147456;

__device__ __forceinline__ unsigned f2bf(float f) { unsigned u = __builtin_bit_cast(unsigned, f); return (u + 0x7fffu + ((u >> 16) & 1u)) >> 16; }
__device__ __forceinline__ unsigned pk2(float lo, float hi) { f32x2_t v = {lo, hi}; bf16x2_t b = __builtin_convertvector(v, bf16x2_t); return __builtin_bit_cast(unsigned, b); }
__device__ __forceinline__ float bflo(unsigned w) { return __builtin_bit_cast(float, w << 16); }
__device__ __forceinline__ float bfhi(unsigned w) { return __builtin_bit_cast(float, w & 0xffff0000u); }
__device__ __forceinline__ unsigned ld_agent(const unsigned* p) { return __hip_atomic_load(p, __ATOMIC_RELAXED, __HIP_MEMORY_SCOPE_AGENT); }
#define LDS_WAIT() asm volatile("s_waitcnt lgkmcnt(0)" ::: "memory")

#define XB_TMO      128
#define XB_XCNT(j)  (256  + 64 * (j))
#define XB_XSUB(j)  (1280 + 64 * (j))
#define XB_XGEN(j)  (2304 + 64 * (j))
#define XB_TOP      3328
#define XB_TOPGEN   3392
#define XCD_BAR_WORDS 3456
#define XB_SPIN_CAP (1u << 18)
__device__ __forceinline__ unsigned xb_ld(unsigned* p)              { return __hip_atomic_load(p, __ATOMIC_RELAXED, __HIP_MEMORY_SCOPE_AGENT); }
__device__ __forceinline__ unsigned xb_add(unsigned* p, unsigned v) { return __hip_atomic_fetch_add(p, v, __ATOMIC_RELAXED, __HIP_MEMORY_SCOPE_AGENT); }
__device__ __forceinline__ unsigned xb_xcc_id() { return (unsigned)__builtin_amdgcn_s_getreg((3 << 11) | 20) & 0xFu; }
#define XB_SPIN(cond, bar) do { unsigned _sp = 0; while (cond) { __builtin_amdgcn_s_sleep(1); \
    if ((++_sp & 255u) == 0u) { if (xb_ld(&(bar)[XB_TMO])) break; if (_sp > XB_SPIN_CAP) { atomicAdd(&(bar)[XB_TMO], 1u); break; } } } } while (0)
struct XcdBarrier { unsigned* bar; unsigned x; volatile LAS unsigned* st; };
__device__ __forceinline__ XcdBarrier xcd_barrier_post(unsigned* bar, volatile LAS unsigned* st) {
    XcdBarrier b; b.bar = bar; b.x = xb_xcc_id(); b.st = st;
    if (threadIdx.x == 0) (void)xb_add(&bar[XB_XCNT(b.x)], 1u);
    return b;
}
__device__ __forceinline__ void xcd_barrier_complete(unsigned* bar, unsigned x, unsigned& nloc, unsigned& nx) {
    const unsigned G = gridDim.x * gridDim.y * gridDim.z;
    unsigned sum, cnt, mine, sp = 0u;
    for (;;) {
        sum = 0u; cnt = 0u; mine = 0u;
#pragma unroll
        for (unsigned j = 0; j < 16; ++j) { const unsigned c = xb_ld(&bar[XB_XCNT(j)]); sum += c; cnt += (c > 0u) ? 1u : 0u; mine = (j == x) ? c : mine; }
        if (sum == G) break;
        __builtin_amdgcn_s_sleep(1);
        if ((++sp & 255u) == 0u) { if (xb_ld(&bar[XB_TMO])) break; if (sp > XB_SPIN_CAP) { atomicAdd(&bar[XB_TMO], 1u); break; } }
    }
    nloc = mine > 0u ? mine : 1u; nx = cnt > 0u ? cnt : 1u;
}
__device__ __forceinline__ void xcd_barrier(const XcdBarrier& b) {
    asm volatile("s_waitcnt vmcnt(0)" ::: "memory");
    __syncthreads();
    if (threadIdx.x == 0) {
        unsigned* bar = b.bar;
        __builtin_amdgcn_s_waitcnt(0);
        unsigned nloc = b.st[0], nx = b.st[1];
        if (nloc == 0u) { xcd_barrier_complete(bar, b.x, nloc, nx); b.st[0] = nloc; b.st[1] = nx; }
        const unsigned old = xb_add(&bar[XB_XSUB(b.x)], 1u);
        const unsigned gen = old / nloc;
        if (old + 1u == (gen + 1u) * nloc) {
            __builtin_amdgcn_fence(__ATOMIC_RELEASE, "agent");
            asm volatile("s_waitcnt vmcnt(0)" ::: "memory");
            const unsigned og = xb_add(&bar[XB_TOP], 1u);
            const unsigned tg = og / nx;
            if (og + 1u == (tg + 1u) * nx) xb_add(&bar[XB_TOPGEN], 1u);
            else XB_SPIN(xb_ld(&bar[XB_TOPGEN]) == tg, bar);
            __builtin_amdgcn_fence(__ATOMIC_ACQUIRE, "agent");
            xb_add(&bar[XB_XGEN(b.x)], 1u);
            asm volatile("s_waitcnt vmcnt(0)" ::: "memory");
        } else {
            XB_SPIN(xb_ld(&bar[XB_XGEN(b.x)]) == gen, bar);
            __builtin_amdgcn_fence(__ATOMIC_ACQUIRE, "agent");
            asm volatile("s_waitcnt vmcnt(0)" ::: "memory");
        }
    }
    __syncthreads();
}

namespace pg8 {
constexpr int BM = 256, BK = 64, HALF = 128, HTB = HALF * BK * 2, STAGE_BYTES = 8 * HTB, NXCD = 8, WGM = 8;
__device__ __forceinline__ int lds_byte(int r, int c) { const int st = (r >> 4) * 2 + (c >> 5), rr = r & 15, cc = c & 31, ob = rr * 64 + cc * 2; return st * 1024 + (ob ^ (((ob >> 9) & 1) << 5)); }
__device__ __forceinline__ void stage_rc(int b, int& R, int& C) { const int st = b / 1024, sb = b % 1024, swz = sb ^ (((sb >> 9) & 1) << 5); R = (st >> 1) * 16 + swz / 64; C = (st & 1) * 32 + (swz % 64) / 2; }
__device__ __forceinline__ int perm32(int rho) { const int n = rho >> 4, i = rho & 15; return 8 * (i >> 2) + 4 * n + (i & 3); }

struct Unit { int pm, pn, e, t0, cnt; };

struct DenseSched {
    static constexpr bool GATHER = false;
    int nM, nN, nwg, G, c, K; const bf16_t* Bt;
    __device__ void init(int M, int N, int K_, const bf16_t* Bt_, int G_, int c_) { nM = M / BM; nN = N / BM; nwg = nM * nN; G = G_; c = c_; K = K_; Bt = Bt_; }
    __device__ __forceinline__ bool next(int i, Unit& u) const {
        const long L = (long)i * G + c; if (L >= nwg) return false;
        int wgid = (int)L; { const int q = nwg / NXCD, r = nwg % NXCD, xcd = wgid % NXCD, off = wgid / NXCD; wgid = (xcd < r ? xcd * (q + 1) : r * (q + 1) + (xcd - r) * q) + off; }
        const int nig = WGM * nN, gid = wgid / nig, fm = gid * WGM, gsz = (nM - fm) < WGM ? (nM - fm) : WGM;
        u.pm = fm + ((wgid % nig) % gsz); u.pn = (wgid % nig) / gsz; u.e = 0; u.t0 = 0; u.cnt = 0; return true;
    }
    __device__ __forceinline__ int arow(const Unit& u, int r) const { return u.pm * BM + r; }
    __device__ __forceinline__ const bf16_t* bptr(const Unit& u) const { return Bt + (size_t)u.pn * BM * K; }
};
template <bool GATHER_> struct MoeSched {
    static constexpr bool GATHER = GATHER_;
    const volatile LAS int* pre; const unsigned* cnt; const int* tok; const bf16_t* W; int K, G, c;
    __device__ __forceinline__ bool next(int i, Unit& u) const {
        const int L = i * G + c, T = L >> 2; const int ntile = __builtin_amdgcn_readfirstlane(pre[32]);
        if (T >= ntile) return false;
        int e = 0; while (__builtin_amdgcn_readfirstlane(pre[e + 1]) <= T) ++e;
        u.e = e; u.pm = T; u.pn = L & 3; u.t0 = (T - __builtin_amdgcn_readfirstlane(pre[e])) * BM; u.cnt = __builtin_amdgcn_readfirstlane((int)ld_agent(cnt + 64 * e)); return true;
    }
    __device__ __forceinline__ int arow(const Unit& u, int r) const {
        if (GATHER_) { const int pos = u.t0 + r; return pos < u.cnt ? tok[u.e * ECAP + pos] : 0; }
        return u.pm * BM + r;
    }
    __device__ __forceinline__ const bf16_t* bptr(const Unit& u) const { return W + ((size_t)u.e * 1024 + (size_t)u.pn * BM) * K; }
};

template <class Epi, class Sched>
__device__ __forceinline__ void gemm_phase(LAS unsigned char* lds, const bf16_t* Abase_, int K, const Sched& S, const Epi& E) {
    int tid = threadIdx.x; asm volatile("" : "+v"(tid));
    const int wid = __builtin_amdgcn_readfirstlane(tid >> 6), lane = tid & 63, wr = wid >> 2, wc = wid & 3, fr = lane & 15, fq = lane >> 4;
    constexpr bool GATHER = Sched::GATHER;
    const int nt = K / BK;
    int Rs[2], Cs[2]; unsigned voffA[2], voffB[2];
#pragma unroll
    for (int i = 0; i < 2; ++i) { int R, C; stage_rc(tid * 16 + i * 8192, R, C); Rs[i] = R; Cs[i] = C; const int Rb = Epi::PERM ? ((R & ~31) + perm32(R & 31)) : R;
        voffA[i] = (unsigned)(R * K + C) * 2u; voffB[i] = (unsigned)(Rb * K + C) * 2u; }
    const size_t kstep = (size_t)(BK * 2);
    const size_t hstep = (size_t)HALF * K * 2;
    const unsigned ldsw = (unsigned)wid * 1024u;
    const char* Abase = (const char*)Abase_;
    const int aoff = lds_byte(wr * 64 + fr, fq * 8), boff = lds_byte(wc * 32 + fr, fq * 8);
#define PG8_SA(b, h) (((b) * 2 + (h)) * HTB)
#define PG8_SB(b, h) ((4 + (b) * 2 + (h)) * HTB)
#define PG8_STAGE(bufoff, gbase, v0, v1) do { \
        __builtin_amdgcn_global_load_lds((const unsigned*)((const char*)(gbase) + (v0)), (LAS unsigned*)(lds + (bufoff) + ldsw), 16, 0, 0); \
        __builtin_amdgcn_global_load_lds((const unsigned*)((const char*)(gbase) + (v1)), (LAS unsigned*)(lds + (bufoff) + ldsw + 8192), 16, 0, 0); } while (0)
#define PG8_STAGE_AC(bufoff, h, koff) do { if constexpr (GATHER) PG8_STAGE(bufoff, Abase + (koff), cA[h][0], cA[h][1]); else PG8_STAGE(bufoff, cAp + (h) * hstep + (koff), voffA[0], voffA[1]); } while (0)
#define PG8_STAGE_AX(bufoff, h, koff) do { if constexpr (GATHER) PG8_STAGE(bufoff, a2p + (koff), (h) ? x10 : x00, (h) ? x11 : x01); else PG8_STAGE(bufoff, a2p + (h) * hstep + (koff), voffA[0], voffA[1]); } while (0)
#define PG8_STAGE_B(bufoff, gbase) PG8_STAGE(bufoff, gbase, voffB[0], voffB[1])
#define PG8_LDA(dst, b, h) do { _Pragma("unroll") for (int m = 0; m < 4; ++m) _Pragma("unroll") for (int k = 0; k < 2; ++k) dst[m][k] = *(const LAS bf16x8*)(lds + PG8_SA(b, h) + aoff + m * 2048 + k * 1024); } while (0)
#define PG8_LDB(dst, b, h) do { _Pragma("unroll") for (int n = 0; n < 2; ++n) _Pragma("unroll") for (int k = 0; k < 2; ++k) dst[n][k] = *(const LAS bf16x8*)(lds + PG8_SB(b, h) + boff + n * 2048 + k * 1024); } while (0)
#define PG8_MMA(ai, bj, At, Bt) do { __builtin_amdgcn_s_setprio(1); _Pragma("unroll") for (int m = 0; m < 4; ++m) _Pragma("unroll") for (int n = 0; n < 2; ++n) _Pragma("unroll") for (int k = 0; k < 2; ++k) \
        acc[ai][bj][m][n] = __builtin_amdgcn_mfma_f32_16x16x32_bf16(Bt[n][k], At[m][k], acc[ai][bj][m][n], 0, 0, 0); __builtin_amdgcn_s_setprio(0); } while (0)
#define PG8_WAIT_V(n) asm volatile("s_waitcnt vmcnt(" #n ")" ::: "memory")
#define PG8_WAIT_L(n) asm volatile("s_waitcnt lgkmcnt(" #n ")" ::: "memory")
#define PG8_BAR __builtin_amdgcn_s_barrier()
#define PG8_SCHED __builtin_amdgcn_sched_barrier(0)
#define PG8_MKA(dst, u) do { _Pragma("unroll") for (int h_ = 0; h_ < 2; ++h_) _Pragma("unroll") for (int i_ = 0; i_ < 2; ++i_) dst[h_][i_] = ((unsigned)S.arow(u, h_ * HALF + Rs[i_]) * (unsigned)K + (unsigned)Cs[i_]) * 2u; } while (0)
    Unit cur, nxt; int ui = 0;
    if (!S.next(0, cur)) return;
    f32x4 acc[2][2][4][2];
#pragma unroll
    for (int a = 0; a < 2; ++a)
#pragma unroll
        for (int b = 0; b < 2; ++b)
#pragma unroll
            for (int m = 0; m < 4; ++m)
#pragma unroll
                for (int n = 0; n < 2; ++n) acc[a][b][m][n] = (f32x4){0.f, 0.f, 0.f, 0.f};
    bf16x8 At[4][2], B0[2][2], B1[2][2];
    unsigned cA[2][2] = {{0u, 0u}, {0u, 0u}}, nA[2][2] = {{0u, 0u}, {0u, 0u}};
    const char* cAp = Abase; const char* nAp = Abase;
    if constexpr (GATHER) { PG8_MKA(cA, cur); } else { cAp = Abase + (size_t)S.arow(cur, 0) * K * 2; }
    const char* cB = (const char*)S.bptr(cur);
    PG8_STAGE_B(PG8_SB(0, 0), cB); PG8_STAGE_B(PG8_SB(0, 1), cB + hstep); PG8_STAGE_AC(PG8_SA(0, 0), 0, 0); PG8_STAGE_AC(PG8_SA(0, 1), 1, 0);
    if (wr == 1) PG8_BAR;
    PG8_WAIT_V(2); PG8_BAR;
    PG8_STAGE_B(PG8_SB(1, 0), cB + kstep); PG8_STAGE_AC(PG8_SA(1, 0), 0, kstep); PG8_STAGE_B(PG8_SB(1, 1), cB + hstep + kstep);
    PG8_WAIT_V(6); PG8_BAR;
    for (;;) {
        const bool has_next = S.next(ui + 1, nxt);
        const char* nB = cB; nAp = cAp;
        if (has_next) { nB = (const char*)S.bptr(nxt); if constexpr (GATHER) { PG8_MKA(nA, nxt); } else { nAp = Abase + (size_t)S.arow(nxt, 0) * K * 2; } }
        else { if constexpr (GATHER) {
#pragma unroll
            for (int h_ = 0; h_ < 2; ++h_)
#pragma unroll
                for (int i_ = 0; i_ < 2; ++i_) nA[h_][i_] = cA[h_][i_]; } }
        for (int t = 0; t < nt; t += 2) {
            const bool last = (t == nt - 2);
            const size_t k1 = (size_t)(t + 1) * kstep, k2 = last ? (size_t)0 : (size_t)(t + 2) * kstep;
            const char* a2p = (GATHER ? Abase : (last ? nAp : cAp)) + k2; const char* b2 = (last ? nB : cB) + k2;
            const char* b3 = b2 + kstep;
            const unsigned x00 = last ? nA[0][0] : cA[0][0], x01 = last ? nA[0][1] : cA[0][1], x10 = last ? nA[1][0] : cA[1][0], x11 = last ? nA[1][1] : cA[1][1];
            PG8_LDB(B0, 0, 0); PG8_LDB(B1, 0, 1); PG8_SCHED; PG8_LDA(At, 0, 0); PG8_STAGE_AC(PG8_SA(1, 1), 1, k1);
            PG8_WAIT_V(8); PG8_WAIT_L(0); PG8_BAR; PG8_MMA(0, 0, At, B0); PG8_MMA(0, 1, At, B1); PG8_BAR; PG8_SCHED;
            PG8_LDA(At, 0, 1); PG8_STAGE_B(PG8_SB(0, 0), b2); PG8_STAGE_B(PG8_SB(0, 1), b2 + hstep); PG8_STAGE_AX(PG8_SA(0, 0), 0, 0);
            PG8_WAIT_V(8); PG8_WAIT_L(0); PG8_BAR; PG8_MMA(1, 0, At, B0); PG8_MMA(1, 1, At, B1); PG8_BAR; PG8_SCHED;
            PG8_LDB(B0, 1, 0); PG8_LDB(B1, 1, 1); PG8_SCHED; PG8_LDA(At, 1, 0); PG8_STAGE_AX(PG8_SA(0, 1), 1, 0);
            PG8_WAIT_V(8); PG8_WAIT_L(0); PG8_BAR; PG8_MMA(0, 0, At, B0); PG8_MMA(0, 1, At, B1); PG8_BAR; PG8_SCHED;
            PG8_LDA(At, 1, 1); PG8_STAGE_B(PG8_SB(1, 0), b3); PG8_STAGE_B(PG8_SB(1, 1), b3 + hstep); PG8_STAGE_AX(PG8_SA(1, 0), 0, kstep);
            PG8_WAIT_V(8); PG8_WAIT_L(0); PG8_BAR; PG8_MMA(1, 0, At, B0); PG8_MMA(1, 1, At, B1); PG8_BAR; PG8_SCHED;
        }
        if (wr == 0) PG8_BAR;
        E(acc, cur, wr, wc, fr, fq);
        if (!has_next) break;
#pragma unroll
        for (int a = 0; a < 2; ++a)
#pragma unroll
            for (int b = 0; b < 2; ++b)
#pragma unroll
                for (int m = 0; m < 4; ++m)
#pragma unroll
                    for (int n = 0; n < 2; ++n) acc[a][b][m][n] = (f32x4){0.f, 0.f, 0.f, 0.f};
        cur = nxt; cB = nB; cAp = nAp; ++ui;
        if constexpr (GATHER) {
#pragma unroll
        for (int h_ = 0; h_ < 2; ++h_)
#pragma unroll
            for (int i_ = 0; i_ < 2; ++i_) cA[h_][i_] = nA[h_][i_]; }
        if (wr == 1) PG8_BAR;
    }
    PG8_WAIT_V(0);
    PG8_BAR;
#undef PG8_SA
#undef PG8_SB
#undef PG8_STAGE
#undef PG8_STAGE_AC
#undef PG8_STAGE_AX
#undef PG8_STAGE_B
#undef PG8_LDA
#undef PG8_LDB
#undef PG8_MMA
#undef PG8_WAIT_V
#undef PG8_WAIT_L
#undef PG8_BAR
#undef PG8_SCHED
#undef PG8_MKA
}

struct EpiWin {
    static constexpr bool PERM = true;
    bf16_t* proj; const float* rrow; const float* dqn; const float* cqn;
    __device__ __forceinline__ void operator()(const f32x4 (&acc)[2][2][4][2], const Unit& u, int wr, int wc, int fr, int fq) const {
        const int pn = u.pn;
        const float* g = nullptr;
        if (pn == 3 || pn == 4) g = dqn; else if (pn == 5 || pn == 6) g = dqn + 64; else if (pn == 9) g = cqn; else if (pn == 10) g = cqn + 64;
        const float qs = (pn == 0 || pn == 3 || pn == 4 || pn == 9) ? QSCALE : 1.0f;
        f32x4 gv[2][2];
#pragma unroll
        for (int bj = 0; bj < 2; ++bj)
#pragma unroll
            for (int n = 0; n < 2; ++n) { f32x4 t = g ? *(const f32x4*)(g + 32 * bj + 8 * fq + 4 * n) : (f32x4){1.f, 1.f, 1.f, 1.f}; gv[bj][n] = t * qs; }
        const bool donorm = (g != nullptr);
#pragma unroll
        for (int ai = 0; ai < 2; ++ai)
#pragma unroll
            for (int m = 0; m < 4; ++m) {
                const int row = u.pm * BM + ai * HALF + wr * 64 + m * 16 + fr;
                const float rs = rrow[row];
                f32x4 v[2][2]; float ss = 0.f;
#pragma unroll
                for (int bj = 0; bj < 2; ++bj)
#pragma unroll
                    for (int n = 0; n < 2; ++n) { v[bj][n] = acc[ai][bj][m][n] * rs; const f32x4 q = v[bj][n] * v[bj][n]; ss += (q[0] + q[1]) + (q[2] + q[3]); }
                float rn = 1.0f;
                if (donorm) { ss += __shfl_xor(ss, 16); ss += __shfl_xor(ss, 32); rn = __builtin_amdgcn_rsqf(ss * (1.0f / 64.0f) + EPS); }
                bf16_t* rowp = proj + (size_t)row * QKVW + pn * BM + 64 * wc + 8 * fq;
#pragma unroll
                for (int bj = 0; bj < 2; ++bj) { const f32x4 a = v[bj][0] * rn * gv[bj][0], b = v[bj][1] * rn * gv[bj][1];
                    u32x4 w; w.x = pk2(a[0], a[1]); w.y = pk2(a[2], a[3]); w.z = pk2(b[0], b[1]); w.w = pk2(b[2], b[3]);
                    *(u32x4*)(rowp + 32 * bj) = w; }
            }
    }
};
struct EpiWout {
    static constexpr bool PERM = false;
    const float* hin; float* out;
    __device__ __forceinline__ void operator()(const f32x4 (&acc)[2][2][4][2], const Unit& u, int wr, int wc, int fr, int fq) const {
        const int col0 = u.pn * BM + wc * 32 + 4 * fq;
#pragma unroll
        for (int ai = 0; ai < 2; ++ai)
#pragma unroll
            for (int m = 0; m < 4; ++m) { const size_t off = (size_t)(u.pm * BM + ai * HALF + wr * 64 + m * 16 + fr) * DM + col0;
#pragma unroll
                for (int bj = 0; bj < 2; ++bj)
#pragma unroll
                    for (int n = 0; n < 2; ++n) { const f32x4 b = *(const f32x4*)(hin + off + bj * HALF + n * 16); *(f32x4*)(out + off + bj * HALF + n * 16) = b + acc[ai][bj][m][n]; }
                if (m & 1) asm volatile("" ::: "memory"); }
    }
};
struct EpiGU {
    static constexpr bool PERM = true;
    bf16_t* hid; const float* rsl;
    __device__ __forceinline__ void operator()(const f32x4 (&acc)[2][2][4][2], const Unit& u, int wr, int wc, int fr, int fq) const {
#pragma unroll
        for (int ai = 0; ai < 2; ++ai)
#pragma unroll
            for (int m = 0; m < 4; ++m) {
                const int rl = ai * HALF + wr * 64 + m * 16 + fr, pos = u.t0 + rl;
                const float rs = pos < u.cnt ? rsl[u.e * ECAP + pos] : 0.f;
                float o[8];
#pragma unroll
                for (int n = 0; n < 2; ++n)
#pragma unroll
                    for (int i = 0; i < 4; ++i) { const float gt = acc[ai][0][m][n][i] * rs, up = acc[ai][1][m][n][i] * rs;
                        const float sg = gt * __builtin_amdgcn_rcpf(1.0f + __builtin_amdgcn_exp2f(-gt * LOG2E)); o[n * 4 + i] = sg * up; }
                u32x4 w; w.x = pk2(o[0], o[1]); w.y = pk2(o[2], o[3]); w.z = pk2(o[4], o[5]); w.w = pk2(o[6], o[7]);
                *(u32x4*)(hid + (size_t)(u.pm * BM + rl) * DEXP + u.pn * HALF + 32 * wc + 8 * fq) = w;
            }
    }
};
struct EpiDown {
    static constexpr bool PERM = true;
    bf16_t* ybuf; const float* gl;
    __device__ __forceinline__ void operator()(const f32x4 (&acc)[2][2][4][2], const Unit& u, int wr, int wc, int fr, int fq) const {
#pragma unroll
        for (int ai = 0; ai < 2; ++ai)
#pragma unroll
            for (int m = 0; m < 4; ++m) {
                const int rl = ai * HALF + wr * 64 + m * 16 + fr, pos = u.t0 + rl;
                const float gt = pos < u.cnt ? gl[u.e * ECAP + pos] : 0.f;
                bf16_t* rowp = ybuf + (size_t)(u.pm * BM + rl) * DM + u.pn * BM + wc * 32 + 8 * fq;
#pragma unroll
                for (int bj = 0; bj < 2; ++bj) { const f32x4 a = acc[ai][bj][m][0] * gt, b = acc[ai][bj][m][1] * gt;
                    u32x4 w; w.x = pk2(a[0], a[1]); w.y = pk2(a[2], a[3]); w.z = pk2(b[0], b[1]); w.w = pk2(b[2], b[3]);
                    *(u32x4*)(rowp + bj * HALF) = w; }
            }
    }
};
}

__device__ __forceinline__ int crow(int r, int hi) { return (r & 3) + 8 * (r >> 2) + 4 * hi; }
__device__ __forceinline__ v4i16 vtr(const LAS unsigned char* p) { return __builtin_amdgcn_ds_read_tr16_b64_v4i16((LAS v4i16*)p); }
__device__ __forceinline__ bf16x8 mk8(v4i16 lo, v4i16 hi) { return (bf16x8){lo[0], lo[1], lo[2], lo[3], hi[0], hi[1], hi[2], hi[3]}; }
__device__ __forceinline__ void qk_tile(f32x16& p0, f32x16& p1, const LAS unsigned char* kt, const bf16x8* qr, int r32, int hi) {
    const LAS unsigned char* kb = kt + hi * 1024 + r32 * 16;
#pragma unroll
    for (int d0 = 0; d0 < 4; ++d0) {
        const bf16x8 a0 = *(const LAS bf16x8*)(kb + d0 * 2048), a1 = *(const LAS bf16x8*)(kb + d0 * 2048 + 512);
        p0 = __builtin_amdgcn_mfma_f32_32x32x16_bf16(a0, qr[d0], p0, 0, 0, 0);
        p1 = __builtin_amdgcn_mfma_f32_32x32x16_bf16(a1, qr[d0], p1, 0, 0, 0);
    }
}
template <int ND> __device__ __forceinline__ void pv_tile(f32x16* o, const LAS unsigned char* vt, const bf16x8* pa, int lane, int hi) {
    const LAS unsigned char* vb = vt + ((lane >> 4) & 1) * 32 + (lane & 3) * 8 + (4 * hi + ((lane & 15) >> 2)) * 64;
#pragma unroll
    for (int d0 = 0; d0 < ND; ++d0)
#pragma unroll
        for (int ks = 0; ks < 4; ++ks) {
            const v4i16 lo = vtr(vb + d0 * 4096 + ks * 1024), h2 = vtr(vb + d0 * 4096 + ks * 1024 + 512);
            o[d0] = __builtin_amdgcn_mfma_f32_32x32x16_bf16(mk8(lo, h2), pa[ks], o[d0], 0, 0, 0);
        }
}
__device__ __forceinline__ void pack_p(bf16x8* pa, const f32x16& p0, const f32x16& p1) {
    u32x4 w;
    w.x = pk2(p0[0], p0[1]); w.y = pk2(p0[2], p0[3]); w.z = pk2(p0[4], p0[5]); w.w = pk2(p0[6], p0[7]); pa[0] = __builtin_bit_cast(bf16x8, w);
    w.x = pk2(p0[8], p0[9]); w.y = pk2(p0[10], p0[11]); w.z = pk2(p0[12], p0[13]); w.w = pk2(p0[14], p0[15]); pa[1] = __builtin_bit_cast(bf16x8, w);
    w.x = pk2(p1[0], p1[1]); w.y = pk2(p1[2], p1[3]); w.z = pk2(p1[4], p1[5]); w.w = pk2(p1[6], p1[7]); pa[2] = __builtin_bit_cast(bf16x8, w);
    w.x = pk2(p1[8], p1[9]); w.y = pk2(p1[10], p1[11]); w.z = pk2(p1[12], p1[13]); w.w = pk2(p1[14], p1[15]); pa[3] = __builtin_bit_cast(bf16x8, w);
}
template <int ND> __device__ __forceinline__ void softmax_step(f32x16& p0, f32x16& p1, float& mrun, float& l, f32x16* o) {
    float mx = p0[0];
#pragma unroll
    for (int r = 1; r < 16; ++r) mx = fmaxf(mx, p0[r]);
#pragma unroll
    for (int r = 0; r < 16; ++r) mx = fmaxf(mx, p1[r]);
    mx = fmaxf(mx, __shfl_xor(mx, 32));
    const float mn = fmaxf(mrun, mx), alpha = __builtin_amdgcn_exp2f(mrun - mn);
    mrun = mn;
    float s = 0.f;
#pragma unroll
    for (int r = 0; r < 16; ++r) { p0[r] = __builtin_amdgcn_exp2f(p0[r] - mn); p1[r] = __builtin_amdgcn_exp2f(p1[r] - mn); s += p0[r] + p1[r]; }
    l = l * alpha + s;
#pragma unroll
    for (int d0 = 0; d0 < ND; ++d0)
#pragma unroll
        for (int r = 0; r < 16; ++r) o[d0][r] *= alpha;
}
__device__ __forceinline__ int t5_bucket_past_or_future(int rel) {
    const int n = rel < 0 ? -rel : rel;
    int v;
    if (n < 8) v = n;
    else v = 8 + (n >= 13) + (n >= 20) + (n >= 30) + (n >= 46) + (n >= 70) + (n >= 108) + (n >= 166);
    return (rel > 0 ? 16 : 0) + v;
}

__device__ __forceinline__ void attnB_unit(LAS unsigned char* lds, const bf16_t* proj, bf16_t* merged, const float* t5_bias, const float* dlam, const float* subln, float lam_init, int b, int h, int qb) {
    int tid = threadIdx.x; asm volatile("" : "+v"(tid)); const int lane = tid & 63, r32 = lane & 31, hi = lane >> 5; const int wid = __builtin_amdgcn_readfirstlane(tid >> 6);
    const int m = wid >> 2, s = wid & 3, q0w = qb * 128 + s * 32;
    const size_t tokbase = (size_t)b * SEQ;
    LAS float* tb = (LAS float*)(lds + TB_OFF);
    for (int i = tid; i < 320; i += NWAVES * 64) tb[i] = t5_bias[t5_bucket_past_or_future(i - 256) * 4 + h] * LOG2E;
    float lam;
    { float a = dlam[lane] * dlam[64 + lane], c = dlam[128 + lane] * dlam[192 + lane];
#pragma unroll
      for (int o_ = 1; o_ < 64; o_ <<= 1) { a += __shfl_xor(a, o_); c += __shfl_xor(c, o_); }
      lam = __expf(a) - __expf(c) + lam_init; }
    bf16x8 qr[4];
    { const bf16_t* qp = proj + (tokbase + q0w + r32) * QKVW + 768 + h * 128 + m * 64 + hi * 8;
#pragma unroll
      for (int d0 = 0; d0 < 4; ++d0) qr[d0] = *(const bf16x8*)(qp + d0 * 16); }
    const int ntiles = 2 * qb + 2, mylast = q0w >> 6;
    const int pid0 = wid, pid1 = wid + 8;
    const bf16_t* srcK1 = proj + (tokbase + lane) * QKVW + 1280 + h * 128 + 8 * wid;
    const bf16_t* srcK2 = srcK1 + 64;
    const bf16_t* srcV0 = proj + (tokbase + 16 * (pid0 & 3) + (lane >> 2)) * QKVW + 1792 + h * 128 + 32 * (pid0 >> 2) + 8 * (lane & 3);
    const bf16_t* srcV1 = proj + (tokbase + 16 * (pid1 & 3) + (lane >> 2)) * QKVW + 1792 + h * 128 + 32 * (pid1 >> 2) + 8 * (lane & 3);
    const size_t tstep = (size_t)64 * QKVW;
#define GLDS16(src, dstoff) __builtin_amdgcn_global_load_lds((const unsigned*)(src), (LAS unsigned*)(lds + (dstoff)), 16, 0, 0)
    const int uK1 = wid * 1024, uK2 = 8192 + uK1, uV0 = 16384 + pid0 * 1024, uV1 = 16384 + pid1 * 1024;
    GLDS16(srcK1, uK1); GLDS16(srcK2, uK2); GLDS16(srcV0, uV0); GLDS16(srcV1, uV1);
    __syncthreads();
    const float cb = tb[0];
    float mrun = -1e30f, l = 0.f; f32x16 o[4];
#pragma unroll
    for (int d0 = 0; d0 < 4; ++d0) o[d0] = f32x16{};
    for (int t = 0; t < ntiles; ++t) {
        if (t + 1 < ntiles) { const size_t off = (size_t)(t + 1) * tstep; const int nb = ((t + 1) & 1) * 32768; GLDS16(srcK1 + off, nb + uK1); GLDS16(srcK2 + off, nb + uK2); GLDS16(srcV0 + off, nb + uV0); GLDS16(srcV1 + off, nb + uV1); }
        if (t <= mylast) {
            const LAS unsigned char* bufp = lds + (t & 1) * 32768;
            f32x16 p0 = f32x16{}, p1 = f32x16{};
            qk_tile(p0, p1, bufp + m * 8192, qr, r32, hi);
            if (64 * t + 63 - q0w <= -166) {
#pragma unroll
                for (int r = 0; r < 16; ++r) { p0[r] += cb; p1[r] += cb; }
            } else {
                const int relbase = 64 * t - (q0w + r32) + 256;
#pragma unroll
                for (int r = 0; r < 16; ++r) { const int i0 = relbase + crow(r, hi); p0[r] += tb[i0 < 0 ? 0 : i0]; const int i1 = i0 + 32; p1[r] += tb[i1 < 0 ? 0 : i1]; }
            }
            softmax_step<4>(p0, p1, mrun, l, o);
            bf16x8 pa[4]; pack_p(pa, p0, p1);
            pv_tile<4>(o, bufp + 16384, pa, lane, hi);
        }
        asm volatile("s_waitcnt vmcnt(0)" ::: "memory");
        __syncthreads();
    }
    const float lt = l + __shfl_xor(l, 32), inv = 1.0f / lt;
    LAS float* X = (LAS float*)lds;
    if (m == 1) {
#pragma unroll
        for (int d0 = 0; d0 < 4; ++d0)
#pragma unroll
            for (int r = 0; r < 16; ++r) X[((s * 64 + d0 * 16 + r) * 64) + lane] = o[d0][r] * inv;
    }
    __syncthreads();
    if (m == 0) {
        float ss = 0.f;
#pragma unroll
        for (int d0 = 0; d0 < 4; ++d0)
#pragma unroll
            for (int r = 0; r < 16; ++r) { const float y = o[d0][r] * inv - lam * X[((s * 64 + d0 * 16 + r) * 64) + lane]; o[d0][r] = y; ss += y * y; }
        ss += __shfl_xor(ss, 32);
        const float rn = __builtin_amdgcn_rsqf(ss * (1.0f / 128.0f) + EPS) * (1.0f - lam_init);
        bf16_t* op = merged + (tokbase + q0w + r32) * DM + 256 + h * 128 + 4 * hi;
#pragma unroll
        for (int d0 = 0; d0 < 4; ++d0)
#pragma unroll
            for (int a = 0; a < 4; ++a) { const f32x4 g = *(const f32x4*)(subln + 32 * d0 + 8 * a + 4 * hi);
                u32x2 w; w.x = pk2(o[d0][4 * a] * rn * g[0], o[d0][4 * a + 1] * rn * g[1]); w.y = pk2(o[d0][4 * a + 2] * rn * g[2], o[d0][4 * a + 3] * rn * g[3]);
                *(u32x2*)(op + 32 * d0 + 8 * a) = w; }
    }
    __syncthreads();
}

__device__ __forceinline__ void attnC_unit(LAS unsigned char* lds, const bf16_t* proj, bf16_t* merged, const float* relb  , int b, int h, int qb) {
    int tid = threadIdx.x; asm volatile("" : "+v"(tid)); const int lane = tid & 63, r32 = lane & 31, hi = lane >> 5; const int wid = __builtin_amdgcn_readfirstlane(tid >> 6);
    const int c0 = 4 * qb, cw = c0 + (wid >> 1), q0w = 64 * cw + 32 * (wid & 1);
    const size_t tokbase = (size_t)b * SEQ;
    LAS float* tb = (LAS float*)(lds + TB_OFF);
    for (int i = tid; i < 257; i += NWAVES * 64) tb[i] = relb[i * 4 + h] * LOG2E;
    bf16x8 qr[4];
    { const bf16_t* qp = proj + (tokbase + q0w + r32) * QKVW + 2304 + h * 64 + hi * 8;
#pragma unroll
      for (int d0 = 0; d0 < 4; ++d0) qr[d0] = *(const bf16x8*)(qp + d0 * 16); }
    const int tlo = c0 - 8 < 0 ? 0 : c0 - 8, thi = c0 + 3;
    const bf16_t* srcK = proj + (tokbase + lane) * QKVW + 2560 + h * 64 + 8 * wid;
    const bf16_t* srcV = proj + (tokbase + 16 * (wid & 3) + (lane >> 2)) * QKVW + 2816 + h * 64 + 32 * (wid >> 2) + 8 * (lane & 3);
    const int uK = wid * 1024, uV = 8192 + uK;
    const size_t tstep = (size_t)64 * QKVW;
    GLDS16(srcK + tlo * tstep, uK); GLDS16(srcV + tlo * tstep, uV);
    __syncthreads();
    const float cb = tb[0];
    float mrun = -1e30f, l = 0.f; f32x16 o[2]; o[0] = f32x16{}; o[1] = f32x16{};
    for (int t = tlo; t <= thi; ++t) {
        const int bi = (t - tlo) & 1;
        if (t < thi) { const size_t off = (size_t)(t + 1) * tstep; const int nb = (bi ^ 1) * 16384; GLDS16(srcK + off, nb + uK); GLDS16(srcV + off, nb + uV); }
        if (t >= cw - 8 && t <= cw) {
            const LAS unsigned char* bufp = lds + bi * 16384;
            f32x16 p0 = f32x16{}, p1 = f32x16{};
            qk_tile(p0, p1, bufp, qr, r32, hi);
            if (64 * t + 63 - q0w <= -128) {
#pragma unroll
                for (int r = 0; r < 16; ++r) { p0[r] += cb; p1[r] += cb; }
            } else {
                const int relbase = 64 * t - (q0w + r32) + 128;
#pragma unroll
                for (int r = 0; r < 16; ++r) { int i0 = relbase + crow(r, hi), i1 = i0 + 32; i0 = i0 < 0 ? 0 : (i0 > 256 ? 256 : i0); i1 = i1 < 0 ? 0 : (i1 > 256 ? 256 : i1); p0[r] += tb[i0]; p1[r] += tb[i1]; }
            }
            softmax_step<2>(p0, p1, mrun, l, o);
            bf16x8 pa[4]; pack_p(pa, p0, p1);
            pv_tile<2>(o, bufp + 8192, pa, lane, hi);
        }
        asm volatile("s_waitcnt vmcnt(0)" ::: "memory");
        __syncthreads();
    }
    const float lt = l + __shfl_xor(l, 32), inv = 1.0f / lt;
    bf16_t* op = merged + (tokbase + q0w + r32) * DM + 768 + h * 64 + 4 * hi;
#pragma unroll
    for (int d0 = 0; d0 < 2; ++d0)
#pragma unroll
        for (int a = 0; a < 4; ++a) { u32x2 w; w.x = pk2(o[d0][4 * a] * inv, o[d0][4 * a + 1] * inv); w.y = pk2(o[d0][4 * a + 2] * inv, o[d0][4 * a + 3] * inv); *(u32x2*)(op + 32 * d0 + 8 * a) = w; }
}

__device__ __forceinline__ void attnA_unit(LAS unsigned char* lds, const bf16_t* proj, bf16_t* merged, int b, int h, int qb) {
    int tid = threadIdx.x; asm volatile("" : "+v"(tid)); const int lane = tid & 63, r32 = lane & 31, hi = lane >> 5; const int wid = __builtin_amdgcn_readfirstlane(tid >> 6);
    const int q0w = 256 * qb + 32 * wid, td = q0w >> 6;
    const size_t tokbase = (size_t)b * SEQ;
    LAS unsigned char* wl = lds + wid * 16384;
    bf16x8 qr[4];
    { const bf16_t* qp = proj + (tokbase + q0w + r32) * QKVW + h * 64 + hi * 8;
#pragma unroll
      for (int d0 = 0; d0 < 4; ++d0) qr[d0] = *(const bf16x8*)(qp + d0 * 16); }
    float carry = 0.f; f32x16 o[2]; o[0] = f32x16{}; o[1] = f32x16{};
    const int qpos = q0w + r32;
    for (int t = td; t >= 0; --t) {
        const bf16_t* kp = proj + (tokbase + 64 * t + lane) * QKVW + 256 + h * 64;
        const bf16_t* vp = proj + (tokbase + 64 * t + (lane >> 2)) * QKVW + 512 + h * 64 + 8 * (lane & 3);
        const int wbase = wid * 16384;
#pragma unroll
        for (int j = 0; j < 8; ++j) GLDS16(kp + 8 * j, wbase + j * 1024);
#pragma unroll
        for (int j = 0; j < 8; ++j) GLDS16(vp + (size_t)(16 * (j & 3)) * QKVW + 32 * (j >> 2), wbase + 8192 + j * 1024);
        asm volatile("s_waitcnt vmcnt(0)" ::: "memory");
        f32x16 p0 = f32x16{}, p1 = f32x16{};
        qk_tile(p0, p1, wl, qr, r32, hi);
        f32x16 k0, k1;
        const bool diag = (t == td);
#pragma unroll
        for (int r = 0; r < 16; ++r) {
            const float z0 = p0[r], z1 = p1[r];
            float a0 = -(fmaxf(z0, 0.f) + __builtin_amdgcn_logf(1.0f + __builtin_amdgcn_exp2f(-fabsf(z0))));
            float a1 = -(fmaxf(z1, 0.f) + __builtin_amdgcn_logf(1.0f + __builtin_amdgcn_exp2f(-fabsf(z1))));
            if (diag) { const int key = 64 * t + crow(r, hi); if (key >= qpos) a0 = 0.f; if (key + 32 >= qpos) a1 = 0.f; }
            k0[r] = a0; k1[r] = a1;
        }
        float G[2][4], Go[2][4];
#pragma unroll
        for (int a = 0; a < 4; ++a) { G[0][a] = (k0[4 * a] + k0[4 * a + 1]) + (k0[4 * a + 2] + k0[4 * a + 3]); G[1][a] = (k1[4 * a] + k1[4 * a + 1]) + (k1[4 * a + 2] + k1[4 * a + 3]); }
#pragma unroll
        for (int P = 0; P < 2; ++P)
#pragma unroll
            for (int a = 0; a < 4; ++a) Go[P][a] = __shfl_xor(G[P][a], 32);
        float accs = carry;
#pragma unroll
        for (int P = 1; P >= 0; --P)
#pragma unroll
            for (int a = 3; a >= 0; --a) {
                f32x16& kk_ = P ? k1 : k0; f32x16& pp = P ? p1 : p0;
                float bt = accs + (hi == 0 ? Go[P][a] : 0.f);
#pragma unroll
                for (int i = 3; i >= 0; --i) { const int r = 4 * a + i; const float lk = kk_[r]; pp[r] = __builtin_amdgcn_exp2f(pp[r] + lk + bt); bt += lk; }
                accs += G[P][a] + Go[P][a];
            }
        carry = accs;
        if (diag) {
#pragma unroll
            for (int r = 0; r < 16; ++r) { const int key = 64 * t + crow(r, hi); if (key >= qpos) p0[r] = 0.f; if (key + 32 >= qpos) p1[r] = 0.f; }
        }
        bf16x8 pa[4]; pack_p(pa, p0, p1);
        pv_tile<2>(o, wl + 8192, pa, lane, hi);
        asm volatile("s_waitcnt lgkmcnt(0)" ::: "memory");
        if (__all(carry < -150.0f)) break;
    }
    bf16_t* op = merged + (tokbase + q0w + r32) * DM + h * 64 + 4 * hi;
#pragma unroll
    for (int d0 = 0; d0 < 2; ++d0)
#pragma unroll
        for (int a = 0; a < 4; ++a) { u32x2 w; w.x = pk2(o[d0][4 * a], o[d0][4 * a + 1]); w.y = pk2(o[d0][4 * a + 2], o[d0][4 * a + 3]); *(u32x2*)(op + 32 * d0 + 8 * a) = w; }
}

struct Args { const float* in[18]; float* out; unsigned char* ws; int ph_lo, ph_hi; };
enum { I_X = 0, I_T5, I_ANORM, I_WIN, I_DQN, I_DLAM, I_DSUB, I_CQN, I_CRB, I_WOUT, I_FNORM, I_RGW, I_RGB, I_REW, I_REB, I_WG, I_WU, I_WD };

__device__ __forceinline__ int rowmap(int kind, int n) {
    if (kind == 1) return (n & ~255) + 128 * ((n & 63) >> 5) + 32 * ((n >> 6) & 3) + (n & 31);
    if (kind == 2) return 256 * (n >> 7) + (n & 127);
    if (kind == 3) return 256 * (n >> 7) + 128 + (n & 127);
    return n;
}
__device__ __forceinline__ void transpose_item(const float* W, int K, int N, const float* gain, bf16_t* WT, int kind, LAS float* scr, int item, int lane) {
    const int nblk = N / 32, kb = item / nblk, nb = item % nblk, k0 = 64 * kb, n0 = 32 * nb;
#pragma unroll 8
    for (int i = 0; i < 32; ++i) { const int kk = 2 * i + (lane >> 5); float v = W[(size_t)(k0 + kk) * N + n0 + (lane & 31)]; if (gain) v *= gain[k0 + kk]; scr[kk * 33 + (lane & 31)] = v; }
    LDS_WAIT();
    const int c = lane & 7;
#pragma unroll
    for (int j = 0; j < 4; ++j) { const int n = (lane >> 3) + 8 * j; const LAS float* s = scr + (8 * c) * 33 + n;
        u32x4 o; o.x = pk2(s[0 * 33], s[1 * 33]); o.y = pk2(s[2 * 33], s[3 * 33]); o.z = pk2(s[4 * 33], s[5 * 33]); o.w = pk2(s[6 * 33], s[7 * 33]);
        *(u32x4*)(WT + (size_t)rowmap(kind, n0 + n) * K + k0 + 8 * c) = o; }
    LDS_WAIT();
}
__device__ __forceinline__ float wave_sum(float v) {
#pragma unroll
    for (int o = 1; o < 64; o <<= 1) v += __shfl_xor(v, o);
    return v;
}

__global__ void __launch_bounds__(NWAVES * 64, 2) fwd_kernel(Args args) {
    extern __shared__ __attribute__((aligned(16))) unsigned char lds_raw[];
    LAS unsigned char* lds = (LAS unsigned char*)lds_raw;
    volatile LAS unsigned* MISC = (volatile LAS unsigned*)(lds + MISC_OFF);
    const int G = gridDim.x, bx = blockIdx.x;
    const int vcu = (G % 8 == 0) ? (bx % 8) * (G / 8) + bx / 8 : bx;
    unsigned char* ws0 = args.ws;
    gu32* ctl = (gu32*)(ws0 + WS_CTL);
#define PHASE_LOCALS() \
    unsigned long long zero_ = 0ull; asm volatile("" : "+s"(zero_)); unsigned char* ws = ws0 + zero_; \
    int tid = threadIdx.x; asm volatile("" : "+v"(tid)); \
    const int lane = tid & 63, wave = __builtin_amdgcn_readfirstlane(tid >> 6); \
    const int gw = vcu * NWAVES + wave, NGW = G * NWAVES; \
    float* out = args.out; \
    bf16_t* hb = (bf16_t*)(ws + WS_HB); bf16_t* proj = (bf16_t*)(ws + WS_PROJ); bf16_t* merged = (bf16_t*)(ws + WS_MERGED); \
    bf16_t* hid = (bf16_t*)(ws + WS_HID); bf16_t* ybuf = (bf16_t*)(ws + WS_YBUF); float* rrow = (float*)(ws + WS_RROW); \
    unsigned* slot_of = (unsigned*)(ws + WS_SLOT); int* tok_list = (int*)(ws + WS_TOK); float* gate_list = (float*)(ws + WS_GATE); float* rs_list = (float*)(ws + WS_RS); \
    (void)lane; (void)wave; (void)gw; (void)NGW; (void)out; (void)hb; (void)proj; (void)merged; (void)hid; (void)ybuf; (void)rrow; (void)slot_of; (void)tok_list; (void)gate_list; (void)rs_list;

    if (threadIdx.x < 64) MISC[threadIdx.x] = 0u;
    __syncthreads();
#if MK_N_LAUNCHES == 1
    XcdBarrier bar = xcd_barrier_post((unsigned*)(ctl + CW_BAR), MISC + 40);
#define GRID_BAR() xcd_barrier(bar)
#else
#define GRID_BAR() do {} while (0)
#endif
    const int lo = args.ph_lo, hi_ph = args.ph_hi;
#ifndef PH_MASK
#define PH_MASK 0xff
#endif
#define IN(k) (lo <= (k) && (k) < hi_ph && ((PH_MASK >> ((k) == 0 ? 0 : (((k) - 1) % 7) + 1)) & 1))
#define BOTH(k) (IN(k) && IN((k) + 1))

    if (IN(0)) {
        PHASE_LOCALS();
        LAS float* scr = (LAS float*)(lds + wave * 16384);
        constexpr int I_IN = 16 * 96, I_OUT = 16 * 32, I_E = 256;
        constexpr int N_A = DEPTH * I_IN, N_B = DEPTH * I_OUT, N_C = DEPTH * NEXP * I_E;
        constexpr int NITEMS = N_A + N_B + 3 * N_C;
        for (int it = gw; it < NITEMS; it += NGW) {
            int r = it;
            if (r < N_A) { const int l = r / I_IN; transpose_item(args.in[I_WIN] + (size_t)l * DM * QKVW, DM, QKVW, args.in[I_ANORM] + l * DM, (bf16_t*)(ws + WS_WIN) + (size_t)l * QKVW * DM, 1, scr, r % I_IN, lane); continue; } r -= N_A;
            if (r < N_B) { const int l = r / I_OUT; transpose_item(args.in[I_WOUT] + (size_t)l * DM * DM, DM, DM, nullptr, (bf16_t*)(ws + WS_WOUT) + (size_t)l * DM * DM, 0, scr, r % I_OUT, lane); continue; } r -= N_B;
            const int which = r / N_C, r2 = r % N_C, le = r2 / I_E, item = r2 % I_E, l = le / NEXP;
            if (which == 0) transpose_item(args.in[I_WG] + (size_t)le * DM * DEXP, DM, DEXP, args.in[I_FNORM] + l * DM, (bf16_t*)(ws + WS_WGU) + (size_t)le * 1024 * DM, 2, scr, item, lane);
            else if (which == 1) transpose_item(args.in[I_WU] + (size_t)le * DM * DEXP, DM, DEXP, args.in[I_FNORM] + l * DM, (bf16_t*)(ws + WS_WGU) + (size_t)le * 1024 * DM, 3, scr, item, lane);
            else transpose_item(args.in[I_WD] + (size_t)le * DEXP * DM, DEXP, DM, nullptr, (bf16_t*)(ws + WS_WD) + (size_t)le * DM * DEXP, 0, scr, item, lane);
        }
        for (int i = (vcu * NWAVES * 64 + tid); i < DEPTH * 48 * 1024; i += G * NWAVES * 64) {
            const int l = i / (48 * 1024), n = (i / 1024) % 48, k = i % 1024;
            float w = 0.f;
            if (n < 4) w = args.in[I_RGW][((size_t)l * DM + k) * 4 + n]; else if (n < 36) w = args.in[I_REW][((size_t)l * DM + k) * 32 + (n - 4)];
            w *= args.in[I_FNORM][l * DM + k];
            const unsigned hb_ = f2bf(w); const float wl = w - __builtin_bit_cast(float, hb_ << 16);
            ((bf16_t*)(ws + WS_WRH))[i] = (bf16_t)hb_; ((bf16_t*)(ws + WS_WRL))[i] = (bf16_t)f2bf(wl);
        }
        const float* x = args.in[I_X];
        for (int row = gw; row < NTOK; row += NGW) {
            const f32x4* xr = (const f32x4*)(x + (size_t)row * DM) + lane; float ss = 0.f; u32x2* o8 = (u32x2*)(hb + (size_t)row * DM) + lane;
#pragma unroll
            for (int j = 0; j < 4; ++j) { const f32x4 v = xr[64 * j]; ss += (v[0] * v[0] + v[1] * v[1]) + (v[2] * v[2] + v[3] * v[3]); u32x2 w; w.x = pk2(v[0], v[1]); w.y = pk2(v[2], v[3]); o8[64 * j] = w; }
            ss = wave_sum(ss);
            if (lane == 0) rrow[row] = __builtin_amdgcn_rsqf(ss * (1.0f / DM) + EPS);
        }
        if (BOTH(0)) GRID_BAR();
    }

    for (int l = 0; l < DEPTH; ++l) {
        const int pb = 1 + 7 * l;
        const float lam_init = 0.8f - 0.6f * __expf(-0.3f * (float)l);
        const unsigned* cntl = (const unsigned*)(ctl + CW_CNT) + l * 32 * 64;
        if (IN(pb + 0)) {
            PHASE_LOCALS();
            pg8::DenseSched S; S.init(NTOK, QKVW, DM, (const bf16_t*)(ws + WS_WIN) + (size_t)l * QKVW * DM, G, bx);
            pg8::EpiWin E{proj, rrow, args.in[I_DQN] + l * 128, args.in[I_CQN] + l * 128};
            pg8::gemm_phase<pg8::EpiWin, pg8::DenseSched>(lds, hb, DM, S, E);
            if (BOTH(pb + 0)) GRID_BAR();
        }
        if (IN(pb + 1)) {
            PHASE_LOCALS();
            for (int P = vcu; P < 512; P += G) {
                const int bh = P >> 4, s = P & 15;
                attnB_unit(lds, proj, merged, args.in[I_T5], args.in[I_DLAM] + l * 256, args.in[I_DSUB] + l * 128, lam_init, bh >> 2, bh & 3, 31 - s);
                attnB_unit(lds, proj, merged, args.in[I_T5], args.in[I_DLAM] + l * 256, args.in[I_DSUB] + l * 128, lam_init, bh >> 2, bh & 3, s);
            }
            for (int U = vcu; U < 512; U += G) { const int bh = U >> 4; attnC_unit(lds, proj, merged, args.in[I_CRB] + l * 257 * 4, bh >> 2, bh & 3, U & 15); __syncthreads(); }
            for (int U = vcu; U < 512; U += G) { const int bh = U >> 4; attnA_unit(lds, proj, merged, bh >> 2, bh & 3, U & 15); }
            __syncthreads();
            if (BOTH(pb + 1)) GRID_BAR();
        }
        if (IN(pb + 2)) {
            PHASE_LOCALS();
            pg8::DenseSched S; S.init(NTOK, DM, DM, (const bf16_t*)(ws + WS_WOUT) + (size_t)l * DM * DM, G, bx);
            pg8::EpiWout E{l == 0 ? args.in[I_X] : (const float*)out, out};
            pg8::gemm_phase<pg8::EpiWout, pg8::DenseSched>(lds, merged, DM, S, E);
            if (BOTH(pb + 2)) GRID_BAR();
        }
        if (IN(pb + 3)) {
            PHASE_LOCALS();
            LAS float* lg = (LAS float*)lds;
            LAS float* rrl = (LAS float*)(lds + 128 * 49 * 4);
            LAS int* hist = (LAS int*)(lds + 128 * 49 * 4 + 512);
            const bf16_t* wrh = (const bf16_t*)(ws + WS_WRH) + (size_t)l * 48 * 1024;
            const bf16_t* wrl = (const bf16_t*)(ws + WS_WRL) + (size_t)l * 48 * 1024;
            const float* rgb = args.in[I_RGB] + l * 4; const float* reb = args.in[I_REB] + l * 32;
            const int fr = lane & 15, fq = lane >> 4;
            for (int chunk = vcu; chunk < NTOK / 128; chunk += G) {
                if (tid < 32) hist[tid] = 0;
                const int row = chunk * 128 + wave * 16 + fr;
                const float* hp = out + (size_t)row * DM + 8 * fq;
                f32x4 acc[3]; acc[0] = acc[1] = acc[2] = (f32x4){0.f, 0.f, 0.f, 0.f};
                float ss = 0.f;
#pragma unroll 2
                for (int k0 = 0; k0 < DM; k0 += 32) {
                    const f32x4 x0 = *(const f32x4*)(hp + k0), x1 = *(const f32x4*)(hp + k0 + 4);
                    ss += (x0[0] * x0[0] + x0[1] * x0[1]) + (x0[2] * x0[2] + x0[3] * x0[3]) + (x1[0] * x1[0] + x1[1] * x1[1]) + (x1[2] * x1[2] + x1[3] * x1[3]);
                    u32x4 ah; ah.x = pk2(x0[0], x0[1]); ah.y = pk2(x0[2], x0[3]); ah.z = pk2(x1[0], x1[1]); ah.w = pk2(x1[2], x1[3]);
                    u32x4 al; al.x = pk2(x0[0] - bflo(ah.x), x0[1] - bfhi(ah.x)); al.y = pk2(x0[2] - bflo(ah.y), x0[3] - bfhi(ah.y));
                    al.z = pk2(x1[0] - bflo(ah.z), x1[1] - bfhi(ah.z)); al.w = pk2(x1[2] - bflo(ah.w), x1[3] - bfhi(ah.w));
                    *(u32x4*)(hb + (size_t)row * DM + k0 + 8 * fq) = ah;
                    const bf16x8 aH = __builtin_bit_cast(bf16x8, ah), aL = __builtin_bit_cast(bf16x8, al);
#pragma unroll
                    for (int cbk = 0; cbk < 3; ++cbk) {
                        const bf16x8 bH = *(const bf16x8*)(wrh + (size_t)(cbk * 16 + fr) * DM + k0 + 8 * fq), bL = *(const bf16x8*)(wrl + (size_t)(cbk * 16 + fr) * DM + k0 + 8 * fq);
                        acc[cbk] = __builtin_amdgcn_mfma_f32_16x16x32_bf16(aH, bH, acc[cbk], 0, 0, 0);
                        acc[cbk] = __builtin_amdgcn_mfma_f32_16x16x32_bf16(aH, bL, acc[cbk], 0, 0, 0);
                        acc[cbk] = __builtin_amdgcn_mfma_f32_16x16x32_bf16(aL, bH, acc[cbk], 0, 0, 0);
                    }
                }
                ss += __shfl_xor(ss, 16); ss += __shfl_xor(ss, 32);
                if (fq == 0) rrl[wave * 16 + fr] = __builtin_amdgcn_rsqf(ss * (1.0f / DM) + EPS);
#pragma unroll
                for (int cbk = 0; cbk < 3; ++cbk)
#pragma unroll
                    for (int rg = 0; rg < 4; ++rg) lg[(wave * 16 + 4 * fq + rg) * 49 + cbk * 16 + fr] = acc[cbk][rg];
                __syncthreads();
                int e1 = 0, e2 = 0, lr1 = 0, lr2 = 0; float g1 = 0.f, g2 = 0.f, rr = 0.f;
                if (tid < 128) {
                    rr = rrl[tid];
                    const LAS float* lp = lg + tid * 49;
                    float gl[4]; int gs = 0; float gmax = -3.0e38f;
#pragma unroll
                    for (int i = 0; i < 4; ++i) { gl[i] = lp[i] * rr + rgb[i]; if (gl[i] > gmax) { gmax = gl[i]; gs = i; } }
                    float den = 0.f;
#pragma unroll
                    for (int i = 0; i < 4; ++i) den += __expf(gl[i] - gmax);
                    const float gwt = 1.0f / den;
                    float el[8]; int i1 = 0; float m1 = -3.0e38f;
#pragma unroll
                    for (int i = 0; i < 8; ++i) { el[i] = lp[4 + gs * 8 + i] * rr + reb[gs * 8 + i]; if (el[i] > m1) { m1 = el[i]; i1 = i; } }
                    int i2 = 0; float m2 = -3.0e38f;
#pragma unroll
                    for (int i = 0; i < 8; ++i) { if (i != i1 && el[i] > m2) { m2 = el[i]; i2 = i; } }
                    const float ex = __expf(m2 - m1), p1 = 1.0f / (1.0f + ex), p2 = ex * p1;
                    g1 = gwt * p1; g2 = gwt * p2; e1 = gs * 8 + i1; e2 = gs * 8 + i2;
                    lr1 = __hip_atomic_fetch_add(&hist[e1], 1, __ATOMIC_RELAXED, __HIP_MEMORY_SCOPE_WORKGROUP); lr2 = __hip_atomic_fetch_add(&hist[e2], 1, __ATOMIC_RELAXED, __HIP_MEMORY_SCOPE_WORKGROUP);
                }
                __syncthreads();
                if (tid < 32) { const int c_ = hist[tid]; hist[32 + tid] = c_ ? (int)__hip_atomic_fetch_add((unsigned*)cntl + 64 * tid, (unsigned)c_, __ATOMIC_RELAXED, __HIP_MEMORY_SCOPE_AGENT) : 0; }
                __syncthreads();
                if (tid < 128) {
                    const int tok = chunk * 128 + tid;
                    const int pos1 = hist[32 + e1] + lr1, pos2 = hist[32 + e2] + lr2;
                    tok_list[e1 * ECAP + pos1] = tok; gate_list[e1 * ECAP + pos1] = g1; rs_list[e1 * ECAP + pos1] = rr;
                    tok_list[e2 * ECAP + pos2] = tok; gate_list[e2 * ECAP + pos2] = g2; rs_list[e2 * ECAP + pos2] = rr;
                    slot_of[tok * 2] = ((unsigned)e1 << 16) | (unsigned)pos1; slot_of[tok * 2 + 1] = ((unsigned)e2 << 16) | (unsigned)pos2;
                }
                __syncthreads();
            }
            if (BOTH(pb + 3)) GRID_BAR();
        }
        if (IN(pb + 4) || IN(pb + 5) || IN(pb + 6)) {
            if (threadIdx.x == 0) { int s_ = 0; for (int e = 0; e < 32; ++e) { MISC[e] = (unsigned)s_; s_ += ((int)ld_agent(cntl + 64 * e) + 255) >> 8; } MISC[32] = (unsigned)s_; }
            __syncthreads();
        }
        if (IN(pb + 4)) {
            PHASE_LOCALS();
            pg8::MoeSched<true> S{(const volatile LAS int*)MISC, cntl, tok_list, (const bf16_t*)(ws + WS_WGU) + (size_t)l * NEXP * 1024 * DM, DM, G, bx};
            pg8::EpiGU E{hid, rs_list};
            pg8::gemm_phase<pg8::EpiGU, pg8::MoeSched<true>>(lds, hb, DM, S, E);
            if (BOTH(pb + 4)) GRID_BAR();
        }
        if (IN(pb + 5)) {
            PHASE_LOCALS();
            pg8::MoeSched<false> S{(const volatile LAS int*)MISC, cntl, tok_list, (const bf16_t*)(ws + WS_WD) + (size_t)l * NEXP * DM * DEXP, DEXP, G, bx};
            pg8::EpiDown E{ybuf, gate_list};
            pg8::gemm_phase<pg8::EpiDown, pg8::MoeSched<false>>(lds, hid, DEXP, S, E);
            if (BOTH(pb + 5)) GRID_BAR();
        }
        if (IN(pb + 6)) {
            PHASE_LOCALS();
            for (int row = gw; row < NTOK; row += NGW) {
                const unsigned s0 = ld_agent(slot_of + row * 2), s1 = ld_agent(slot_of + row * 2 + 1);
                const size_t y0 = (size_t)(MISC[s0 >> 16] * 256u + (s0 & 0xffffu)), y1 = (size_t)(MISC[s1 >> 16] * 256u + (s1 & 0xffffu));
                f32x4* hr = (f32x4*)(out + (size_t)row * DM) + lane;
                const u32x2* ya = (const u32x2*)(ybuf + y0 * DM) + lane; const u32x2* yb = (const u32x2*)(ybuf + y1 * DM) + lane;
                u32x2* o8 = (u32x2*)(hb + (size_t)row * DM) + lane;
                float ss = 0.f;
#pragma unroll
                for (int j = 0; j < 4; ++j) { f32x4 v = hr[64 * j]; const u32x2 a = ya[64 * j], b2 = yb[64 * j];
                    v[0] += bflo(a.x) + bflo(b2.x); v[1] += bfhi(a.x) + bfhi(b2.x); v[2] += bflo(a.y) + bflo(b2.y); v[3] += bfhi(a.y) + bfhi(b2.y);
                    hr[64 * j] = v; ss += (v[0] * v[0] + v[1] * v[1]) + (v[2] * v[2] + v[3] * v[3]);
                    u32x2 w; w.x = pk2(v[0], v[1]); w.y = pk2(v[2], v[3]); o8[64 * j] = w; }
                ss = wave_sum(ss);
                if (lane == 0) rrow[row] = __builtin_amdgcn_rsqf(ss * (1.0f / DM) + EPS);
            }
            if (BOTH(pb + 6)) GRID_BAR();
        }
    }
#undef IN
#undef BOTH
}

extern "C" void kernel_launch(void* const* d_in, const int* in_sizes, int n_in, void* d_out, int out_size, void* d_ws, size_t ws_size, hipStream_t stream) {
    static int grid = 0;
    if (grid == 0) {
        if (n_in != 18 || out_size != NTOK * DM || ws_size < WS_END) { fprintf(stderr, "kernel_launch: unexpected shapes (n_in %d, out %d, ws %zu < %zu)\n", n_in, out_size, ws_size, (size_t)WS_END); grid = -1; return; }
        int dev = 0, cus = 0, per_cu = 0;
        if (hipGetDevice(&dev) != hipSuccess || hipDeviceGetAttribute(&cus, hipDeviceAttributeMultiprocessorCount, dev) != hipSuccess) { grid = -1; return; }
        if (hipFuncSetAttribute((const void*)fwd_kernel, hipFuncAttributeMaxDynamicSharedMemorySize, LDS_BYTES) != hipSuccess) { fprintf(stderr, "kernel_launch: hipFuncSetAttribute failed\n"); grid = -1; return; }
        if (hipOccupancyMaxActiveBlocksPerMultiprocessor(&per_cu, (const void*)fwd_kernel, NWAVES * 64, LDS_BYTES) != hipSuccess || per_cu < 1) fprintf(stderr, "kernel_launch: occupancy query says %d\n", per_cu);
        (void)hipGetLastError();
        grid = cus;
    }
    if (grid < 0) return;
    if (hipMemsetAsync((char*)d_ws + WS_CTL, 0, CTL_ZERO_BYTES, stream) != hipSuccess) return;
    Args a{};
    for (int i = 0; i < 18; ++i) a.in[i] = (const float*)d_in[i];
    a.out = (float*)d_out; a.ws = (unsigned char*)d_ws;
#if MK_N_LAUNCHES == 1
    a.ph_lo = 0; a.ph_hi = NPHASES;
    hipLaunchKernelGGL(fwd_kernel, dim3(grid), dim3(NWAVES * 64), LDS_BYTES, stream, a);
#else
    for (int p = 0; p < NPHASES; ++p) { a.ph_lo = p; a.ph_hi = p + 1; hipLaunchKernelGGL(fwd_kernel, dim3(grid), dim3(NWAVES * 64), LDS_BYTES, stream, a); }
#endif
}
```

```cpp
#include <hip/hip_runtime.h>
#include <cstdio>
#include <cstdint>

#ifndef MK_N_LAUNCHES
#define MK_N_LAUNCHES 1
#endif

#define LAS __attribute__((address_space(3)))
#define GAS __attribute__((address_space(1)))
typedef unsigned short bf16_t;
typedef short bf16x8 __attribute__((ext_vector_type(8)));
typedef short v4i16 __attribute__((ext_vector_type(4)));
typedef float f32x4 __attribute__((ext_vector_type(4)));
typedef float f32x16 __attribute__((ext_vector_type(16)));
typedef unsigned u32x4 __attribute__((ext_vector_type(4)));
typedef unsigned u32x2 __attribute__((ext_vector_type(2)));
typedef float f32x2_t __attribute__((ext_vector_type(2)));
typedef __bf16 bf16x2_t __attribute__((ext_vector_type(2)));
typedef GAS unsigned gu32;

constexpr int DM = 1024, BATCH = 8, SEQ = 4096, NTOK = BATCH * SEQ, DEPTH = 2;
constexpr int QKVW = 3072, NEXP = 32, DEXP = 512, ECAP = 32768;
constexpr int MAXROWS = 73728;
constexpr float EPS = 1e-6f;
constexpr float LOG2E = 1.4426950408889634f;
constexpr float QSCALE = 0.125f * LOG2E;
constexpr int NWAVES = 8;
constexpr int NPHASES = 1 + 7 * DEPTH;

constexpr size_t MiB = 1u << 20;
constexpr size_t WS_CTL = 0, CTL_ZERO_BYTES = 1 * MiB;
constexpr size_t WS_WIN = 1 * MiB;
constexpr size_t WS_WOUT = 13 * MiB;
constexpr size_t WS_WGU = 17 * MiB;
constexpr size_t WS_WD = 145 * MiB;
constexpr size_t WS_WRH = 209 * MiB;
constexpr size_t WS_WRL = WS_WRH + 256 * 1024;
constexpr size_t WS_RROW = 210 * MiB;
constexpr size_t WS_SLOT = WS_RROW + 256 * 1024;
constexpr size_t WS_TOK = 211 * MiB;
constexpr size_t WS_GATE = 215 * MiB;
constexpr size_t WS_RS = 219 * MiB;
constexpr size_t WS_HB = 223 * MiB;
constexpr size_t WS_R = 287 * MiB;
constexpr size_t WS_PROJ = WS_R, WS_MERGED = WS_R + 192 * MiB;
constexpr size_t WS_HID = WS_R;
constexpr size_t WS_YBUF = WS_R + 72 * MiB;
constexpr size_t WS_END = 543 * MiB;
constexpr int CW_BAR = 4096;
constexpr int CW_CNT = 16384;

constexpr int RING_BYTES = 131072;
constexpr int MISC_OFF = RING_BYTES;
constexpr int TB_OFF = RING_BYTES + 1024;
constexpr int LDS_BYTES = 147456;

__device__ __forceinline__ unsigned f2bf(float f) { unsigned u = __builtin_bit_cast(unsigned, f); return (u + 0x7fffu + ((u >> 16) & 1u)) >> 16; }
__device__ __forceinline__ unsigned pk2(float lo, float hi) { f32x2_t v = {lo, hi}; bf16x2_t b = __builtin_convertvector(v, bf16x2_t); return __builtin_bit_cast(unsigned, b); }
__device__ __forceinline__ float bflo(unsigned w) { return __builtin_bit_cast(float, w << 16); }
__device__ __forceinline__ float bfhi(unsigned w) { return __builtin_bit_cast(float, w & 0xffff0000u); }
__device__ __forceinline__ unsigned ld_agent(const unsigned* p) { return __hip_atomic_load(p, __ATOMIC_RELAXED, __HIP_MEMORY_SCOPE_AGENT); }
#define LDS_WAIT() asm volatile("s_waitcnt lgkmcnt(0)" ::: "memory")

#define XB_TMO      128
#define XB_XCNT(j)  (256  + 64 * (j))
#define XB_XSUB(j)  (1280 + 64 * (j))
#define XB_XGEN(j)  (2304 + 64 * (j))
#define XB_TOP      3328
#define XB_TOPGEN   3392
#define XCD_BAR_WORDS 3456
#define XB_SPIN_CAP (1u << 18)
__device__ __forceinline__ unsigned xb_ld(unsigned* p)              { return __hip_atomic_load(p, __ATOMIC_RELAXED, __HIP_MEMORY_SCOPE_AGENT); }
__device__ __forceinline__ unsigned xb_add(unsigned* p, unsigned v) { return __hip_atomic_fetch_add(p, v, __ATOMIC_RELAXED, __HIP_MEMORY_SCOPE_AGENT); }
__device__ __forceinline__ unsigned xb_xcc_id() { return (unsigned)__builtin_amdgcn_s_getreg((3 << 11) | 20) & 0xFu; }
#define XB_SPIN(cond, bar) do { unsigned _sp = 0; while (cond) { __builtin_amdgcn_s_sleep(1); \
    if ((++_sp & 255u) == 0u) { if (xb_ld(&(bar)[XB_TMO])) break; if (_sp > XB_SPIN_CAP) { atomicAdd(&(bar)[XB_TMO], 1u); break; } } } } while (0)
struct XcdBarrier { unsigned* bar; unsigned x; volatile LAS unsigned* st; };
__device__ __forceinline__ XcdBarrier xcd_barrier_post(unsigned* bar, volatile LAS unsigned* st) {
    XcdBarrier b; b.bar = bar; b.x = xb_xcc_id(); b.st = st;
    if (threadIdx.x == 0) (void)xb_add(&bar[XB_XCNT(b.x)], 1u);
    return b;
}
__device__ __forceinline__ void xcd_barrier_complete(unsigned* bar, unsigned x, unsigned& nloc, unsigned& nx) {
    const unsigned G = gridDim.x * gridDim.y * gridDim.z;
    unsigned sum, cnt, mine, sp = 0u;
    for (;;) {
        sum = 0u; cnt = 0u; mine = 0u;
#pragma unroll
        for (unsigned j = 0; j < 16; ++j) { const unsigned c = xb_ld(&bar[XB_XCNT(j)]); sum += c; cnt += (c > 0u) ? 1u : 0u; mine = (j == x) ? c : mine; }
        if (sum == G) break;
        __builtin_amdgcn_s_sleep(1);
        if ((++sp & 255u) == 0u) { if (xb_ld(&bar[XB_TMO])) break; if (sp > XB_SPIN_CAP) { atomicAdd(&bar[XB_TMO], 1u); break; } }
    }
    nloc = mine > 0u ? mine : 1u; nx = cnt > 0u ? cnt : 1u;
}
__device__ __forceinline__ void xcd_barrier(const XcdBarrier& b) {
    asm volatile("s_waitcnt vmcnt(0)" ::: "memory");
    __syncthreads();
    if (threadIdx.x == 0) {
        unsigned* bar = b.bar;
        __builtin_amdgcn_s_waitcnt(0);
        unsigned nloc = b.st[0], nx = b.st[1];
        if (nloc == 0u) { xcd_barrier_complete(bar, b.x, nloc, nx); b.st[0] = nloc; b.st[1] = nx; }
        const unsigned old = xb_add(&bar[XB_XSUB(b.x)], 1u);
        const unsigned gen = old / nloc;
        if (old + 1u == (gen + 1u) * nloc) {
            __builtin_amdgcn_fence(__ATOMIC_RELEASE, "agent");
            asm volatile("s_waitcnt vmcnt(0)" ::: "memory");
            const unsigned og = xb_add(&bar[XB_TOP], 1u);
            const unsigned tg = og / nx;
            if (og + 1u == (tg + 1u) * nx) xb_add(&bar[XB_TOPGEN], 1u);
            else XB_SPIN(xb_ld(&bar[XB_TOPGEN]) == tg, bar);
            __builtin_amdgcn_fence(__ATOMIC_ACQUIRE, "agent");
            xb_add(&bar[XB_XGEN(b.x)], 1u);
            asm volatile("s_waitcnt vmcnt(0)" ::: "memory");
        } else {
            XB_SPIN(xb_ld(&bar[XB_XGEN(b.x)]) == gen, bar);
            __builtin_amdgcn_fence(__ATOMIC_ACQUIRE, "agent");
            asm volatile("s_waitcnt vmcnt(0)" ::: "memory");
        }
    }
    __syncthreads();
}

namespace pg8 {
constexpr int BM = 256, BK = 64, HALF = 128, HTB = HALF * BK * 2, STAGE_BYTES = 8 * HTB, NXCD = 8, WGM = 8;
__device__ __forceinline__ int lds_byte(int r, int c) { const int st = (r >> 4) * 2 + (c >> 5), rr = r & 15, cc = c & 31, ob = rr * 64 + cc * 2; return st * 1024 + (ob ^ (((ob >> 9) & 1) << 5)); }
__device__ __forceinline__ void stage_rc(int b, int& R, int& C) { const int st = b / 1024, sb = b % 1024, swz = sb ^ (((sb >> 9) & 1) << 5); R = (st >> 1) * 16 + swz / 64; C = (st & 1) * 32 + (swz % 64) / 2; }
__device__ __forceinline__ int perm32(int rho) { const int n = rho >> 4, i = rho & 15; return 8 * (i >> 2) + 4 * n + (i & 3); }

struct Unit { int pm, pn, e, t0, cnt; };

struct DenseSched {
    static constexpr bool GATHER = false;
    int nM, nN, nwg, G, c, K; const bf16_t* Bt;
    __device__ void init(int M, int N, int K_, const bf16_t* Bt_, int G_, int c_) { nM = M / BM; nN = N / BM; nwg = nM * nN; G = G_; c = c_; K = K_; Bt = Bt_; }
    __device__ __forceinline__ bool next(int i, Unit& u) const {
        const long L = (long)i * G + c; if (L >= nwg) return false;
        int wgid = (int)L; { const int q = nwg / NXCD, r = nwg % NXCD, xcd = wgid % NXCD, off = wgid / NXCD; wgid = (xcd < r ? xcd * (q + 1) : r * (q + 1) + (xcd - r) * q) + off; }
        const int nig = WGM * nN, gid = wgid / nig, fm = gid * WGM, gsz = (nM - fm) < WGM ? (nM - fm) : WGM;
        u.pm = fm + ((wgid % nig) % gsz); u.pn = (wgid % nig) / gsz; u.e = 0; u.t0 = 0; u.cnt = 0; return true;
    }
    __device__ __forceinline__ int arow(const Unit& u, int r) const { return u.pm * BM + r; }
    __device__ __forceinline__ const bf16_t* bptr(const Unit& u) const { return Bt + (size_t)u.pn * BM * K; }
};
template <bool GATHER_> struct MoeSched {
    static constexpr bool GATHER = GATHER_;
    const volatile LAS int* pre; const unsigned* cnt; const int* tok; const bf16_t* W; int K, G, c;
    __device__ __forceinline__ bool next(int i, Unit& u) const {
        const int L = i * G + c, T = L >> 2; const int ntile = __builtin_amdgcn_readfirstlane(pre[32]);
        if (T >= ntile) return false;
        int e = 0; while (__builtin_amdgcn_readfirstlane(pre[e + 1]) <= T) ++e;
        u.e = e; u.pm = T; u.pn = L & 3; u.t0 = (T - __builtin_amdgcn_readfirstlane(pre[e])) * BM; u.cnt = __builtin_amdgcn_readfirstlane((int)ld_agent(cnt + 64 * e)); return true;
    }
    __device__ __forceinline__ int arow(const Unit& u, int r) const {
        if (GATHER_) { const int pos = u.t0 + r; return pos < u.cnt ? tok[u.e * ECAP + pos] : 0; }
        return u.pm * BM + r;
    }
    __device__ __forceinline__ const bf16_t* bptr(const Unit& u) const { return W + ((size_t)u.e * 1024 + (size_t)u.pn * BM) * K; }
};

template <class Epi, class Sched>
__device__ __forceinline__ void gemm_phase(LAS unsigned char* lds, const bf16_t* Abase_, int K, const Sched& S, const Epi& E) {
    int tid = threadIdx.x; asm volatile("" : "+v"(tid));
    const int wid = __builtin_amdgcn_readfirstlane(tid >> 6), lane = tid & 63, wr = wid >> 2, wc = wid & 3, fr = lane & 15, fq = lane >> 4;
    constexpr bool GATHER = Sched::GATHER;
    const int nt = K / BK;
    int Rs[2], Cs[2]; unsigned voffA[2], voffB[2];
#pragma unroll
    for (int i = 0; i < 2; ++i) { int R, C; stage_rc(tid * 16 + i * 8192, R, C); Rs[i] = R; Cs[i] = C; const int Rb = Epi::PERM ? ((R & ~31) + perm32(R & 31)) : R;
        voffA[i] = (unsigned)(R * K + C) * 2u; voffB[i] = (unsigned)(Rb * K + C) * 2u; }
    const size_t kstep = (size_t)(BK * 2);
    const size_t hstep = (size_t)HALF * K * 2;
    const unsigned ldsw = (unsigned)wid * 1024u;
    const char* Abase = (const char*)Abase_;
    const int aoff = lds_byte(wr * 64 + fr, fq * 8), boff = lds_byte(wc * 32 + fr, fq * 8);
#define PG8_SA(b, h) (((b) * 2 + (h)) * HTB)
#define PG8_SB(b, h) ((4 + (b) * 2 + (h)) * HTB)
#define PG8_STAGE(bufoff, gbase, v0, v1) do { \
        __builtin_amdgcn_global_load_lds((const unsigned*)((const char*)(gbase) + (v0)), (LAS unsigned*)(lds + (bufoff) + ldsw), 16, 0, 0); \
        __builtin_amdgcn_global_load_lds((const unsigned*)((const char*)(gbase) + (v1)), (LAS unsigned*)(lds + (bufoff) + ldsw + 8192), 16, 0, 0); } while (0)
#define PG8_STAGE_AC(bufoff, h, koff) do { if constexpr (GATHER) PG8_STAGE(bufoff, Abase + (koff), cA[h][0], cA[h][1]); else PG8_STAGE(bufoff, cAp + (h) * hstep + (koff), voffA[0], voffA[1]); } while (0)
#define PG8_STAGE_AX(bufoff, h, koff) do { if constexpr (GATHER) PG8_STAGE(bufoff, a2p + (koff), (h) ? x10 : x00, (h) ? x11 : x01); else PG8_STAGE(bufoff, a2p + (h) * hstep + (koff), voffA[0], voffA[1]); } while (0)
#define PG8_STAGE_B(bufoff, gbase) PG8_STAGE(bufoff, gbase, voffB[0], voffB[1])
#define PG8_LDA(dst, b, h) do { _Pragma("unroll") for (int m = 0; m < 4; ++m) _Pragma("unroll") for (int k = 0; k < 2; ++k) dst[m][k] = *(const LAS bf16x8*)(lds + PG8_SA(b, h) + aoff + m * 2048 + k * 1024); } while (0)
#define PG8_LDB(dst, b, h) do { _Pragma("unroll") for (int n = 0; n < 2; ++n) _Pragma("unroll") for (int k = 0; k < 2; ++k) dst[n][k] = *(const LAS bf16x8*)(lds + PG8_SB(b, h) + boff + n * 2048 + k * 1024); } while (0)
#define PG8_MMA(ai, bj, At, Bt) do { __builtin_amdgcn_s_setprio(1); _Pragma("unroll") for (int m = 0; m < 4; ++m) _Pragma("unroll") for (int n = 0; n < 2; ++n) _Pragma("unroll") for (int k = 0; k < 2; ++k) \
        acc[ai][bj][m][n] = __builtin_amdgcn_mfma_f32_16x16x32_bf16(Bt[n][k], At[m][k], acc[ai][bj][m][n], 0, 0, 0); __builtin_amdgcn_s_setprio(0); } while (0)
#define PG8_WAIT_V(n) asm volatile("s_waitcnt vmcnt(" #n ")" ::: "memory")
#define PG8_WAIT_L(n) asm volatile("s_waitcnt lgkmcnt(" #n ")" ::: "memory")
#define PG8_BAR __builtin_amdgcn_s_barrier()
#define PG8_SCHED __builtin_amdgcn_sched_barrier(0)
#define PG8_MKA(dst, u) do { _Pragma("unroll") for (int h_ = 0; h_ < 2; ++h_) _Pragma("unroll") for (int i_ = 0; i_ < 2; ++i_) dst[h_][i_] = ((unsigned)S.arow(u, h_ * HALF + Rs[i_]) * (unsigned)K + (unsigned)Cs[i_]) * 2u; } while (0)
    Unit cur, nxt; int ui = 0;
    if (!S.next(0, cur)) return;
    f32x4 acc[2][2][4][2];
#pragma unroll
    for (int a = 0; a < 2; ++a)
#pragma unroll
        for (int b = 0; b < 2; ++b)
#pragma unroll
            for (int m = 0; m < 4; ++m)
#pragma unroll
                for (int n = 0; n < 2; ++n) acc[a][b][m][n] = (f32x4){0.f, 0.f, 0.f, 0.f};
    bf16x8 At[4][2], B0[2][2], B1[2][2];
    unsigned cA[2][2] = {{0u, 0u}, {0u, 0u}}, nA[2][2] = {{0u, 0u}, {0u, 0u}};
    const char* cAp = Abase; const char* nAp = Abase;
    if constexpr (GATHER) { PG8_MKA(cA, cur); } else { cAp = Abase + (size_t)S.arow(cur, 0) * K * 2; }
    const char* cB = (const char*)S.bptr(cur);
    PG8_STAGE_B(PG8_SB(0, 0), cB); PG8_STAGE_B(PG8_SB(0, 1), cB + hstep); PG8_STAGE_AC(PG8_SA(0, 0), 0, 0); PG8_STAGE_AC(PG8_SA(0, 1), 1, 0);
    if (wr == 1) PG8_BAR;
    PG8_WAIT_V(2); PG8_BAR;
    PG8_STAGE_B(PG8_SB(1, 0), cB + kstep); PG8_STAGE_AC(PG8_SA(1, 0), 0, kstep); PG8_STAGE_B(PG8_SB(1, 1), cB + hstep + kstep);
    PG8_WAIT_V(6); PG8_BAR;
    for (;;) {
        const bool has_next = S.next(ui + 1, nxt);
        const char* nB = cB; nAp = cAp;
        if (has_next) { nB = (const char*)S.bptr(nxt); if constexpr (GATHER) { PG8_MKA(nA, nxt); } else { nAp = Abase + (size_t)S.arow(nxt, 0) * K * 2; } }
        else { if constexpr (GATHER) {
#pragma unroll
            for (int h_ = 0; h_ < 2; ++h_)
#pragma unroll
                for (int i_ = 0; i_ < 2; ++i_) nA[h_][i_] = cA[h_][i_]; } }
        for (int t = 0; t < nt; t += 2) {
            const bool last = (t == nt - 2);
            const size_t k1 = (size_t)(t + 1) * kstep, k2 = last ? (size_t)0 : (size_t)(t + 2) * kstep;
            const char* a2p = (GATHER ? Abase : (last ? nAp : cAp)) + k2; const char* b2 = (last ? nB : cB) + k2;
            const char* b3 = b2 + kstep;
            const unsigned x00 = last ? nA[0][0] : cA[0][0], x01 = last ? nA[0][1] : cA[0][1], x10 = last ? nA[1][0] : cA[1][0], x11 = last ? nA[1][1] : cA[1][1];
            PG8_LDB(B0, 0, 0); PG8_LDB(B1, 0, 1); PG8_SCHED; PG8_LDA(At, 0, 0); PG8_STAGE_AC(PG8_SA(1, 1), 1, k1);
            PG8_WAIT_V(8); PG8_WAIT_L(0); PG8_BAR; PG8_MMA(0, 0, At, B0); PG8_MMA(0, 1, At, B1); PG8_BAR; PG8_SCHED;
            PG8_LDA(At, 0, 1); PG8_STAGE_B(PG8_SB(0, 0), b2); PG8_STAGE_B(PG8_SB(0, 1), b2 + hstep); PG8_STAGE_AX(PG8_SA(0, 0), 0, 0);
            PG8_WAIT_V(8); PG8_WAIT_L(0); PG8_BAR; PG8_MMA(1, 0, At, B0); PG8_MMA(1, 1, At, B1); PG8_BAR; PG8_SCHED;
            PG8_LDB(B0, 1, 0); PG8_LDB(B1, 1, 1); PG8_SCHED; PG8_LDA(At, 1, 0); PG8_STAGE_AX(PG8_SA(0, 1), 1, 0);
            PG8_WAIT_V(8); PG8_WAIT_L(0); PG8_BAR; PG8_MMA(0, 0, At, B0); PG8_MMA(0, 1, At, B1); PG8_BAR; PG8_SCHED;
            PG8_LDA(At, 1, 1); PG8_STAGE_B(PG8_SB(1, 0), b3); PG8_STAGE_B(PG8_SB(1, 1), b3 + hstep); PG8_STAGE_AX(PG8_SA(1, 0), 0, kstep);
            PG8_WAIT_V(8); PG8_WAIT_L(0); PG8_BAR; PG8_MMA(1, 0, At, B0); PG8_MMA(1, 1, At, B1); PG8_BAR; PG8_SCHED;
        }
        if (wr == 0) PG8_BAR;
        E(acc, cur, wr, wc, fr, fq);
        if (!has_next) break;
#pragma unroll
        for (int a = 0; a < 2; ++a)
#pragma unroll
            for (int b = 0; b < 2; ++b)
#pragma unroll
                for (int m = 0; m < 4; ++m)
#pragma unroll
                    for (int n = 0; n < 2; ++n) acc[a][b][m][n] = (f32x4){0.f, 0.f, 0.f, 0.f};
        cur = nxt; cB = nB; cAp = nAp; ++ui;
        if constexpr (GATHER) {
#pragma unroll
        for (int h_ = 0; h_ < 2; ++h_)
#pragma unroll
            for (int i_ = 0; i_ < 2; ++i_) cA[h_][i_] = nA[h_][i_]; }
        if (wr == 1) PG8_BAR;
    }
    PG8_WAIT_V(0);
    PG8_BAR;
#undef PG8_SA
#undef PG8_SB
#undef PG8_STAGE
#undef PG8_STAGE_AC
#undef PG8_STAGE_AX
#undef PG8_STAGE_B
#undef PG8_LDA
#undef PG8_LDB
#undef PG8_MMA
#undef PG8_WAIT_V
#undef PG8_WAIT_L
#undef PG8_BAR
#undef PG8_SCHED
#undef PG8_MKA
}

struct EpiWin {
    static constexpr bool PERM = true;
    bf16_t* proj; const float* rrow; const float* dqn; const float* cqn;
    __device__ __forceinline__ void operator()(const f32x4 (&acc)[2][2][4][2], const Unit& u, int wr, int wc, int fr, int fq) const {
        const int pn = u.pn;
        const float* g = nullptr;
        if (pn == 3 || pn == 4) g = dqn; else if (pn == 5 || pn == 6) g = dqn + 64; else if (pn == 9) g = cqn; else if (pn == 10) g = cqn + 64;
        const float qs = (pn == 0 || pn == 3 || pn == 4 || pn == 9) ? QSCALE : 1.0f;
        f32x4 gv[2][2];
#pragma unroll
        for (int bj = 0; bj < 2; ++bj)
#pragma unroll
            for (int n = 0; n < 2; ++n) { f32x4 t = g ? *(const f32x4*)(g + 32 * bj + 8 * fq + 4 * n) : (f32x4){1.f, 1.f, 1.f, 1.f}; gv[bj][n] = t * qs; }
        const bool donorm = (g != nullptr);
#pragma unroll
        for (int ai = 0; ai < 2; ++ai)
#pragma unroll
            for (int m = 0; m < 4; ++m) {
                const int row = u.pm * BM + ai * HALF + wr * 64 + m * 16 + fr;
                const float rs = rrow[row];
                f32x4 v[2][2]; float ss = 0.f;
#pragma unroll
                for (int bj = 0; bj < 2; ++bj)
#pragma unroll
                    for (int n = 0; n < 2; ++n) { v[bj][n] = acc[ai][bj][m][n] * rs; const f32x4 q = v[bj][n] * v[bj][n]; ss += (q[0] + q[1]) + (q[2] + q[3]); }
                float rn = 1.0f;
                if (donorm) { ss += __shfl_xor(ss, 16); ss += __shfl_xor(ss, 32); rn = __builtin_amdgcn_rsqf(ss * (1.0f / 64.0f) + EPS); }
                bf16_t* rowp = proj + (size_t)row * QKVW + pn * BM + 64 * wc + 8 * fq;
#pragma unroll
                for (int bj = 0; bj < 2; ++bj) { const f32x4 a = v[bj][0] * rn * gv[bj][0], b = v[bj][1] * rn * gv[bj][1];
                    u32x4 w; w.x = pk2(a[0], a[1]); w.y = pk2(a[2], a[3]); w.z = pk2(b[0], b[1]); w.w = pk2(b[2], b[3]);
                    *(u32x4*)(rowp + 32 * bj) = w; }
            }
    }
};
struct EpiWout {
    static constexpr bool PERM = false;
    const float* hin; float* out;
    __device__ __forceinline__ void operator()(const f32x4 (&acc)[2][2][4][2], const Unit& u, int wr, int wc, int fr, int fq) const {
        const int col0 = u.pn * BM + wc * 32 + 4 * fq;
#pragma unroll
        for (int ai = 0; ai < 2; ++ai)
#pragma unroll
            for (int m = 0; m < 4; ++m) { const size_t off = (size_t)(u.pm * BM + ai * HALF + wr * 64 + m * 16 + fr) * DM + col0;
#pragma unroll
                for (int bj = 0; bj < 2; ++bj)
#pragma unroll
                    for (int n = 0; n < 2; ++n) { const f32x4 b = *(const f32x4*)(hin + off + bj * HALF + n * 16); *(f32x4*)(out + off + bj * HALF + n * 16) = b + acc[ai][bj][m][n]; }
                if (m & 1) asm volatile("" ::: "memory"); }
    }
};
struct EpiGU {
    static constexpr bool PERM = true;
    bf16_t* hid; const float* rsl;
    __device__ __forceinline__ void operator()(const f32x4 (&acc)[2][2][4][2], const Unit& u, int wr, int wc, int fr, int fq) const {
#pragma unroll
        for (int ai = 0; ai < 2; ++ai)
#pragma unroll
            for (int m = 0; m < 4; ++m) {
                const int rl = ai * HALF + wr * 64 + m * 16 + fr, pos = u.t0 + rl;
                const float rs = pos < u.cnt ? rsl[u.e * ECAP + pos] : 0.f;
                float o[8];
#pragma unroll
                for (int n = 0; n < 2; ++n)
#pragma unroll
                    for (int i = 0; i < 4; ++i) { const float gt = acc[ai][0][m][n][i] * rs, up = acc[ai][1][m][n][i] * rs;
                        const float sg = gt * __builtin_amdgcn_rcpf(1.0f + __builtin_amdgcn_exp2f(-gt * LOG2E)); o[n * 4 + i] = sg * up; }
                u32x4 w; w.x = pk2(o[0], o[1]); w.y = pk2(o[2], o[3]); w.z = pk2(o[4], o[5]); w.w = pk2(o[6], o[7]);
                *(u32x4*)(hid + (size_t)(u.pm * BM + rl) * DEXP + u.pn * HALF + 32 * wc + 8 * fq) = w;
            }
    }
};
struct EpiDown {
    static constexpr bool PERM = true;
    bf16_t* ybuf; const float* gl;
    __device__ __forceinline__ void operator()(const f32x4 (&acc)[2][2][4][2], const Unit& u, int wr, int wc, int fr, int fq) const {
#pragma unroll
        for (int ai = 0; ai < 2; ++ai)
#pragma unroll
            for (int m = 0; m < 4; ++m) {
                const int rl = ai * HALF + wr * 64 + m * 16 + fr, pos = u.t0 + rl;
                const float gt = pos < u.cnt ? gl[u.e * ECAP + pos] : 0.f;
                bf16_t* rowp = ybuf + (size_t)(u.pm * BM + rl) * DM + u.pn * BM + wc * 32 + 8 * fq;
#pragma unroll
                for (int bj = 0; bj < 2; ++bj) { const f32x4 a = acc[ai][bj][m][0] * gt, b = acc[ai][bj][m][1] * gt;
                    u32x4 w; w.x = pk2(a[0], a[1]); w.y = pk2(a[2], a[3]); w.z = pk2(b[0], b[1]); w.w = pk2(b[2], b[3]);
                    *(u32x4*)(rowp + bj * HALF) = w; }
            }
    }
};
}

__device__ __forceinline__ int crow(int r, int hi) { return (r & 3) + 8 * (r >> 2) + 4 * hi; }
__device__ __forceinline__ v4i16 vtr(const LAS unsigned char* p) { return __builtin_amdgcn_ds_read_tr16_b64_v4i16((LAS v4i16*)p); }
__device__ __forceinline__ bf16x8 mk8(v4i16 lo, v4i16 hi) { return (bf16x8){lo[0], lo[1], lo[2], lo[3], hi[0], hi[1], hi[2], hi[3]}; }
__device__ __forceinline__ void qk_tile(f32x16& p0, f32x16& p1, const LAS unsigned char* kt, const bf16x8* qr, int r32, int hi) {
    const LAS unsigned char* kb = kt + hi * 1024 + r32 * 16;
#pragma unroll
    for (int d0 = 0; d0 < 4; ++d0) {
        const bf16x8 a0 = *(const LAS bf16x8*)(kb + d0 * 2048), a1 = *(const LAS bf16x8*)(kb + d0 * 2048 + 512);
        p0 = __builtin_amdgcn_mfma_f32_32x32x16_bf16(a0, qr[d0], p0, 0, 0, 0);
        p1 = __builtin_amdgcn_mfma_f32_32x32x16_bf16(a1, qr[d0], p1, 0, 0, 0);
    }
}
template <int ND> __device__ __forceinline__ void pv_tile(f32x16* o, const LAS unsigned char* vt, const bf16x8* pa, int lane, int hi) {
    const LAS unsigned char* vb = vt + ((lane >> 4) & 1) * 32 + (lane & 3) * 8 + (4 * hi + ((lane & 15) >> 2)) * 64;
#pragma unroll
    for (int d0 = 0; d0 < ND; ++d0) {
        v4i16 lo[4], h2[4];
#pragma unroll
        for (int ks = 0; ks < 4; ++ks) { lo[ks] = vtr(vb + d0 * 4096 + ks * 1024); h2[ks] = vtr(vb + d0 * 4096 + ks * 1024 + 512); }
#pragma unroll
        for (int ks = 0; ks < 4; ++ks) o[d0] = __builtin_amdgcn_mfma_f32_32x32x16_bf16(mk8(lo[ks], h2[ks]), pa[ks], o[d0], 0, 0, 0);
        __builtin_amdgcn_sched_barrier(0);
    }
}
__device__ __forceinline__ void pack_p(bf16x8* pa, const f32x16& p0, const f32x16& p1) {
    u32x4 w;
    w.x = pk2(p0[0], p0[1]); w.y = pk2(p0[2], p0[3]); w.z = pk2(p0[4], p0[5]); w.w = pk2(p0[6], p0[7]); pa[0] = __builtin_bit_cast(bf16x8, w);
    w.x = pk2(p0[8], p0[9]); w.y = pk2(p0[10], p0[11]); w.z = pk2(p0[12], p0[13]); w.w = pk2(p0[14], p0[15]); pa[1] = __builtin_bit_cast(bf16x8, w);
    w.x = pk2(p1[0], p1[1]); w.y = pk2(p1[2], p1[3]); w.z = pk2(p1[4], p1[5]); w.w = pk2(p1[6], p1[7]); pa[2] = __builtin_bit_cast(bf16x8, w);
    w.x = pk2(p1[8], p1[9]); w.y = pk2(p1[10], p1[11]); w.z = pk2(p1[12], p1[13]); w.w = pk2(p1[14], p1[15]); pa[3] = __builtin_bit_cast(bf16x8, w);
}
#define SM_THR 8.0f
template <int ND> __device__ __forceinline__ void sm_update(f32x16& p0, f32x16& p1, float& mref, float& l, f32x16* o, f32x16& cm, float cb, bool first) {
    float a = __builtin_fmaxf(__builtin_fmaxf(p0[0], p0[1]), p1[0]), b = __builtin_fmaxf(__builtin_fmaxf(p0[2], p0[3]), p1[1]); a = __builtin_fmaxf(__builtin_fmaxf(a, p1[2]), p1[3]);
#pragma unroll
    for (int r = 4; r < 16; r += 4) { a = __builtin_fmaxf(__builtin_fmaxf(a, p0[r]), p0[r + 1]); b = __builtin_fmaxf(__builtin_fmaxf(b, p0[r + 2]), p0[r + 3]);
        a = __builtin_fmaxf(__builtin_fmaxf(a, p1[r]), p1[r + 1]); b = __builtin_fmaxf(__builtin_fmaxf(b, p1[r + 2]), p1[r + 3]); }
    float mx = __builtin_fmaxf(a, b);
    if (first) {
        mx = __builtin_fmaxf(mx, __shfl_xor(mx, 32));
        mref = mx;
#pragma unroll
        for (int r = 0; r < 16; ++r) { p0[r] -= mx; p1[r] -= mx; cm[r] = cb - mx; }
    } else if (__any(mx > SM_THR)) {
        mx = __builtin_fmaxf(mx, __shfl_xor(mx, 32));
        const float d = __builtin_fmaxf(mx, 0.f);
        mref += d;
        const float alpha = __builtin_amdgcn_exp2f(-d);
        l *= alpha;
#pragma unroll
        for (int r = 0; r < 16; ++r) { p0[r] -= d; p1[r] -= d; cm[r] = cb - mref; }
#pragma unroll
        for (int d0 = 0; d0 < ND; ++d0)
#pragma unroll
            for (int r = 0; r < 16; ++r) o[d0][r] *= alpha;
    }
    float s0 = 0.f, s1 = 0.f;
#pragma unroll
    for (int r = 0; r < 16; ++r) { p0[r] = __builtin_amdgcn_exp2f(p0[r]); p1[r] = __builtin_amdgcn_exp2f(p1[r]); s0 += p0[r]; s1 += p1[r]; }
    l += s0 + s1;
}
__device__ __forceinline__ void qk_tile_c(f32x16& p0, f32x16& p1, const LAS unsigned char* kt, const bf16x8* qr, const f32x16& cm, int r32, int hi) {
    const LAS unsigned char* kb = kt + hi * 1024 + r32 * 16;
#pragma unroll
    for (int d0 = 0; d0 < 4; ++d0) {
        const bf16x8 a0 = *(const LAS bf16x8*)(kb + d0 * 2048), a1 = *(const LAS bf16x8*)(kb + d0 * 2048 + 512);
        if (d0 == 0) { p0 = __builtin_amdgcn_mfma_f32_32x32x16_bf16(a0, qr[0], cm, 0, 0, 0); p1 = __builtin_amdgcn_mfma_f32_32x32x16_bf16(a1, qr[0], cm, 0, 0, 0); }
        else { p0 = __builtin_amdgcn_mfma_f32_32x32x16_bf16(a0, qr[d0], p0, 0, 0, 0); p1 = __builtin_amdgcn_mfma_f32_32x32x16_bf16(a1, qr[d0], p1, 0, 0, 0); }
    }
}
__device__ __forceinline__ int t5_bucket_past_or_future(int rel) {
    const int n = rel < 0 ? -rel : rel;
    int v;
    if (n < 8) v = n;
    else v = 8 + (n >= 13) + (n >= 20) + (n >= 30) + (n >= 46) + (n >= 70) + (n >= 108) + (n >= 166);
    return (rel > 0 ? 16 : 0) + v;
}

__device__ __forceinline__ void attnB_unit(LAS unsigned char* lds, const bf16_t* proj, bf16_t* merged, const float* t5_bias, const float* dlam, const float* subln, float lam_init, int b, int h, int qb) {
    int tid = threadIdx.x; asm volatile("" : "+v"(tid)); const int lane = tid & 63, r32 = lane & 31, hi = lane >> 5; const int wid = __builtin_amdgcn_readfirstlane(tid >> 6);
    const int m = wid >> 2, s = wid & 3, q0w = qb * 128 + s * 32;
    const size_t tokbase = (size_t)b * SEQ;
    LAS float* tb = (LAS float*)(lds + TB_OFF);
    const float cb = t5_bias[15 * 4 + h] * LOG2E;
    for (int i = tid; i < 324; i += NWAVES * 64) tb[i] = t5_bias[t5_bucket_past_or_future(i - 260) * 4 + h] * LOG2E - cb;
    float lam;
    { float a = dlam[lane] * dlam[64 + lane], c = dlam[128 + lane] * dlam[192 + lane];
#pragma unroll
      for (int o_ = 1; o_ < 64; o_ <<= 1) { a += __shfl_xor(a, o_); c += __shfl_xor(c, o_); }
      lam = __expf(a) - __expf(c) + lam_init; }
    bf16x8 qr[4];
    { const bf16_t* qp = proj + (tokbase + q0w + r32) * QKVW + 768 + h * 128 + m * 64 + hi * 8;
#pragma unroll
      for (int d0 = 0; d0 < 4; ++d0) qr[d0] = *(const bf16x8*)(qp + d0 * 16); }
    const int ntiles = 2 * qb + 2, mylast = q0w >> 6;
    const int pid0 = wid, pid1 = wid + 8;
    const bf16_t* srcK1 = proj + (tokbase + lane) * QKVW + 1280 + h * 128 + 8 * wid;
    const bf16_t* srcK2 = srcK1 + 64;
    const bf16_t* srcV0 = proj + (tokbase + 16 * (pid0 & 3) + (lane >> 2)) * QKVW + 1792 + h * 128 + 32 * (pid0 >> 2) + 8 * (lane & 3);
    const bf16_t* srcV1 = proj + (tokbase + 16 * (pid1 & 3) + (lane >> 2)) * QKVW + 1792 + h * 128 + 32 * (pid1 >> 2) + 8 * (lane & 3);
    const size_t tstep = (size_t)64 * QKVW;
#define GLDS16(src, dstoff) __builtin_amdgcn_global_load_lds((const unsigned*)(src), (LAS unsigned*)(lds + (dstoff)), 16, 0, 0)
    const int uK1 = wid * 1024, uK2 = 8192 + uK1, uV0 = 16384 + pid0 * 1024, uV1 = 16384 + pid1 * 1024;
    GLDS16(srcK1, uK1); GLDS16(srcK2, uK2); GLDS16(srcV0, uV0); GLDS16(srcV1, uV1);
    __syncthreads();
    float mref = 0.f, l = 0.f; f32x16 o[4]; f32x16 cm;
#pragma unroll
    for (int d0 = 0; d0 < 4; ++d0) o[d0] = f32x16{};
#pragma unroll
    for (int r = 0; r < 16; ++r) cm[r] = cb;
    for (int t = 0; t < ntiles; ++t) {
        if (t + 1 < ntiles) { const size_t off = (size_t)(t + 1) * tstep; const int nb = ((t + 1) & 1) * 32768; GLDS16(srcK1 + off, nb + uK1); GLDS16(srcK2 + off, nb + uK2); GLDS16(srcV0 + off, nb + uV0); GLDS16(srcV1 + off, nb + uV1); }
        if (t <= mylast) {
            const LAS unsigned char* bufp = lds + (t & 1) * 32768;
            f32x16 p0, p1;
            qk_tile_c(p0, p1, bufp + m * 8192, qr, cm, r32, hi);
            if (64 * t + 63 - q0w > -166) {
                const LAS float* tp = tb + (64 * t - (q0w + r32) + 260 + 4 * hi);
#pragma unroll
                for (int r = 0; r < 16; ++r) { p0[r] += tp[(r & 3) + 8 * (r >> 2)]; p1[r] += tp[(r & 3) + 8 * (r >> 2) + 32]; }
            }
            sm_update<4>(p0, p1, mref, l, o, cm, cb, t == 0);
            bf16x8 pa[4]; pack_p(pa, p0, p1);
            pv_tile<4>(o, bufp + 16384, pa, lane, hi);
        }
        asm volatile("s_waitcnt vmcnt(0)" ::: "memory");
        __syncthreads();
    }
    const float lt = l + __shfl_xor(l, 32), inv = 1.0f / lt;
    LAS float* X = (LAS float*)lds;
    if (m == 1) {
#pragma unroll
        for (int d0 = 0; d0 < 4; ++d0)
#pragma unroll
            for (int r = 0; r < 16; ++r) X[((s * 64 + d0 * 16 + r) * 64) + lane] = o[d0][r] * inv;
    }
    __syncthreads();
    if (m == 0) {
        float ss = 0.f;
#pragma unroll
        for (int d0 = 0; d0 < 4; ++d0)
#pragma unroll
            for (int r = 0; r < 16; ++r) { const float y = o[d0][r] * inv - lam * X[((s * 64 + d0 * 16 + r) * 64) + lane]; o[d0][r] = y; ss += y * y; }
        ss += __shfl_xor(ss, 32);
        const float rn = __builtin_amdgcn_rsqf(ss * (1.0f / 128.0f) + EPS) * (1.0f - lam_init);
        bf16_t* op = merged + (tokbase + q0w + r32) * DM + 256 + h * 128 + 4 * hi;
#pragma unroll
        for (int d0 = 0; d0 < 4; ++d0)
#pragma unroll
            for (int a = 0; a < 4; ++a) { const f32x4 g = *(const f32x4*)(subln + 32 * d0 + 8 * a + 4 * hi);
                u32x2 w; w.x = pk2(o[d0][4 * a] * rn * g[0], o[d0][4 * a + 1] * rn * g[1]); w.y = pk2(o[d0][4 * a + 2] * rn * g[2], o[d0][4 * a + 3] * rn * g[3]);
                *(u32x2*)(op + 32 * d0 + 8 * a) = w; }
    }
    __syncthreads();
}

__device__ __forceinline__ void attnC_unit(LAS unsigned char* lds, const bf16_t* proj, bf16_t* merged, const float* relb  , int b, int h, int qb) {
    int tid = threadIdx.x; asm volatile("" : "+v"(tid)); const int lane = tid & 63, r32 = lane & 31, hi = lane >> 5; const int wid = __builtin_amdgcn_readfirstlane(tid >> 6);
    const int c0 = 4 * qb, cw = c0 + (wid >> 1), q0w = 64 * cw + 32 * (wid & 1);
    const size_t tokbase = (size_t)b * SEQ;
    LAS float* tb = (LAS float*)(lds + TB_OFF);
    const float cb = relb[h] * LOG2E;
    for (int i = tid; i < 288; i += NWAVES * 64) { int rel = i - 224; rel = rel < -128 ? -128 : rel; tb[i] = relb[(rel + 128) * 4 + h] * LOG2E - cb; }
    bf16x8 qr[4];
    { const bf16_t* qp = proj + (tokbase + q0w + r32) * QKVW + 2304 + h * 64 + hi * 8;
#pragma unroll
      for (int d0 = 0; d0 < 4; ++d0) qr[d0] = *(const bf16x8*)(qp + d0 * 16); }
    const int tlo = c0 - 8 < 0 ? 0 : c0 - 8, thi = c0 + 3;
    const bf16_t* srcK = proj + (tokbase + lane) * QKVW + 2560 + h * 64 + 8 * wid;
    const bf16_t* srcV = proj + (tokbase + 16 * (wid & 3) + (lane >> 2)) * QKVW + 2816 + h * 64 + 32 * (wid >> 2) + 8 * (lane & 3);
    const int uK = wid * 1024, uV = 8192 + uK;
    const size_t tstep = (size_t)64 * QKVW;
    GLDS16(srcK + tlo * tstep, uK); GLDS16(srcV + tlo * tstep, uV);
    __syncthreads();
    float mref = 0.f, l = 0.f; f32x16 o[2]; o[0] = f32x16{}; o[1] = f32x16{}; f32x16 cm;
#pragma unroll
    for (int r = 0; r < 16; ++r) cm[r] = cb;
    const int myfirst = cw - 8 < 0 ? 0 : cw - 8;
    for (int t = tlo; t <= thi; ++t) {
        const int bi = (t - tlo) & 1;
        if (t < thi) { const size_t off = (size_t)(t + 1) * tstep; const int nb = (bi ^ 1) * 16384; GLDS16(srcK + off, nb + uK); GLDS16(srcV + off, nb + uV); }
        if (t >= myfirst && t <= cw) {
            const LAS unsigned char* bufp = lds + bi * 16384;
            f32x16 p0, p1;
            qk_tile_c(p0, p1, bufp, qr, cm, r32, hi);
            if (64 * t + 63 - q0w > -128) {
                const LAS float* tp = tb + (64 * t - (q0w + r32) + 224 + 4 * hi);
#pragma unroll
                for (int r = 0; r < 16; ++r) { p0[r] += tp[(r & 3) + 8 * (r >> 2)]; p1[r] += tp[(r & 3) + 8 * (r >> 2) + 32]; }
            }
            sm_update<2>(p0, p1, mref, l, o, cm, cb, t == myfirst);
            bf16x8 pa[4]; pack_p(pa, p0, p1);
            pv_tile<2>(o, bufp + 8192, pa, lane, hi);
        }
        asm volatile("s_waitcnt vmcnt(0)" ::: "memory");
        __syncthreads();
    }
    const float lt = l + __shfl_xor(l, 32), inv = 1.0f / lt;
    bf16_t* op = merged + (tokbase + q0w + r32) * DM + 768 + h * 64 + 4 * hi;
#pragma unroll
    for (int d0 = 0; d0 < 2; ++d0)
#pragma unroll
        for (int a = 0; a < 4; ++a) { u32x2 w; w.x = pk2(o[d0][4 * a] * inv, o[d0][4 * a + 1] * inv); w.y = pk2(o[d0][4 * a + 2] * inv, o[d0][4 * a + 3] * inv); *(u32x2*)(op + 32 * d0 + 8 * a) = w; }
}

__device__ __forceinline__ void attnA_unit(LAS unsigned char* lds, const bf16_t* proj, bf16_t* merged, int b, int h, int qb) {
    int tid = threadIdx.x; asm volatile("" : "+v"(tid)); const int lane = tid & 63, r32 = lane & 31, hi = lane >> 5; const int wid = __builtin_amdgcn_readfirstlane(tid >> 6);
    const int q0w = 256 * qb + 32 * wid, td = q0w >> 6;
    const size_t tokbase = (size_t)b * SEQ;
    LAS unsigned char* wl = lds + wid * 16384;
    bf16x8 qr[4];
    { const bf16_t* qp = proj + (tokbase + q0w + r32) * QKVW + h * 64 + hi * 8;
#pragma unroll
      for (int d0 = 0; d0 < 4; ++d0) qr[d0] = *(const bf16x8*)(qp + d0 * 16); }
    float carry = 0.f; f32x16 o[2]; o[0] = f32x16{}; o[1] = f32x16{};
    const int qpos = q0w + r32;
    for (int t = td; t >= 0; --t) {
        const bf16_t* kp = proj + (tokbase + 64 * t + lane) * QKVW + 256 + h * 64;
        const bf16_t* vp = proj + (tokbase + 64 * t + (lane >> 2)) * QKVW + 512 + h * 64 + 8 * (lane & 3);
        const int wbase = wid * 16384;
#pragma unroll
        for (int j = 0; j < 8; ++j) GLDS16(kp + 8 * j, wbase + j * 1024);
#pragma unroll
        for (int j = 0; j < 8; ++j) GLDS16(vp + (size_t)(16 * (j & 3)) * QKVW + 32 * (j >> 2), wbase + 8192 + j * 1024);
        asm volatile("s_waitcnt vmcnt(0)" ::: "memory");
        f32x16 p0 = f32x16{}, p1 = f32x16{};
        qk_tile(p0, p1, wl, qr, r32, hi);
        f32x16 k0, k1;
        const bool diag = (t == td);
#pragma unroll
        for (int r = 0; r < 16; ++r) {
            const float z0 = p0[r], z1 = p1[r];
            float a0 = -(fmaxf(z0, 0.f) + __builtin_amdgcn_logf(1.0f + __builtin_amdgcn_exp2f(-fabsf(z0))));
            float a1 = -(fmaxf(z1, 0.f) + __builtin_amdgcn_logf(1.0f + __builtin_amdgcn_exp2f(-fabsf(z1))));
            if (diag) { const int key = 64 * t + crow(r, hi); if (key >= qpos) a0 = 0.f; if (key + 32 >= qpos) a1 = 0.f; }
            k0[r] = a0; k1[r] = a1;
        }
        float G[2][4], Go[2][4];
#pragma unroll
        for (int a = 0; a < 4; ++a) { G[0][a] = (k0[4 * a] + k0[4 * a + 1]) + (k0[4 * a + 2] + k0[4 * a + 3]); G[1][a] = (k1[4 * a] + k1[4 * a + 1]) + (k1[4 * a + 2] + k1[4 * a + 3]); }
#pragma unroll
        for (int P = 0; P < 2; ++P)
#pragma unroll
            for (int a = 0; a < 4; ++a) Go[P][a] = __shfl_xor(G[P][a], 32);
        float accs = carry;
#pragma unroll
        for (int P = 1; P >= 0; --P)
#pragma unroll
            for (int a = 3; a >= 0; --a) {
                f32x16& kk_ = P ? k1 : k0; f32x16& pp = P ? p1 : p0;
                float bt = accs + (hi == 0 ? Go[P][a] : 0.f);
#pragma unroll
                for (int i = 3; i >= 0; --i) { const int r = 4 * a + i; const float lk = kk_[r]; pp[r] = __builtin_amdgcn_exp2f(pp[r] + lk + bt); bt += lk; }
                accs += G[P][a] + Go[P][a];
            }
        carry = accs;
        if (diag) {
#pragma unroll
            for (int r = 0; r < 16; ++r) { const int key = 64 * t + crow(r, hi); if (key >= qpos) p0[r] = 0.f; if (key + 32 >= qpos) p1[r] = 0.f; }
        }
        bf16x8 pa[4]; pack_p(pa, p0, p1);
        pv_tile<2>(o, wl + 8192, pa, lane, hi);
        asm volatile("s_waitcnt lgkmcnt(0)" ::: "memory");
        if (__all(carry < -150.0f)) break;
    }
    bf16_t* op = merged + (tokbase + q0w + r32) * DM + h * 64 + 4 * hi;
#pragma unroll
    for (int d0 = 0; d0 < 2; ++d0)
#pragma unroll
        for (int a = 0; a < 4; ++a) { u32x2 w; w.x = pk2(o[d0][4 * a], o[d0][4 * a + 1]); w.y = pk2(o[d0][4 * a + 2], o[d0][4 * a + 3]); *(u32x2*)(op + 32 * d0 + 8 * a) = w; }
}

struct Args { const float* in[18]; float* out; unsigned char* ws; int ph_lo, ph_hi; };
enum { I_X = 0, I_T5, I_ANORM, I_WIN, I_DQN, I_DLAM, I_DSUB, I_CQN, I_CRB, I_WOUT, I_FNORM, I_RGW, I_RGB, I_REW, I_REB, I_WG, I_WU, I_WD };

__device__ __forceinline__ int rowmap(int kind, int n) {
    if (kind == 1) return (n & ~255) + 128 * ((n & 63) >> 5) + 32 * ((n >> 6) & 3) + (n & 31);
    if (kind == 2) return 256 * (n >> 7) + (n & 127);
    if (kind == 3) return 256 * (n >> 7) + 128 + (n & 127);
    return n;
}
__device__ __forceinline__ void transpose_item(const float* W, int K, int N, const float* gain, bf16_t* WT, int kind, int item, int lane) {
    const int nblk = N / 64, kb = item / nblk, nb = item % nblk, k0 = 64 * kb, n0 = 64 * nb;
    const float* src = W + (size_t)k0 * N + n0 + lane;
    float v[64];
#pragma unroll
    for (int k = 0; k < 64; ++k) v[k] = src[(size_t)k * N];
    if (gain) {
#pragma unroll
        for (int k = 0; k < 64; ++k) v[k] *= gain[k0 + k];
    }
    bf16_t* dst = WT + (size_t)rowmap(kind, n0 + lane) * K + k0;
#pragma unroll
    for (int j = 0; j < 8; ++j) { u32x4 o; o.x = pk2(v[8 * j], v[8 * j + 1]); o.y = pk2(v[8 * j + 2], v[8 * j + 3]); o.z = pk2(v[8 * j + 4], v[8 * j + 5]); o.w = pk2(v[8 * j + 6], v[8 * j + 7]);
        *(u32x4*)(dst + 8 * j) = o; }
}
__device__ __forceinline__ float wave_sum(float v) {
#pragma unroll
    for (int o = 1; o < 64; o <<= 1) v += __shfl_xor(v, o);
    return v;
}

__global__ void __launch_bounds__(NWAVES * 64, 2) fwd_kernel(Args args) {
    extern __shared__ __attribute__((aligned(16))) unsigned char lds_raw[];
    LAS unsigned char* lds = (LAS unsigned char*)lds_raw;
    volatile LAS unsigned* MISC = (volatile LAS unsigned*)(lds + MISC_OFF);
    const int G = gridDim.x, bx = blockIdx.x;
    const int vcu = (G % 8 == 0) ? (bx % 8) * (G / 8) + bx / 8 : bx;
    unsigned char* ws0 = args.ws;
    gu32* ctl = (gu32*)(ws0 + WS_CTL);
#define PHASE_LOCALS() \
    unsigned long long zero_ = 0ull; asm volatile("" : "+s"(zero_)); unsigned char* ws = ws0 + zero_; \
    int tid = threadIdx.x; asm volatile("" : "+v"(tid)); \
    const int lane = tid & 63, wave = __builtin_amdgcn_readfirstlane(tid >> 6); \
    const int gw = vcu * NWAVES + wave, NGW = G * NWAVES; \
    float* out = args.out; \
    bf16_t* hb = (bf16_t*)(ws + WS_HB); bf16_t* proj = (bf16_t*)(ws + WS_PROJ); bf16_t* merged = (bf16_t*)(ws + WS_MERGED); \
    bf16_t* hid = (bf16_t*)(ws + WS_HID); bf16_t* ybuf = (bf16_t*)(ws + WS_YBUF); float* rrow = (float*)(ws + WS_RROW); \
    unsigned* slot_of = (unsigned*)(ws + WS_SLOT); int* tok_list = (int*)(ws + WS_TOK); float* gate_list = (float*)(ws + WS_GATE); float* rs_list = (float*)(ws + WS_RS); \
    (void)lane; (void)wave; (void)gw; (void)NGW; (void)out; (void)hb; (void)proj; (void)merged; (void)hid; (void)ybuf; (void)rrow; (void)slot_of; (void)tok_list; (void)gate_list; (void)rs_list;

    if (threadIdx.x < 64) MISC[threadIdx.x] = 0u;
    __syncthreads();
#if MK_N_LAUNCHES == 1
    XcdBarrier bar = xcd_barrier_post((unsigned*)(ctl + CW_BAR), MISC + 40);
#define GRID_BAR() xcd_barrier(bar)
#else
#define GRID_BAR() do {} while (0)
#endif
    const int lo = args.ph_lo, hi_ph = args.ph_hi;
#ifndef PH_MASK
#define PH_MASK 0xff
#endif
#define IN(k) (lo <= (k) && (k) < hi_ph && ((PH_MASK >> ((k) == 0 ? 0 : (((k) - 1) % 7) + 1)) & 1))
#define BOTH(k) (IN(k) && IN((k) + 1))
#ifndef DUP_MASK
#define DUP_MASK 0
#endif
#define REPS(kind) (((DUP_MASK >> (kind)) & 1) ? 2 : 1)

    if (IN(0)) for (int rep_ = 0; rep_ < REPS(0); ++rep_) {
        PHASE_LOCALS();
        constexpr int I_IN = 16 * 48, I_OUT = 16 * 16, I_E = 128;
        constexpr int N_A = DEPTH * I_IN, N_B = DEPTH * I_OUT, N_C = DEPTH * NEXP * I_E;
        constexpr int NITEMS = N_A + N_B + 3 * N_C;
        for (int it = gw; it < NITEMS; it += NGW) {
            int r = it;
            if (r < N_A) { const int l = r / I_IN; transpose_item(args.in[I_WIN] + (size_t)l * DM * QKVW, DM, QKVW, args.in[I_ANORM] + l * DM, (bf16_t*)(ws + WS_WIN) + (size_t)l * QKVW * DM, 1, r % I_IN, lane); continue; } r -= N_A;
            if (r < N_B) { const int l = r / I_OUT; transpose_item(args.in[I_WOUT] + (size_t)l * DM * DM, DM, DM, nullptr, (bf16_t*)(ws + WS_WOUT) + (size_t)l * DM * DM, 0, r % I_OUT, lane); continue; } r -= N_B;
            const int which = r / N_C, r2 = r % N_C, le = r2 / I_E, item = r2 % I_E, l = le / NEXP;
            if (which == 0) transpose_item(args.in[I_WG] + (size_t)le * DM * DEXP, DM, DEXP, args.in[I_FNORM] + l * DM, (bf16_t*)(ws + WS_WGU) + (size_t)le * 1024 * DM, 2, item, lane);
            else if (which == 1) transpose_item(args.in[I_WU] + (size_t)le * DM * DEXP, DM, DEXP, args.in[I_FNORM] + l * DM, (bf16_t*)(ws + WS_WGU) + (size_t)le * 1024 * DM, 3, item, lane);
            else transpose_item(args.in[I_WD] + (size_t)le * DEXP * DM, DEXP, DM, nullptr, (bf16_t*)(ws + WS_WD) + (size_t)le * DM * DEXP, 0, item, lane);
        }
        for (int i = (vcu * NWAVES * 64 + tid); i < DEPTH * 48 * 1024; i += G * NWAVES * 64) {
            const int l = i / (48 * 1024), n = (i / 1024) % 48, k = i % 1024;
            float w = 0.f;
            if (n < 4) w = args.in[I_RGW][((size_t)l * DM + k) * 4 + n]; else if (n < 36) w = args.in[I_REW][((size_t)l * DM + k) * 32 + (n - 4)];
            w *= args.in[I_FNORM][l * DM + k];
            const unsigned hb_ = f2bf(w); const float wl = w - __builtin_bit_cast(float, hb_ << 16);
            ((bf16_t*)(ws + WS_WRH))[i] = (bf16_t)hb_; ((bf16_t*)(ws + WS_WRL))[i] = (bf16_t)f2bf(wl);
        }
        const float* x = args.in[I_X];
        for (int row = gw; row < NTOK; row += NGW) {
            const f32x4* xr = (const f32x4*)(x + (size_t)row * DM) + lane; float ss = 0.f; u32x2* o8 = (u32x2*)(hb + (size_t)row * DM) + lane;
#pragma unroll
            for (int j = 0; j < 4; ++j) { const f32x4 v = xr[64 * j]; ss += (v[0] * v[0] + v[1] * v[1]) + (v[2] * v[2] + v[3] * v[3]); u32x2 w; w.x = pk2(v[0], v[1]); w.y = pk2(v[2], v[3]); o8[64 * j] = w; }
            ss = wave_sum(ss);
            if (lane == 0) rrow[row] = __builtin_amdgcn_rsqf(ss * (1.0f / DM) + EPS);
        }
        if (rep_ == REPS(0) - 1) { if (BOTH(0)) GRID_BAR(); } else __syncthreads();
    }

    for (int l = 0; l < DEPTH; ++l) {
        const int pb = 1 + 7 * l;
        const float lam_init = 0.8f - 0.6f * __expf(-0.3f * (float)l);
        const unsigned* cntl = (const unsigned*)(ctl + CW_CNT) + l * 32 * 64;
        if (IN(pb + 0)) for (int rep_ = 0; rep_ < ((1 == 3 && l != 0) ? 1 : REPS(1)); ++rep_) {
            PHASE_LOCALS();
            pg8::DenseSched S; S.init(NTOK, QKVW, DM, (const bf16_t*)(ws + WS_WIN) + (size_t)l * QKVW * DM, G, bx);
            pg8::EpiWin E{proj, rrow, args.in[I_DQN] + l * 128, args.in[I_CQN] + l * 128};
            pg8::gemm_phase<pg8::EpiWin, pg8::DenseSched>(lds, hb, DM, S, E);
            if (rep_ == ((1 == 3 && l != 0) ? 1 : REPS(1)) - 1) { if (BOTH(pb + 0)) GRID_BAR(); } else __syncthreads();
        }
        if (IN(pb + 1)) for (int rep_ = 0; rep_ < ((2 == 3 && l != 0) ? 1 : REPS(2)); ++rep_) {
            PHASE_LOCALS();
            for (int P = vcu; P < 512; P += G) {
                const int bh = P >> 4, s = P & 15;
                attnB_unit(lds, proj, merged, args.in[I_T5], args.in[I_DLAM] + l * 256, args.in[I_DSUB] + l * 128, lam_init, bh >> 2, bh & 3, 31 - s);
                attnB_unit(lds, proj, merged, args.in[I_T5], args.in[I_DLAM] + l * 256, args.in[I_DSUB] + l * 128, lam_init, bh >> 2, bh & 3, s);
            }
            for (int U = vcu; U < 512; U += G) { const int bh = U >> 4; attnC_unit(lds, proj, merged, args.in[I_CRB] + l * 257 * 4, bh >> 2, bh & 3, U & 15); __syncthreads(); }
            for (int U = vcu; U < 512; U += G) { const int bh = U >> 4; attnA_unit(lds, proj, merged, bh >> 2, bh & 3, U & 15); }
            __syncthreads();
            if (rep_ == ((2 == 3 && l != 0) ? 1 : REPS(2)) - 1) { if (BOTH(pb + 1)) GRID_BAR(); } else __syncthreads();
        }
        if (IN(pb + 2)) for (int rep_ = 0; rep_ < ((3 == 3 && l != 0) ? 1 : REPS(3)); ++rep_) {
            PHASE_LOCALS();
            pg8::DenseSched S; S.init(NTOK, DM, DM, (const bf16_t*)(ws + WS_WOUT) + (size_t)l * DM * DM, G, bx);
            pg8::EpiWout E{l == 0 ? args.in[I_X] : (const float*)out, out};
            pg8::gemm_phase<pg8::EpiWout, pg8::DenseSched>(lds, merged, DM, S, E);
            if (rep_ == ((3 == 3 && l != 0) ? 1 : REPS(3)) - 1) { if (BOTH(pb + 2)) GRID_BAR(); } else __syncthreads();
        }
        if (IN(pb + 3)) {
            PHASE_LOCALS();
            LAS float* lg = (LAS float*)lds;
            LAS float* rrl = (LAS float*)(lds + 128 * 49 * 4);
            LAS int* hist = (LAS int*)(lds + 128 * 49 * 4 + 512);
            const bf16_t* wrh = (const bf16_t*)(ws + WS_WRH) + (size_t)l * 48 * 1024;
            const bf16_t* wrl = (const bf16_t*)(ws + WS_WRL) + (size_t)l * 48 * 1024;
            const float* rgb = args.in[I_RGB] + l * 4; const float* reb = args.in[I_REB] + l * 32;
            const int fr = lane & 15, fq = lane >> 4;
            for (int chunk = vcu; chunk < NTOK / 128; chunk += G) {
                if (tid < 32) hist[tid] = 0;
                const int row = chunk * 128 + wave * 16 + fr;
                const float* hp = out + (size_t)row * DM + 8 * fq;
                f32x4 acc[3]; acc[0] = acc[1] = acc[2] = (f32x4){0.f, 0.f, 0.f, 0.f};
                float ss = 0.f;
#pragma unroll 2
                for (int k0 = 0; k0 < DM; k0 += 32) {
                    const f32x4 x0 = *(const f32x4*)(hp + k0), x1 = *(const f32x4*)(hp + k0 + 4);
                    ss += (x0[0] * x0[0] + x0[1] * x0[1]) + (x0[2] * x0[2] + x0[3] * x0[3]) + (x1[0] * x1[0] + x1[1] * x1[1]) + (x1[2] * x1[2] + x1[3] * x1[3]);
                    u32x4 ah; ah.x = pk2(x0[0], x0[1]); ah.y = pk2(x0[2], x0[3]); ah.z = pk2(x1[0], x1[1]); ah.w = pk2(x1[2], x1[3]);
                    u32x4 al; al.x = pk2(x0[0] - bflo(ah.x), x0[1] - bfhi(ah.x)); al.y = pk2(x0[2] - bflo(ah.y), x0[3] - bfhi(ah.y));
                    al.z = pk2(x1[0] - bflo(ah.z), x1[1] - bfhi(ah.z)); al.w = pk2(x1[2] - bflo(ah.w), x1[3] - bfhi(ah.w));
                    *(u32x4*)(hb + (size_t)row * DM + k0 + 8 * fq) = ah;
                    const bf16x8 aH = __builtin_bit_cast(bf16x8, ah), aL = __builtin_bit_cast(bf16x8, al);
#pragma unroll
                    for (int cbk = 0; cbk < 3; ++cbk) {
                        const bf16x8 bH = *(const bf16x8*)(wrh + (size_t)(cbk * 16 + fr) * DM + k0 + 8 * fq), bL = *(const bf16x8*)(wrl + (size_t)(cbk * 16 + fr) * DM + k0 + 8 * fq);
                        acc[cbk] = __builtin_amdgcn_mfma_f32_16x16x32_bf16(aH, bH, acc[cbk], 0, 0, 0);
                        acc[cbk] = __builtin_amdgcn_mfma_f32_16x16x32_bf16(aH, bL, acc[cbk], 0, 0, 0);
                        acc[cbk] = __builtin_amdgcn_mfma_f32_16x16x32_bf16(aL, bH, acc[cbk], 0, 0, 0);
                    }
                }
                ss += __shfl_xor(ss, 16); ss += __shfl_xor(ss, 32);
                if (fq == 0) rrl[wave * 16 + fr] = __builtin_amdgcn_rsqf(ss * (1.0f / DM) + EPS);
#pragma unroll
                for (int cbk = 0; cbk < 3; ++cbk)
#pragma unroll
                    for (int rg = 0; rg < 4; ++rg) lg[(wave * 16 + 4 * fq + rg) * 49 + cbk * 16 + fr] = acc[cbk][rg];
                __syncthreads();
                int e1 = 0, e2 = 0, lr1 = 0, lr2 = 0; float g1 = 0.f, g2 = 0.f, rr = 0.f;
                if (tid < 128) {
                    rr = rrl[tid];
                    const LAS float* lp = lg + tid * 49;
                    float gl[4]; int gs = 0; float gmax = -3.0e38f;
#pragma unroll
                    for (int i = 0; i < 4; ++i) { gl[i] = lp[i] * rr + rgb[i]; if (gl[i] > gmax) { gmax = gl[i]; gs = i; } }
                    float den = 0.f;
#pragma unroll
                    for (int i = 0; i < 4; ++i) den += __expf(gl[i] - gmax);
                    const float gwt = 1.0f / den;
                    float el[8]; int i1 = 0; float m1 = -3.0e38f;
#pragma unroll
                    for (int i = 0; i < 8; ++i) { el[i] = lp[4 + gs * 8 + i] * rr + reb[gs * 8 + i]; if (el[i] > m1) { m1 = el[i]; i1 = i; } }
                    int i2 = 0; float m2 = -3.0e38f;
#pragma unroll
                    for (int i = 0; i < 8; ++i) { if (i != i1 && el[i] > m2) { m2 = el[i]; i2 = i; } }
                    const float ex = __expf(m2 - m1), p1 = 1.0f / (1.0f + ex), p2 = ex * p1;
                    g1 = gwt * p1; g2 = gwt * p2; e1 = gs * 8 + i1; e2 = gs * 8 + i2;
                    lr1 = __hip_atomic_fetch_add(&hist[e1], 1, __ATOMIC_RELAXED, __HIP_MEMORY_SCOPE_WORKGROUP); lr2 = __hip_atomic_fetch_add(&hist[e2], 1, __ATOMIC_RELAXED, __HIP_MEMORY_SCOPE_WORKGROUP);
                }
                __syncthreads();
                if (tid < 32) { const int c_ = hist[tid]; hist[32 + tid] = c_ ? (int)__hip_atomic_fetch_add((unsigned*)cntl + 64 * tid, (unsigned)c_, __ATOMIC_RELAXED, __HIP_MEMORY_SCOPE_AGENT) : 0; }
                __syncthreads();
                if (tid < 128) {
                    const int tok = chunk * 128 + tid;
                    const int pos1 = hist[32 + e1] + lr1, pos2 = hist[32 + e2] + lr2;
                    tok_list[e1 * ECAP + pos1] = tok; gate_list[e1 * ECAP + pos1] = g1; rs_list[e1 * ECAP + pos1] = rr;
                    tok_list[e2 * ECAP + pos2] = tok; gate_list[e2 * ECAP + pos2] = g2; rs_list[e2 * ECAP + pos2] = rr;
                    slot_of[tok * 2] = ((unsigned)e1 << 16) | (unsigned)pos1; slot_of[tok * 2 + 1] = ((unsigned)e2 << 16) | (unsigned)pos2;
                }
                __syncthreads();
            }
            if (BOTH(pb + 3)) GRID_BAR();
        }
        if (IN(pb + 4) || IN(pb + 5) || IN(pb + 6)) {
            if (threadIdx.x == 0) { int s_ = 0; for (int e = 0; e < 32; ++e) { MISC[e] = (unsigned)s_; s_ += ((int)ld_agent(cntl + 64 * e) + 255) >> 8; } MISC[32] = (unsigned)s_; }
            __syncthreads();
        }
        if (IN(pb + 4)) for (int rep_ = 0; rep_ < ((5 == 3 && l != 0) ? 1 : REPS(5)); ++rep_) {
            PHASE_LOCALS();
            pg8::MoeSched<true> S{(const volatile LAS int*)MISC, cntl, tok_list, (const bf16_t*)(ws + WS_WGU) + (size_t)l * NEXP * 1024 * DM, DM, G, bx};
            pg8::EpiGU E{hid, rs_list};
            pg8::gemm_phase<pg8::EpiGU, pg8::MoeSched<true>>(lds, hb, DM, S, E);
            if (rep_ == ((5 == 3 && l != 0) ? 1 : REPS(5)) - 1) { if (BOTH(pb + 4)) GRID_BAR(); } else __syncthreads();
        }
        if (IN(pb + 5)) for (int rep_ = 0; rep_ < ((6 == 3 && l != 0) ? 1 : REPS(6)); ++rep_) {
            PHASE_LOCALS();
            pg8::MoeSched<false> S{(const volatile LAS int*)MISC, cntl, tok_list, (const bf16_t*)(ws + WS_WD) + (size_t)l * NEXP * DM * DEXP, DEXP, G, bx};
            pg8::EpiDown E{ybuf, gate_list};
            pg8::gemm_phase<pg8::EpiDown, pg8::MoeSched<false>>(lds, hid, DEXP, S, E);
            if (rep_ == ((6 == 3 && l != 0) ? 1 : REPS(6)) - 1) { if (BOTH(pb + 5)) GRID_BAR(); } else __syncthreads();
        }
        if (IN(pb + 6)) {
            PHASE_LOCALS();
            for (int row = gw; row < NTOK; row += NGW) {
                const unsigned s0 = ld_agent(slot_of + row * 2), s1 = ld_agent(slot_of + row * 2 + 1);
                const size_t y0 = (size_t)(MISC[s0 >> 16] * 256u + (s0 & 0xffffu)), y1 = (size_t)(MISC[s1 >> 16] * 256u + (s1 & 0xffffu));
                f32x4* hr = (f32x4*)(out + (size_t)row * DM) + lane;
                const u32x2* ya = (const u32x2*)(ybuf + y0 * DM) + lane; const u32x2* yb = (const u32x2*)(ybuf + y1 * DM) + lane;
                u32x2* o8 = (u32x2*)(hb + (size_t)row * DM) + lane;
                float ss = 0.f;
#pragma unroll
                for (int j = 0; j < 4; ++j) { f32x4 v = hr[64 * j]; const u32x2 a = ya[64 * j], b2 = yb[64 * j];
                    v[0] += bflo(a.x) + bflo(b2.x); v[1] += bfhi(a.x) + bfhi(b2.x); v[2] += bflo(a.y) + bflo(b2.y); v[3] += bfhi(a.y) + bfhi(b2.y);
                    hr[64 * j] = v; ss += (v[0] * v[0] + v[1] * v[1]) + (v[2] * v[2] + v[3] * v[3]);
                    u32x2 w; w.x = pk2(v[0], v[1]); w.y = pk2(v[2], v[3]); o8[64 * j] = w; }
                ss = wave_sum(ss);
                if (lane == 0) rrow[row] = __builtin_amdgcn_rsqf(ss * (1.0f / DM) + EPS);
            }
            if (BOTH(pb + 6)) GRID_BAR();
        }
    }
#undef IN
#undef BOTH
}

extern "C" void kernel_launch(void* const* d_in, const int* in_sizes, int n_in, void* d_out, int out_size, void* d_ws, size_t ws_size, hipStream_t stream) {
    static int grid = 0;
    if (grid == 0) {
        if (n_in != 18 || out_size != NTOK * DM || ws_size < WS_END) { fprintf(stderr, "kernel_launch: unexpected shapes (n_in %d, out %d, ws %zu < %zu)\n", n_in, out_size, ws_size, (size_t)WS_END); grid = -1; return; }
        int dev = 0, cus = 0, per_cu = 0;
        if (hipGetDevice(&dev) != hipSuccess || hipDeviceGetAttribute(&cus, hipDeviceAttributeMultiprocessorCount, dev) != hipSuccess) { grid = -1; return; }
        if (hipFuncSetAttribute((const void*)fwd_kernel, hipFuncAttributeMaxDynamicSharedMemorySize, LDS_BYTES) != hipSuccess) { fprintf(stderr, "kernel_launch: hipFuncSetAttribute failed\n"); grid = -1; return; }
        if (hipOccupancyMaxActiveBlocksPerMultiprocessor(&per_cu, (const void*)fwd_kernel, NWAVES * 64, LDS_BYTES) != hipSuccess || per_cu < 1) fprintf(stderr, "kernel_launch: occupancy query says %d\n", per_cu);
        (void)hipGetLastError();
        grid = cus;
    }
    if (grid < 0) return;
    if (hipMemsetAsync((char*)d_ws + WS_CTL, 0, CTL_ZERO_BYTES, stream) != hipSuccess) return;
    Args a{};
    for (int i = 0; i < 18; ++i) a.in[i] = (const float*)d_in[i];
    a.out = (float*)d_out; a.ws = (unsigned char*)d_ws;
#if MK_N_LAUNCHES == 1
    a.ph_lo = 0; a.ph_hi = NPHASES;
    hipLaunchKernelGGL(fwd_kernel, dim3(grid), dim3(NWAVES * 64), LDS_BYTES, stream, a);
#else
    for (int p = 0; p < NPHASES; ++p) { a.ph_lo = p; a.ph_hi = p + 1; hipLaunchKernelGGL(fwd_kernel, dim3(grid), dim3(NWAVES * 64), LDS_BYTES, stream, a); }
#endif
}
```

```cpp
#include <hip/hip_runtime.h>
#include <cstdio>
#include <cstdint>

#ifndef MK_N_LAUNCHES
#define MK_N_LAUNCHES 1
#endif

#define LAS __attribute__((address_space(3)))
#define GAS __attribute__((address_space(1)))
typedef unsigned short bf16_t;
typedef short bf16x8 __attribute__((ext_vector_type(8)));
typedef short v4i16 __attribute__((ext_vector_type(4)));
typedef float f32x4 __attribute__((ext_vector_type(4)));
typedef float f32x16 __attribute__((ext_vector_type(16)));
typedef unsigned u32x4 __attribute__((ext_vector_type(4)));
typedef unsigned u32x2 __attribute__((ext_vector_type(2)));
typedef float f32x2_t __attribute__((ext_vector_type(2)));
typedef __bf16 bf16x2_t __attribute__((ext_vector_type(2)));
typedef GAS unsigned gu32;

constexpr int DM = 1024, BATCH = 8, SEQ = 4096, NTOK = BATCH * SEQ, DEPTH = 2;
constexpr int QKVW = 3072, NEXP = 32, DEXP = 512, ECAP = 32768;
constexpr int MAXROWS = 73728;
constexpr float EPS = 1e-6f;
constexpr float LOG2E = 1.4426950408889634f;
constexpr float QSCALE = 0.125f * LOG2E;
constexpr int NWAVES = 8;
constexpr int NPHASES = 1 + 7 * DEPTH;

constexpr size_t MiB = 1u << 20;
constexpr size_t WS_CTL = 0, CTL_ZERO_BYTES = 1 * MiB;
constexpr size_t WS_WIN = 1 * MiB;
constexpr size_t WS_WOUT = 13 * MiB;
constexpr size_t WS_WGU = 17 * MiB;
constexpr size_t WS_WD = 145 * MiB;
constexpr size_t WS_WRH = 209 * MiB;
constexpr size_t WS_WRL = WS_WRH + 256 * 1024;
constexpr size_t WS_RROW = 210 * MiB;
constexpr size_t WS_SLOT = WS_RROW + 256 * 1024;
constexpr size_t WS_TOK = 211 * MiB;
constexpr size_t WS_GATE = 215 * MiB;
constexpr size_t WS_RS = 219 * MiB;
constexpr size_t WS_HB = 223 * MiB;
constexpr size_t WS_R = 287 * MiB;
constexpr size_t WS_PROJ = WS_R, WS_MERGED = WS_R + 192 * MiB;
constexpr size_t WS_HID = WS_R;
constexpr size_t WS_YBUF = WS_R + 72 * MiB;
constexpr size_t WS_END = 543 * MiB;
constexpr int CW_BAR = 4096;
constexpr int CW_CNT = 16384;

constexpr int RING_BYTES = 131072;
constexpr int MISC_OFF = RING_BYTES;
constexpr int TB_OFF = RING_BYTES + 1024;
constexpr int LDS_BYTES = 147456;

__device__ __forceinline__ unsigned f2bf(float f) { unsigned u = __builtin_bit_cast(unsigned, f); return (u + 0x7fffu + ((u >> 16) & 1u)) >> 16; }
__device__ __forceinline__ unsigned pk2(float lo, float hi) { f32x2_t v = {lo, hi}; bf16x2_t b = __builtin_convertvector(v, bf16x2_t); return __builtin_bit_cast(unsigned, b); }
__device__ __forceinline__ float bflo(unsigned w) { return __builtin_bit_cast(float, w << 16); }
__device__ __forceinline__ float bfhi(unsigned w) { return __builtin_bit_cast(float, w & 0xffff0000u); }
__device__ __forceinline__ unsigned ld_agent(const unsigned* p) { return __hip_atomic_load(p, __ATOMIC_RELAXED, __HIP_MEMORY_SCOPE_AGENT); }
#define LDS_WAIT() asm volatile("s_waitcnt lgkmcnt(0)" ::: "memory")

#define XB_TMO      128
#define XB_XCNT(j)  (256  + 64 * (j))
#define XB_XSUB(j)  (1280 + 64 * (j))
#define XB_XGEN(j)  (2304 + 64 * (j))
#define XB_TOP      3328
#define XB_TOPGEN   3392
#define XCD_BAR_WORDS 3456
#define XB_SPIN_CAP (1u << 18)
__device__ __forceinline__ unsigned xb_ld(unsigned* p)              { return __hip_atomic_load(p, __ATOMIC_RELAXED, __HIP_MEMORY_SCOPE_AGENT); }
__device__ __forceinline__ unsigned xb_add(unsigned* p, unsigned v) { return __hip_atomic_fetch_add(p, v, __ATOMIC_RELAXED, __HIP_MEMORY_SCOPE_AGENT); }
__device__ __forceinline__ unsigned xb_xcc_id() { return (unsigned)__builtin_amdgcn_s_getreg((3 << 11) | 20) & 0xFu; }
#define XB_SPIN(cond, bar) do { unsigned _sp = 0; while (cond) { __builtin_amdgcn_s_sleep(1); \
    if ((++_sp & 255u) == 0u) { if (xb_ld(&(bar)[XB_TMO])) break; if (_sp > XB_SPIN_CAP) { atomicAdd(&(bar)[XB_TMO], 1u); break; } } } } while (0)
struct XcdBarrier { unsigned* bar; unsigned x; volatile LAS unsigned* st; };
__device__ __forceinline__ XcdBarrier xcd_barrier_post(unsigned* bar, volatile LAS unsigned* st) {
    XcdBarrier b; b.bar = bar; b.x = xb_xcc_id(); b.st = st;
    if (threadIdx.x == 0) (void)xb_add(&bar[XB_XCNT(b.x)], 1u);
    return b;
}
__device__ __forceinline__ void xcd_barrier_complete(unsigned* bar, unsigned x, unsigned& nloc, unsigned& nx) {
    const unsigned G = gridDim.x * gridDim.y * gridDim.z;
    unsigned sum, cnt, mine, sp = 0u;
    for (;;) {
        sum = 0u; cnt = 0u; mine = 0u;
#pragma unroll
        for (unsigned j = 0; j < 16; ++j) { const unsigned c = xb_ld(&bar[XB_XCNT(j)]); sum += c; cnt += (c > 0u) ? 1u : 0u; mine = (j == x) ? c : mine; }
        if (sum == G) break;
        __builtin_amdgcn_s_sleep(1);
        if ((++sp & 255u) == 0u) { if (xb_ld(&bar[XB_TMO])) break; if (sp > XB_SPIN_CAP) { atomicAdd(&bar[XB_TMO], 1u); break; } }
    }
    nloc = mine > 0u ? mine : 1u; nx = cnt > 0u ? cnt : 1u;
}
__device__ __forceinline__ void xcd_barrier(const XcdBarrier& b) {
    asm volatile("s_waitcnt vmcnt(0)" ::: "memory");
    __syncthreads();
    if (threadIdx.x == 0) {
        unsigned* bar = b.bar;
        __builtin_amdgcn_s_waitcnt(0);
        unsigned nloc = b.st[0], nx = b.st[1];
        if (nloc == 0u) { xcd_barrier_complete(bar, b.x, nloc, nx); b.st[0] = nloc; b.st[1] = nx; }
        const unsigned old = xb_add(&bar[XB_XSUB(b.x)], 1u);
        const unsigned gen = old / nloc;
        if (old + 1u == (gen + 1u) * nloc) {
            __builtin_amdgcn_fence(__ATOMIC_RELEASE, "agent");
            asm volatile("s_waitcnt vmcnt(0)" ::: "memory");
            const unsigned og = xb_add(&bar[XB_TOP], 1u);
            const unsigned tg = og / nx;
            if (og + 1u == (tg + 1u) * nx) xb_add(&bar[XB_TOPGEN], 1u);
            else XB_SPIN(xb_ld(&bar[XB_TOPGEN]) == tg, bar);
            __builtin_amdgcn_fence(__ATOMIC_ACQUIRE, "agent");
            xb_add(&bar[XB_XGEN(b.x)], 1u);
            asm volatile("s_waitcnt vmcnt(0)" ::: "memory");
        } else {
            XB_SPIN(xb_ld(&bar[XB_XGEN(b.x)]) == gen, bar);
            __builtin_amdgcn_fence(__ATOMIC_ACQUIRE, "agent");
            asm volatile("s_waitcnt vmcnt(0)" ::: "memory");
        }
    }
    __syncthreads();
}

namespace pg8 {
constexpr int BM = 256, BK = 64, HALF = 128, HTB = HALF * BK * 2, STAGE_BYTES = 8 * HTB, NXCD = 8, WGM = 8;
__device__ __forceinline__ int lds_byte(int r, int c) { const int st = (r >> 4) * 2 + (c >> 5), rr = r & 15, cc = c & 31, ob = rr * 64 + cc * 2; return st * 1024 + (ob ^ (((ob >> 9) & 1) << 5)); }
__device__ __forceinline__ void stage_rc(int b, int& R, int& C) { const int st = b / 1024, sb = b % 1024, swz = sb ^ (((sb >> 9) & 1) << 5); R = (st >> 1) * 16 + swz / 64; C = (st & 1) * 32 + (swz % 64) / 2; }
__device__ __forceinline__ int perm32(int rho) { const int n = rho >> 4, i = rho & 15; return 8 * (i >> 2) + 4 * n + (i & 3); }

struct Unit { int pm, pn, e, t0, cnt; };

struct DenseSched {
    static constexpr bool GATHER = false;
    int nM, nN, nwg, G, c, K; const bf16_t* Bt;
    __device__ void init(int M, int N, int K_, const bf16_t* Bt_, int G_, int c_) { nM = M / BM; nN = N / BM; nwg = nM * nN; G = G_; c = c_; K = K_; Bt = Bt_; }
    __device__ __forceinline__ bool next(int i, Unit& u) const {
        const long L = (long)i * G + c; if (L >= nwg) return false;
        int wgid = (int)L; { const int q = nwg / NXCD, r = nwg % NXCD, xcd = wgid % NXCD, off = wgid / NXCD; wgid = (xcd < r ? xcd * (q + 1) : r * (q + 1) + (xcd - r) * q) + off; }
        const int nig = WGM * nN, gid = wgid / nig, fm = gid * WGM, gsz = (nM - fm) < WGM ? (nM - fm) : WGM;
        u.pm = fm + ((wgid % nig) % gsz); u.pn = (wgid % nig) / gsz; u.e = 0; u.t0 = 0; u.cnt = 0; return true;
    }
    __device__ __forceinline__ int arow(const Unit& u, int r) const { return u.pm * BM + r; }
    __device__ __forceinline__ const bf16_t* bptr(const Unit& u) const { return Bt + (size_t)u.pn * BM * K; }
};
template <bool GATHER_> struct MoeSched {
    static constexpr bool GATHER = GATHER_;
    const volatile LAS int* pre; const unsigned* cnt; const int* tok; const bf16_t* W; int K, G, c;
    __device__ __forceinline__ bool next(int i, Unit& u) const {
        const int L = i * G + c, T = L >> 2; const int ntile = __builtin_amdgcn_readfirstlane(pre[32]);
        if (T >= ntile) return false;
        int e = 0; while (__builtin_amdgcn_readfirstlane(pre[e + 1]) <= T) ++e;
        u.e = e; u.pm = T; u.pn = L & 3; u.t0 = (T - __builtin_amdgcn_readfirstlane(pre[e])) * BM; u.cnt = __builtin_amdgcn_readfirstlane((int)ld_agent(cnt + 64 * e)); return true;
    }
    __device__ __forceinline__ int arow(const Unit& u, int r) const {
        if (GATHER_) { const int pos = u.t0 + r; return pos < u.cnt ? tok[u.e * ECAP + pos] : 0; }
        return u.pm * BM + r;
    }
    __device__ __forceinline__ const bf16_t* bptr(const Unit& u) const { return W + ((size_t)u.e * 1024 + (size_t)u.pn * BM) * K; }
};

template <class Epi, class Sched>
__device__ __forceinline__ void gemm_phase(LAS unsigned char* lds, const bf16_t* Abase_, int K, const Sched& S, const Epi& E) {
    int tid = threadIdx.x; asm volatile("" : "+v"(tid));
    const int wid = __builtin_amdgcn_readfirstlane(tid >> 6), lane = tid & 63, wr = wid >> 2, wc = wid & 3, fr = lane & 15, fq = lane >> 4;
    constexpr bool GATHER = Sched::GATHER;
    const int nt = K / BK;
    int Rs[2], Cs[2]; unsigned voffA[2], voffB[2];
#pragma unroll
    for (int i = 0; i < 2; ++i) { int R, C; stage_rc(tid * 16 + i * 8192, R, C); Rs[i] = R; Cs[i] = C; const int Rb = Epi::PERM ? ((R & ~31) + perm32(R & 31)) : R;
        voffA[i] = (unsigned)(R * K + C) * 2u; voffB[i] = (unsigned)(Rb * K + C) * 2u; }
    const size_t kstep = (size_t)(BK * 2);
    const size_t hstep = (size_t)HALF * K * 2;
    const unsigned ldsw = (unsigned)wid * 1024u;
    const char* Abase = (const char*)Abase_;
    const int aoff = lds_byte(wr * 64 + fr, fq * 8), boff = lds_byte(wc * 32 + fr, fq * 8);
#define PG8_SA(b, h) (((b) * 2 + (h)) * HTB)
#define PG8_SB(b, h) ((4 + (b) * 2 + (h)) * HTB)
#define PG8_STAGE(bufoff, gbase, v0, v1) do { \
        __builtin_amdgcn_global_load_lds((const unsigned*)((const char*)(gbase) + (v0)), (LAS unsigned*)(lds + (bufoff) + ldsw), 16, 0, 0); \
        __builtin_amdgcn_global_load_lds((const unsigned*)((const char*)(gbase) + (v1)), (LAS unsigned*)(lds + (bufoff) + ldsw + 8192), 16, 0, 0); } while (0)
#define PG8_STAGE_AC(bufoff, h, koff) do { if constexpr (GATHER) PG8_STAGE(bufoff, Abase + (koff), cA[h][0], cA[h][1]); else PG8_STAGE(bufoff, cAp + (h) * hstep + (koff), voffA[0], voffA[1]); } while (0)
#define PG8_STAGE_AX(bufoff, h, koff) do { if constexpr (GATHER) PG8_STAGE(bufoff, a2p + (koff), (h) ? x10 : x00, (h) ? x11 : x01); else PG8_STAGE(bufoff, a2p + (h) * hstep + (koff), voffA[0], voffA[1]); } while (0)
#define PG8_STAGE_B(bufoff, gbase) PG8_STAGE(bufoff, gbase, voffB[0], voffB[1])
#define PG8_LDA(dst, b, h) do { _Pragma("unroll") for (int m = 0; m < 4; ++m) _Pragma("unroll") for (int k = 0; k < 2; ++k) dst[m][k] = *(const LAS bf16x8*)(lds + PG8_SA(b, h) + aoff + m * 2048 + k * 1024); } while (0)
#define PG8_LDB(dst, b, h) do { _Pragma("unroll") for (int n = 0; n < 2; ++n) _Pragma("unroll") for (int k = 0; k < 2; ++k) dst[n][k] = *(const LAS bf16x8*)(lds + PG8_SB(b, h) + boff + n * 2048 + k * 1024); } while (0)
#define PG8_MMA(ai, bj, At, Bt) do { __builtin_amdgcn_s_setprio(1); _Pragma("unroll") for (int m = 0; m < 4; ++m) _Pragma("unroll") for (int n = 0; n < 2; ++n) _Pragma("unroll") for (int k = 0; k < 2; ++k) \
        acc[ai][bj][m][n] = __builtin_amdgcn_mfma_f32_16x16x32_bf16(Bt[n][k], At[m][k], acc[ai][bj][m][n], 0, 0, 0); __builtin_amdgcn_s_setprio(0); } while (0)
#define PG8_WAIT_V(n) asm volatile("s_waitcnt vmcnt(" #n ")" ::: "memory")
#define PG8_WAIT_L(n) asm volatile("s_waitcnt lgkmcnt(" #n ")" ::: "memory")
#define PG8_BAR __builtin_amdgcn_s_barrier()
#define PG8_SCHED __builtin_amdgcn_sched_barrier(0)
#define PG8_MKA(dst, u) do { _Pragma("unroll") for (int h_ = 0; h_ < 2; ++h_) _Pragma("unroll") for (int i_ = 0; i_ < 2; ++i_) dst[h_][i_] = ((unsigned)S.arow(u, h_ * HALF + Rs[i_]) * (unsigned)K + (unsigned)Cs[i_]) * 2u; } while (0)
    Unit cur, nxt; int ui = 0;
    if (!S.next(0, cur)) return;
    f32x4 acc[2][2][4][2];
#pragma unroll
    for (int a = 0; a < 2; ++a)
#pragma unroll
        for (int b = 0; b < 2; ++b)
#pragma unroll
            for (int m = 0; m < 4; ++m)
#pragma unroll
                for (int n = 0; n < 2; ++n) acc[a][b][m][n] = (f32x4){0.f, 0.f, 0.f, 0.f};
    bf16x8 At[4][2], B0[2][2], B1[2][2];
    unsigned cA[2][2] = {{0u, 0u}, {0u, 0u}}, nA[2][2] = {{0u, 0u}, {0u, 0u}};
    const char* cAp = Abase; const char* nAp = Abase;
    if constexpr (GATHER) { PG8_MKA(cA, cur); } else { cAp = Abase + (size_t)S.arow(cur, 0) * K * 2; }
    const char* cB = (const char*)S.bptr(cur);
    PG8_STAGE_B(PG8_SB(0, 0), cB); PG8_STAGE_B(PG8_SB(0, 1), cB + hstep); PG8_STAGE_AC(PG8_SA(0, 0), 0, 0); PG8_STAGE_AC(PG8_SA(0, 1), 1, 0);
    if (wr == 1) PG8_BAR;
    PG8_WAIT_V(2); PG8_BAR;
    PG8_STAGE_B(PG8_SB(1, 0), cB + kstep); PG8_STAGE_AC(PG8_SA(1, 0), 0, kstep); PG8_STAGE_B(PG8_SB(1, 1), cB + hstep + kstep);
    PG8_WAIT_V(6); PG8_BAR;
    for (;;) {
        const bool has_next = S.next(ui + 1, nxt);
        const char* nB = cB; nAp = cAp;
        if (has_next) { nB = (const char*)S.bptr(nxt); if constexpr (GATHER) { PG8_MKA(nA, nxt); } else { nAp = Abase + (size_t)S.arow(nxt, 0) * K * 2; } }
        else { if constexpr (GATHER) {
#pragma unroll
            for (int h_ = 0; h_ < 2; ++h_)
#pragma unroll
                for (int i_ = 0; i_ < 2; ++i_) nA[h_][i_] = cA[h_][i_]; } }
        for (int t = 0; t < nt; t += 2) {
            const bool last = (t == nt - 2);
            const size_t k1 = (size_t)(t + 1) * kstep, k2 = last ? (size_t)0 : (size_t)(t + 2) * kstep;
            const char* a2p = (GATHER ? Abase : (last ? nAp : cAp)) + k2; const char* b2 = (last ? nB : cB) + k2;
            const char* b3 = b2 + kstep;
            const unsigned x00 = last ? nA[0][0] : cA[0][0], x01 = last ? nA[0][1] : cA[0][1], x10 = last ? nA[1][0] : cA[1][0], x11 = last ? nA[1][1] : cA[1][1];
            PG8_LDB(B0, 0, 0); PG8_LDB(B1, 0, 1); PG8_SCHED; PG8_LDA(At, 0, 0); PG8_STAGE_AC(PG8_SA(1, 1), 1, k1);
            PG8_WAIT_V(8); PG8_WAIT_L(0); PG8_BAR; PG8_MMA(0, 0, At, B0); PG8_MMA(0, 1, At, B1); PG8_BAR; PG8_SCHED;
            PG8_LDA(At, 0, 1); PG8_STAGE_B(PG8_SB(0, 0), b2); PG8_STAGE_B(PG8_SB(0, 1), b2 + hstep); PG8_STAGE_AX(PG8_SA(0, 0), 0, 0);
            PG8_WAIT_V(8); PG8_WAIT_L(0); PG8_BAR; PG8_MMA(1, 0, At, B0); PG8_MMA(1, 1, At, B1); PG8_BAR; PG8_SCHED;
            PG8_LDB(B0, 1, 0); PG8_LDB(B1, 1, 1); PG8_SCHED; PG8_LDA(At, 1, 0); PG8_STAGE_AX(PG8_SA(0, 1), 1, 0);
            PG8_WAIT_V(8); PG8_WAIT_L(0); PG8_BAR; PG8_MMA(0, 0, At, B0); PG8_MMA(0, 1, At, B1); PG8_BAR; PG8_SCHED;
            PG8_LDA(At, 1, 1); PG8_STAGE_B(PG8_SB(1, 0), b3); PG8_STAGE_B(PG8_SB(1, 1), b3 + hstep); PG8_STAGE_AX(PG8_SA(1, 0), 0, kstep);
            PG8_WAIT_V(8); PG8_WAIT_L(0); PG8_BAR; PG8_MMA(1, 0, At, B0); PG8_MMA(1, 1, At, B1); PG8_BAR; PG8_SCHED;
        }
        if (wr == 0) PG8_BAR;
        E(acc, cur, wr, wc, fr, fq);
        if (!has_next) break;
#pragma unroll
        for (int a = 0; a < 2; ++a)
#pragma unroll
            for (int b = 0; b < 2; ++b)
#pragma unroll
                for (int m = 0; m < 4; ++m)
#pragma unroll
                    for (int n = 0; n < 2; ++n) acc[a][b][m][n] = (f32x4){0.f, 0.f, 0.f, 0.f};
        cur = nxt; cB = nB; cAp = nAp; ++ui;
        if constexpr (GATHER) {
#pragma unroll
        for (int h_ = 0; h_ < 2; ++h_)
#pragma unroll
            for (int i_ = 0; i_ < 2; ++i_) cA[h_][i_] = nA[h_][i_]; }
        if (wr == 1) PG8_BAR;
    }
    PG8_WAIT_V(0);
    PG8_BAR;
#undef PG8_SA
#undef PG8_SB
#undef PG8_STAGE
#undef PG8_STAGE_AC
#undef PG8_STAGE_AX
#undef PG8_STAGE_B
#undef PG8_LDA
#undef PG8_LDB
#undef PG8_MMA
#undef PG8_WAIT_V
#undef PG8_WAIT_L
#undef PG8_BAR
#undef PG8_SCHED
#undef PG8_MKA
}

struct EpiWin {
    static constexpr bool PERM = true;
    bf16_t* proj; const float* rrow; const float* dqn; const float* cqn;
    __device__ __forceinline__ void operator()(const f32x4 (&acc)[2][2][4][2], const Unit& u, int wr, int wc, int fr, int fq) const {
        const int pn = u.pn;
        const float* g = nullptr;
        if (pn == 3 || pn == 4) g = dqn; else if (pn == 5 || pn == 6) g = dqn + 64; else if (pn == 9) g = cqn; else if (pn == 10) g = cqn + 64;
        const float qs = (pn == 0 || pn == 3 || pn == 4 || pn == 9) ? QSCALE : 1.0f;
        f32x4 gv[2][2];
#pragma unroll
        for (int bj = 0; bj < 2; ++bj)
#pragma unroll
            for (int n = 0; n < 2; ++n) { f32x4 t = g ? *(const f32x4*)(g + 32 * bj + 8 * fq + 4 * n) : (f32x4){1.f, 1.f, 1.f, 1.f}; gv[bj][n] = t * qs; }
        const bool donorm = (g != nullptr);
#pragma unroll
        for (int ai = 0; ai < 2; ++ai)
#pragma unroll
            for (int m = 0; m < 4; ++m) {
                const int row = u.pm * BM + ai * HALF + wr * 64 + m * 16 + fr;
                const float rs = rrow[row];
                f32x4 v[2][2]; float ss = 0.f;
#pragma unroll
                for (int bj = 0; bj < 2; ++bj)
#pragma unroll
                    for (int n = 0; n < 2; ++n) { v[bj][n] = acc[ai][bj][m][n] * rs; const f32x4 q = v[bj][n] * v[bj][n]; ss += (q[0] + q[1]) + (q[2] + q[3]); }
                float rn = 1.0f;
                if (donorm) { ss += __shfl_xor(ss, 16); ss += __shfl_xor(ss, 32); rn = __builtin_amdgcn_rsqf(ss * (1.0f / 64.0f) + EPS); }
                bf16_t* rowp = proj + (size_t)row * QKVW + pn * BM + 64 * wc + 8 * fq;
#pragma unroll
                for (int bj = 0; bj < 2; ++bj) { const f32x4 a = v[bj][0] * rn * gv[bj][0], b = v[bj][1] * rn * gv[bj][1];
                    u32x4 w; w.x = pk2(a[0], a[1]); w.y = pk2(a[2], a[3]); w.z = pk2(b[0], b[1]); w.w = pk2(b[2], b[3]);
                    *(u32x4*)(rowp + 32 * bj) = w; }
            }
    }
};
struct EpiWout {
    static constexpr bool PERM = true;
    bf16_t* h;
    __device__ __forceinline__ void operator()(const f32x4 (&acc)[2][2][4][2], const Unit& u, int wr, int wc, int fr, int fq) const {
#pragma unroll
        for (int ai = 0; ai < 2; ++ai)
#pragma unroll
            for (int m = 0; m < 4; ++m) { bf16_t* rowp = h + (size_t)(u.pm * BM + ai * HALF + wr * 64 + m * 16 + fr) * DM + u.pn * BM + wc * 32 + 8 * fq;
#pragma unroll
                for (int bj = 0; bj < 2; ++bj) { const u32x4 b = *(const u32x4*)(rowp + bj * HALF); const f32x4 a0 = acc[ai][bj][m][0], a1 = acc[ai][bj][m][1];
                    u32x4 w; w.x = pk2(bflo(b.x) + a0[0], bfhi(b.x) + a0[1]); w.y = pk2(bflo(b.y) + a0[2], bfhi(b.y) + a0[3]); w.z = pk2(bflo(b.z) + a1[0], bfhi(b.z) + a1[1]); w.w = pk2(bflo(b.w) + a1[2], bfhi(b.w) + a1[3]);
                    *(u32x4*)(rowp + bj * HALF) = w; }
                if (m & 1) asm volatile("" ::: "memory"); }
    }
};
struct EpiGU {
    static constexpr bool PERM = true;
    bf16_t* hid; const float* rsl;
    __device__ __forceinline__ void operator()(const f32x4 (&acc)[2][2][4][2], const Unit& u, int wr, int wc, int fr, int fq) const {
#pragma unroll
        for (int ai = 0; ai < 2; ++ai)
#pragma unroll
            for (int m = 0; m < 4; ++m) {
                const int rl = ai * HALF + wr * 64 + m * 16 + fr, pos = u.t0 + rl;
                const float rs = pos < u.cnt ? rsl[u.e * ECAP + pos] : 0.f;
                float o[8];
#pragma unroll
                for (int n = 0; n < 2; ++n)
#pragma unroll
                    for (int i = 0; i < 4; ++i) { const float gt = acc[ai][0][m][n][i] * rs, up = acc[ai][1][m][n][i] * rs;
                        const float sg = gt * __builtin_amdgcn_rcpf(1.0f + __builtin_amdgcn_exp2f(-gt * LOG2E)); o[n * 4 + i] = sg * up; }
                u32x4 w; w.x = pk2(o[0], o[1]); w.y = pk2(o[2], o[3]); w.z = pk2(o[4], o[5]); w.w = pk2(o[6], o[7]);
                *(u32x4*)(hid + (size_t)(u.pm * BM + rl) * DEXP + u.pn * HALF + 32 * wc + 8 * fq) = w;
            }
    }
};
struct EpiDown {
    static constexpr bool PERM = true;
    bf16_t* ybuf; const float* gl;
    __device__ __forceinline__ void operator()(const f32x4 (&acc)[2][2][4][2], const Unit& u, int wr, int wc, int fr, int fq) const {
#pragma unroll
        for (int ai = 0; ai < 2; ++ai)
#pragma unroll
            for (int m = 0; m < 4; ++m) {
                const int rl = ai * HALF + wr * 64 + m * 16 + fr, pos = u.t0 + rl;
                const float gt = pos < u.cnt ? gl[u.e * ECAP + pos] : 0.f;
                bf16_t* rowp = ybuf + (size_t)(u.pm * BM + rl) * DM + u.pn * BM + wc * 32 + 8 * fq;
#pragma unroll
                for (int bj = 0; bj < 2; ++bj) { const f32x4 a = acc[ai][bj][m][0] * gt, b = acc[ai][bj][m][1] * gt;
                    u32x4 w; w.x = pk2(a[0], a[1]); w.y = pk2(a[2], a[3]); w.z = pk2(b[0], b[1]); w.w = pk2(b[2], b[3]);
                    *(u32x4*)(rowp + bj * HALF) = w; }
            }
    }
};
}

__device__ __forceinline__ void glds16_asm(const void* gsrc, unsigned lds_dst) {
    unsigned keep;
    asm volatile("s_mov_b32 %0, m0\n\ts_mov_b32 m0, %2\n\ts_nop 0\n\tglobal_load_lds_dwordx4 %1, off\n\ts_mov_b32 m0, %0" : "=&s"(keep) : "v"(gsrc), "s"(lds_dst) : "memory");
}
__device__ __forceinline__ int crow(int r, int hi) { return (r & 3) + 8 * (r >> 2) + 4 * hi; }
__device__ __forceinline__ v4i16 vtr(const LAS unsigned char* p) { return __builtin_amdgcn_ds_read_tr16_b64_v4i16((LAS v4i16*)p); }
__device__ __forceinline__ bf16x8 mk8(v4i16 lo, v4i16 hi) { return (bf16x8){lo[0], lo[1], lo[2], lo[3], hi[0], hi[1], hi[2], hi[3]}; }
__device__ __forceinline__ void qk_tile(f32x16& p0, f32x16& p1, const LAS unsigned char* kt, const bf16x8* qr, int r32, int hi) {
    const int x = (r32 >> 1) & 7, y = x >> 1;
    const LAS unsigned char* kb = kt + r32 * 128 + ((hi ^ (x & 1)) << 4);
#pragma unroll
    for (int d0 = 0; d0 < 4; ++d0) {
        const bf16x8 a0 = *(const LAS bf16x8*)(kb + ((d0 ^ y) << 5)), a1 = *(const LAS bf16x8*)(kb + ((d0 ^ y) << 5) + 4096);
        p0 = __builtin_amdgcn_mfma_f32_32x32x16_bf16(a0, qr[d0], p0, 0, 0, 0);
        p1 = __builtin_amdgcn_mfma_f32_32x32x16_bf16(a1, qr[d0], p1, 0, 0, 0);
    }
}
template <int ND> __device__ __forceinline__ void pv_tile(f32x16* o, const LAS unsigned char* vt, const bf16x8* pa, int lane, int hi) {
    const LAS unsigned char* vb = vt + ((lane >> 4) & 1) * 32 + (lane & 3) * 8 + (4 * hi + ((lane & 15) >> 2)) * 64;
#pragma unroll
    for (int d0 = 0; d0 < ND; ++d0) {
        v4i16 lo[4], h2[4];
#pragma unroll
        for (int ks = 0; ks < 4; ++ks) { lo[ks] = vtr(vb + d0 * 4096 + ks * 1024); h2[ks] = vtr(vb + d0 * 4096 + ks * 1024 + 512); }
#pragma unroll
        for (int ks = 0; ks < 4; ++ks) o[d0] = __builtin_amdgcn_mfma_f32_32x32x16_bf16(mk8(lo[ks], h2[ks]), pa[ks], o[d0], 0, 0, 0);
        __builtin_amdgcn_sched_barrier(0);
    }
}
__device__ __forceinline__ void pack_p(bf16x8* pa, const f32x16& p0, const f32x16& p1) {
    u32x4 w;
    w.x = pk2(p0[0], p0[1]); w.y = pk2(p0[2], p0[3]); w.z = pk2(p0[4], p0[5]); w.w = pk2(p0[6], p0[7]); pa[0] = __builtin_bit_cast(bf16x8, w);
    w.x = pk2(p0[8], p0[9]); w.y = pk2(p0[10], p0[11]); w.z = pk2(p0[12], p0[13]); w.w = pk2(p0[14], p0[15]); pa[1] = __builtin_bit_cast(bf16x8, w);
    w.x = pk2(p1[0], p1[1]); w.y = pk2(p1[2], p1[3]); w.z = pk2(p1[4], p1[5]); w.w = pk2(p1[6], p1[7]); pa[2] = __builtin_bit_cast(bf16x8, w);
    w.x = pk2(p1[8], p1[9]); w.y = pk2(p1[10], p1[11]); w.z = pk2(p1[12], p1[13]); w.w = pk2(p1[14], p1[15]); pa[3] = __builtin_bit_cast(bf16x8, w);
}
#define SM_THR 8.0f
template <int ND> __device__ __forceinline__ void sm_update(f32x16& p0, f32x16& p1, float& mref, float& l, f32x16* o, f32x16& cm, float cb, bool first) {
    float a = __builtin_fmaxf(__builtin_fmaxf(p0[0], p0[1]), p1[0]), b = __builtin_fmaxf(__builtin_fmaxf(p0[2], p0[3]), p1[1]); a = __builtin_fmaxf(__builtin_fmaxf(a, p1[2]), p1[3]);
#pragma unroll
    for (int r = 4; r < 16; r += 4) { a = __builtin_fmaxf(__builtin_fmaxf(a, p0[r]), p0[r + 1]); b = __builtin_fmaxf(__builtin_fmaxf(b, p0[r + 2]), p0[r + 3]);
        a = __builtin_fmaxf(__builtin_fmaxf(a, p1[r]), p1[r + 1]); b = __builtin_fmaxf(__builtin_fmaxf(b, p1[r + 2]), p1[r + 3]); }
    float mx = __builtin_fmaxf(a, b);
    if (first) {
        mx = __builtin_fmaxf(mx, __shfl_xor(mx, 32));
        mref = mx;
#pragma unroll
        for (int r = 0; r < 16; ++r) { p0[r] -= mx; p1[r] -= mx; cm[r] = cb - mx; }
    } else if (__any(mx > SM_THR)) {
        mx = __builtin_fmaxf(mx, __shfl_xor(mx, 32));
        const float d = __builtin_fmaxf(mx, 0.f);
        mref += d;
        const float alpha = __builtin_amdgcn_exp2f(-d);
        l *= alpha;
#pragma unroll
        for (int r = 0; r < 16; ++r) { p0[r] -= d; p1[r] -= d; cm[r] = cb - mref; }
#pragma unroll
        for (int d0 = 0; d0 < ND; ++d0)
#pragma unroll
            for (int r = 0; r < 16; ++r) o[d0][r] *= alpha;
    }
    float s0 = 0.f, s1 = 0.f;
#pragma unroll
    for (int r = 0; r < 16; ++r) { p0[r] = __builtin_amdgcn_exp2f(p0[r]); p1[r] = __builtin_amdgcn_exp2f(p1[r]); s0 += p0[r]; s1 += p1[r]; }
    l += s0 + s1;
}
__device__ __forceinline__ void qk_tile_c(f32x16& p0, f32x16& p1, const LAS unsigned char* kt, const bf16x8* qr, const f32x16& cm, int r32, int hi) {
    const int x = (r32 >> 1) & 7;
    const LAS unsigned char* kb = kt + r32 * 128 + ((hi ^ (x & 1)) << 4);
    const int y = x >> 1;
    bf16x8 kf[8];
#pragma unroll
    for (int d0 = 0; d0 < 4; ++d0) { kf[2 * d0] = *(const LAS bf16x8*)(kb + ((d0 ^ y) << 5)); kf[2 * d0 + 1] = *(const LAS bf16x8*)(kb + ((d0 ^ y) << 5) + 4096); }
    __builtin_amdgcn_sched_barrier(0);
    p0 = __builtin_amdgcn_mfma_f32_32x32x16_bf16(kf[0], qr[0], cm, 0, 0, 0); p1 = __builtin_amdgcn_mfma_f32_32x32x16_bf16(kf[1], qr[0], cm, 0, 0, 0);
#pragma unroll
    for (int d0 = 1; d0 < 4; ++d0) { p0 = __builtin_amdgcn_mfma_f32_32x32x16_bf16(kf[2 * d0], qr[d0], p0, 0, 0, 0); p1 = __builtin_amdgcn_mfma_f32_32x32x16_bf16(kf[2 * d0 + 1], qr[d0], p1, 0, 0, 0); }
}
__device__ __forceinline__ void v_read8(v4i16* vf, const LAS unsigned char* vb, int d0) {
#pragma unroll
    for (int ks = 0; ks < 4; ++ks) { vf[2 * ks] = vtr(vb + d0 * 4096 + ks * 1024); vf[2 * ks + 1] = vtr(vb + d0 * 4096 + ks * 1024 + 512); }
}
__device__ __forceinline__ void pv_block(f32x16& o, const v4i16* vf, const bf16x8* pa) {
#pragma unroll
    for (int ks = 0; ks < 4; ++ks) o = __builtin_amdgcn_mfma_f32_32x32x16_bf16(mk8(vf[2 * ks], vf[2 * ks + 1]), pa[ks], o, 0, 0, 0);
}
template <int ND> __device__ __forceinline__ void attn_s1(const LAS unsigned char* kt, const bf16x8* qr, f32x16& cm, float cb, const LAS float* tp, bool near, bool first,
                                                          float& mref, float& l, f32x16* o, bf16x8* pa, int r32, int hi) {
    f32x16 p0, p1;
    qk_tile_c(p0, p1, kt, qr, cm, r32, hi);
    if (near) {
#pragma unroll
        for (int r = 0; r < 16; ++r) { p0[r] += tp[(r & 3) + 8 * (r >> 2)]; p1[r] += tp[(r & 3) + 8 * (r >> 2) + 32]; }
    }
    sm_update<ND>(p0, p1, mref, l, o, cm, cb, first);
    pack_p(pa, p0, p1);
}
template <int ND> __device__ __forceinline__ void attn_s2(const LAS unsigned char* vt, const bf16x8* pa, f32x16* o, int lane, int hi) {
    const LAS unsigned char* vb = vt + ((lane >> 4) & 1) * 32 + (lane & 3) * 8 + (4 * hi + ((lane & 15) >> 2)) * 64;
    v4i16 va[8], vc[8];
    v_read8(va, vb, 0);
#pragma unroll
    for (int d0 = 0; d0 < ND; d0 += 2) {
        if (d0 + 1 < ND) v_read8(vc, vb, d0 + 1);
        __builtin_amdgcn_sched_barrier(0);
        pv_block(o[d0], va, pa);
        __builtin_amdgcn_sched_barrier(0);
        if (d0 + 2 < ND) v_read8(va, vb, d0 + 2);
        __builtin_amdgcn_sched_barrier(0);
        if (d0 + 1 < ND) pv_block(o[d0 + 1], vc, pa);
        __builtin_amdgcn_sched_barrier(0);
    }
}
__device__ __forceinline__ int t5_bucket_past_or_future(int rel) {
    const int n = rel < 0 ? -rel : rel;
    int v;
    if (n < 8) v = n;
    else v = 8 + (n >= 13) + (n >= 20) + (n >= 30) + (n >= 46) + (n >= 70) + (n >= 108) + (n >= 166);
    return (rel > 0 ? 16 : 0) + v;
}

__device__ __forceinline__ void attnB_unit(LAS unsigned char* lds, const bf16_t* proj, bf16_t* merged, const float* t5_bias, const float* dlam, const float* subln, float lam_init, int b, int h, int qb, bool kvdummy = false) {
    int tid = threadIdx.x; asm volatile("" : "+v"(tid)); const int lane = tid & 63, r32 = lane & 31, hi = lane >> 5; const int wid = __builtin_amdgcn_readfirstlane(tid >> 6);
    const int m = wid >> 2, s = wid & 3, q0w = qb * 128 + s * 32;
    const size_t tokbase = (size_t)b * SEQ;
    LAS float* tb = (LAS float*)(lds + TB_OFF);
    const float cb = t5_bias[15 * 4 + h] * LOG2E;
    for (int i = tid; i < 324; i += NWAVES * 64) tb[i] = t5_bias[t5_bucket_past_or_future(i - 260) * 4 + h] * LOG2E - cb;
    float lam;
    { float a = dlam[lane] * dlam[64 + lane], c = dlam[128 + lane] * dlam[192 + lane];
#pragma unroll
      for (int o_ = 1; o_ < 64; o_ <<= 1) { a += __shfl_xor(a, o_); c += __shfl_xor(c, o_); }
      lam = __expf(a) - __expf(c) + lam_init; }
    bf16x8 qr[4];
    { const bf16_t* qp = proj + (tokbase + q0w + r32) * QKVW + 768 + h * 128 + m * 64 + hi * 8;
#pragma unroll
      for (int d0 = 0; d0 < 4; ++d0) qr[d0] = *(const bf16x8*)(qp + d0 * 16); }
    const int ntiles = 2 * qb + 2, mylast = q0w >> 6;
    const int pid0 = wid, pid1 = wid + 8;
    const int kkey = 8 * wid + (lane >> 3), kch = (lane & 7) ^ ((kkey >> 1) & 7);
    const size_t tokkv = kvdummy ? (size_t)0 : tokbase; const int hkv = kvdummy ? 0 : h;
    const bf16_t* srcK1 = proj + (tokkv + kkey) * QKVW + 1280 + hkv * 128 + 8 * kch;
    const bf16_t* srcK2 = srcK1 + 64;
    const bf16_t* srcV0 = proj + (tokkv + 16 * (pid0 & 3) + (lane >> 2)) * QKVW + 1792 + hkv * 128 + 32 * (pid0 >> 2) + 8 * (lane & 3);
    const bf16_t* srcV1 = proj + (tokkv + 16 * (pid1 & 3) + (lane >> 2)) * QKVW + 1792 + hkv * 128 + 32 * (pid1 >> 2) + 8 * (lane & 3);
    const size_t tstep = (size_t)64 * QKVW;
#define GLDS16(src, dstoff) glds16_asm((const void*)(src), (unsigned)__builtin_amdgcn_readfirstlane((int)(ldsbase + (unsigned)(dstoff))))
#define WAIT_BAR() asm volatile("s_waitcnt vmcnt(0) lgkmcnt(0)\n\ts_barrier" ::: "memory")
    const unsigned ldsbase = (unsigned)(size_t)lds;
    const int uK1 = wid * 1024, uK2 = 8192 + uK1, uV0 = 16384 + pid0 * 1024, uV1 = 16384 + pid1 * 1024;
#define B_ISSUE(t_, boff) do { const size_t off_ = (size_t)(t_) * tstep; GLDS16(srcK1 + off_, (boff) + uK1); GLDS16(srcK2 + off_, (boff) + uK2); GLDS16(srcV0 + off_, (boff) + uV0); GLDS16(srcV1 + off_, (boff) + uV1); } while (0)
    B_ISSUE(0, 0); B_ISSUE(1, 32768);
    asm volatile("s_waitcnt vmcnt(4) lgkmcnt(0)\n\ts_barrier" ::: "memory");
    float mref = 0.f, l = 0.f; f32x16 o[4]; f32x16 cm;
#pragma unroll
    for (int d0 = 0; d0 < 4; ++d0) o[d0] = f32x16{};
#pragma unroll
    for (int r = 0; r < 16; ++r) cm[r] = cb;
    int bc = 0, bn = 32768, bnn = 65536;
    bf16x8 pa[4];
    for (int t = 0; t < ntiles; ++t) {
        const bool more = (t + 2 < ntiles);
        if (more) B_ISSUE(t + 2, bnn);
        if (t <= mylast) { const LAS unsigned char* bufp = lds + bc; const bool near = (64 * t + 63 - q0w > -166);
            attn_s1<4>(bufp + m * 8192, qr, cm, cb, tb + (64 * t - (q0w + r32) + 260 + 4 * hi), near, t == 0, mref, l, o, pa, r32, hi);
            attn_s2<4>(bufp + 16384, pa, o, lane, hi); }
        if (more) asm volatile("s_waitcnt vmcnt(4) lgkmcnt(0)\n\ts_barrier" ::: "memory");
        else WAIT_BAR();
        const int tmp_ = bc; bc = bn; bn = bnn; bnn = tmp_;
    }
#undef B_ISSUE
    const float lt = l + __shfl_xor(l, 32), inv = 1.0f / lt;
    LAS float* X = (LAS float*)lds;
    if (m == 1) {
#pragma unroll
        for (int d0 = 0; d0 < 4; ++d0)
#pragma unroll
            for (int r = 0; r < 16; ++r) X[((s * 64 + d0 * 16 + r) * 64) + lane] = o[d0][r] * inv;
    }
    __syncthreads();
    if (m == 0) {
        float ss = 0.f;
#pragma unroll
        for (int d0 = 0; d0 < 4; ++d0)
#pragma unroll
            for (int r = 0; r < 16; ++r) { const float y = o[d0][r] * inv - lam * X[((s * 64 + d0 * 16 + r) * 64) + lane]; o[d0][r] = y; ss += y * y; }
        ss += __shfl_xor(ss, 32);
        const float rn = __builtin_amdgcn_rsqf(ss * (1.0f / 128.0f) + EPS) * (1.0f - lam_init);
        bf16_t* op = merged + (tokbase + q0w + r32) * DM + 256 + h * 128 + 4 * hi;
#pragma unroll
        for (int d0 = 0; d0 < 4; ++d0)
#pragma unroll
            for (int a = 0; a < 4; ++a) { const f32x4 g = *(const f32x4*)(subln + 32 * d0 + 8 * a + 4 * hi);
                u32x2 w; w.x = pk2(o[d0][4 * a] * rn * g[0], o[d0][4 * a + 1] * rn * g[1]); w.y = pk2(o[d0][4 * a + 2] * rn * g[2], o[d0][4 * a + 3] * rn * g[3]);
                *(u32x2*)(op + 32 * d0 + 8 * a) = w; }
    }
    __syncthreads();
}

__device__ __forceinline__ void attnC_unit(LAS unsigned char* lds, const bf16_t* proj, bf16_t* merged, const float* relb  , int b, int h, int qb) {
    int tid = threadIdx.x; asm volatile("" : "+v"(tid)); const int lane = tid & 63, r32 = lane & 31, hi = lane >> 5; const int wid = __builtin_amdgcn_readfirstlane(tid >> 6);
    const int c0 = 4 * qb, cw = c0 + (wid >> 1), q0w = 64 * cw + 32 * (wid & 1);
    const size_t tokbase = (size_t)b * SEQ;
    LAS float* tb = (LAS float*)(lds + TB_OFF);
    const float cb = relb[h] * LOG2E;
    for (int i = tid; i < 288; i += NWAVES * 64) { int rel = i - 224; rel = rel < -128 ? -128 : rel; tb[i] = relb[(rel + 128) * 4 + h] * LOG2E - cb; }
    bf16x8 qr[4];
    { const bf16_t* qp = proj + (tokbase + q0w + r32) * QKVW + 2304 + h * 64 + hi * 8;
#pragma unroll
      for (int d0 = 0; d0 < 4; ++d0) qr[d0] = *(const bf16x8*)(qp + d0 * 16); }
    const int tlo = c0 - 8 < 0 ? 0 : c0 - 8, thi = c0 + 3;
    const int kkey = 8 * wid + (lane >> 3), kch = (lane & 7) ^ ((kkey >> 1) & 7);
    const bf16_t* srcK = proj + (tokbase + kkey) * QKVW + 2560 + h * 64 + 8 * kch;
    const bf16_t* srcV = proj + (tokbase + 16 * (wid & 3) + (lane >> 2)) * QKVW + 2816 + h * 64 + 32 * (wid >> 2) + 8 * (lane & 3);
    const int uK = wid * 1024, uV = 8192 + uK;
    const unsigned ldsbase = (unsigned)(size_t)lds;
    const size_t tstep = (size_t)64 * QKVW;
#define C_ISSUE(t_, boff) do { const size_t off_ = (size_t)(t_) * tstep; GLDS16(srcK + off_, (boff) + uK); GLDS16(srcV + off_, (boff) + uV); } while (0)
    C_ISSUE(tlo, 0); C_ISSUE(tlo + 1, 16384);
    asm volatile("s_waitcnt vmcnt(2) lgkmcnt(0)\n\ts_barrier" ::: "memory");
    float mref = 0.f, l = 0.f; f32x16 o[2]; o[0] = f32x16{}; o[1] = f32x16{}; f32x16 cm;
#pragma unroll
    for (int r = 0; r < 16; ++r) cm[r] = cb;
    const int myfirst = cw - 8 < 0 ? 0 : cw - 8;
    int bc = 0, bn = 16384, bnn = 32768;
    bf16x8 pa[4];
    for (int t = tlo; t <= thi; ++t) {
        const bool more = (t + 2 <= thi);
        if (more) C_ISSUE(t + 2, bnn);
        if (t >= myfirst && t <= cw) { const LAS unsigned char* bufp = lds + bc; const bool near = (64 * t + 63 - q0w > -128);
            attn_s1<2>(bufp, qr, cm, cb, tb + (64 * t - (q0w + r32) + 224 + 4 * hi), near, t == myfirst, mref, l, o, pa, r32, hi);
            attn_s2<2>(bufp + 8192, pa, o, lane, hi); }
        if (more) asm volatile("s_waitcnt vmcnt(2) lgkmcnt(0)\n\ts_barrier" ::: "memory");
        else WAIT_BAR();
        const int tmp_ = bc; bc = bn; bn = bnn; bnn = tmp_;
    }
#undef C_ISSUE
    const float lt = l + __shfl_xor(l, 32), inv = 1.0f / lt;
    bf16_t* op = merged + (tokbase + q0w + r32) * DM + 768 + h * 64 + 4 * hi;
#pragma unroll
    for (int d0 = 0; d0 < 2; ++d0)
#pragma unroll
        for (int a = 0; a < 4; ++a) { u32x2 w; w.x = pk2(o[d0][4 * a] * inv, o[d0][4 * a + 1] * inv); w.y = pk2(o[d0][4 * a + 2] * inv, o[d0][4 * a + 3] * inv); *(u32x2*)(op + 32 * d0 + 8 * a) = w; }
}

__device__ __forceinline__ void attnA_unit(LAS unsigned char* lds, const bf16_t* proj, bf16_t* merged, int b, int h, int qb) {
    int tid = threadIdx.x; asm volatile("" : "+v"(tid)); const int lane = tid & 63, r32 = lane & 31, hi = lane >> 5; const int wid = __builtin_amdgcn_readfirstlane(tid >> 6);
    const int q0w = 256 * qb + 32 * wid, td = q0w >> 6;
    const size_t tokbase = (size_t)b * SEQ;
    LAS unsigned char* wl = lds + wid * 16384;
    const unsigned ldsbase = (unsigned)(size_t)lds;
    bf16x8 qr[4];
    { const bf16_t* qp = proj + (tokbase + q0w + r32) * QKVW + h * 64 + hi * 8;
#pragma unroll
      for (int d0 = 0; d0 < 4; ++d0) qr[d0] = *(const bf16x8*)(qp + d0 * 16); }
    float carry = 0.f; f32x16 o[2]; o[0] = f32x16{}; o[1] = f32x16{};
    const int qpos = q0w + r32;
    for (int t = td; t >= 0; --t) {
        const bf16_t* kp = proj + (tokbase + 64 * t + (lane >> 3)) * QKVW + 256 + h * 64;
        const bf16_t* vp = proj + (tokbase + 64 * t + (lane >> 2)) * QKVW + 512 + h * 64 + 8 * (lane & 3);
        const int wbase = wid * 16384;
#pragma unroll
        for (int j = 0; j < 8; ++j) GLDS16(kp + (size_t)(8 * j) * QKVW + 8 * ((lane & 7) ^ (((8 * j + (lane >> 3)) >> 1) & 7)), wbase + j * 1024);
#pragma unroll
        for (int j = 0; j < 8; ++j) GLDS16(vp + (size_t)(16 * (j & 3)) * QKVW + 32 * (j >> 2), wbase + 8192 + j * 1024);
        asm volatile("s_waitcnt vmcnt(0)" ::: "memory");
        f32x16 p0 = f32x16{}, p1 = f32x16{};
        qk_tile(p0, p1, wl, qr, r32, hi);
        f32x16 k0, k1;
        const bool diag = (t == td);
#pragma unroll
        for (int r = 0; r < 16; ++r) {
            const float z0 = p0[r], z1 = p1[r];
            float a0 = -(fmaxf(z0, 0.f) + __builtin_amdgcn_logf(1.0f + __builtin_amdgcn_exp2f(-fabsf(z0))));
            float a1 = -(fmaxf(z1, 0.f) + __builtin_amdgcn_logf(1.0f + __builtin_amdgcn_exp2f(-fabsf(z1))));
            if (diag) { const int key = 64 * t + crow(r, hi); if (key >= qpos) a0 = 0.f; if (key + 32 >= qpos) a1 = 0.f; }
            k0[r] = a0; k1[r] = a1;
        }
        float G[2][4], Go[2][4];
#pragma unroll
        for (int a = 0; a < 4; ++a) { G[0][a] = (k0[4 * a] + k0[4 * a + 1]) + (k0[4 * a + 2] + k0[4 * a + 3]); G[1][a] = (k1[4 * a] + k1[4 * a + 1]) + (k1[4 * a + 2] + k1[4 * a + 3]); }
#pragma unroll
        for (int P = 0; P < 2; ++P)
#pragma unroll
            for (int a = 0; a < 4; ++a) Go[P][a] = __shfl_xor(G[P][a], 32);
        float accs = carry;
#pragma unroll
        for (int P = 1; P >= 0; --P)
#pragma unroll
            for (int a = 3; a >= 0; --a) {
                f32x16& kk_ = P ? k1 : k0; f32x16& pp = P ? p1 : p0;
                float bt = accs + (hi == 0 ? Go[P][a] : 0.f);
#pragma unroll
                for (int i = 3; i >= 0; --i) { const int r = 4 * a + i; const float lk = kk_[r]; pp[r] = __builtin_amdgcn_exp2f(pp[r] + lk + bt); bt += lk; }
                accs += G[P][a] + Go[P][a];
            }
        carry = accs;
        if (diag) {
#pragma unroll
            for (int r = 0; r < 16; ++r) { const int key = 64 * t + crow(r, hi); if (key >= qpos) p0[r] = 0.f; if (key + 32 >= qpos) p1[r] = 0.f; }
        }
        bf16x8 pa[4]; pack_p(pa, p0, p1);
        pv_tile<2>(o, wl + 8192, pa, lane, hi);
        asm volatile("s_waitcnt lgkmcnt(0)" ::: "memory");
        if (__all(carry < -150.0f)) break;
    }
    bf16_t* op = merged + (tokbase + q0w + r32) * DM + h * 64 + 4 * hi;
#pragma unroll
    for (int d0 = 0; d0 < 2; ++d0)
#pragma unroll
        for (int a = 0; a < 4; ++a) { u32x2 w; w.x = pk2(o[d0][4 * a], o[d0][4 * a + 1]); w.y = pk2(o[d0][4 * a + 2], o[d0][4 * a + 3]); *(u32x2*)(op + 32 * d0 + 8 * a) = w; }
}

struct Args { const float* in[18]; float* out; unsigned char* ws; int ph_lo, ph_hi; };
enum { I_X = 0, I_T5, I_ANORM, I_WIN, I_DQN, I_DLAM, I_DSUB, I_CQN, I_CRB, I_WOUT, I_FNORM, I_RGW, I_RGB, I_REW, I_REB, I_WG, I_WU, I_WD };

__device__ __forceinline__ int rowmap(int kind, int n) {
    if (kind == 1) return (n & ~255) + 128 * ((n & 63) >> 5) + 32 * ((n >> 6) & 3) + (n & 31);
    if (kind == 2) return 256 * (n >> 7) + (n & 127);
    if (kind == 3) return 256 * (n >> 7) + 128 + (n & 127);
    return n;
}
__device__ __forceinline__ void transpose_item(const float* W, int K, int N, const float* gain, bf16_t* WT, int kind, int item, int lane) {
    const int nblk = N / 64, kb = item / nblk, nb = item % nblk, k0 = 64 * kb, n0 = 64 * nb;
    const float* src = W + (size_t)k0 * N + n0 + lane;
    float v[64];
#pragma unroll
    for (int k = 0; k < 64; ++k) v[k] = src[(size_t)k * N];
    if (gain) {
#pragma unroll
        for (int k = 0; k < 64; ++k) v[k] *= gain[k0 + k];
    }
    bf16_t* dst = WT + (size_t)rowmap(kind, n0 + lane) * K + k0;
#pragma unroll
    for (int j = 0; j < 8; ++j) { u32x4 o; o.x = pk2(v[8 * j], v[8 * j + 1]); o.y = pk2(v[8 * j + 2], v[8 * j + 3]); o.z = pk2(v[8 * j + 4], v[8 * j + 5]); o.w = pk2(v[8 * j + 6], v[8 * j + 7]);
        *(u32x4*)(dst + 8 * j) = o; }
}
__device__ __forceinline__ float wave_sum(float v) {
#pragma unroll
    for (int o = 1; o < 64; o <<= 1) v += __shfl_xor(v, o);
    return v;
}

__global__ void __launch_bounds__(NWAVES * 64, 2) fwd_kernel(Args args) {
    extern __shared__ __attribute__((aligned(16))) unsigned char lds_raw[];
    LAS unsigned char* lds = (LAS unsigned char*)lds_raw;
    volatile LAS unsigned* MISC = (volatile LAS unsigned*)(lds + MISC_OFF);
    const int G = gridDim.x, bx = blockIdx.x;
    const int vcu = (G % 8 == 0) ? (bx % 8) * (G / 8) + bx / 8 : bx;
    unsigned char* ws0 = args.ws;
    gu32* ctl = (gu32*)(ws0 + WS_CTL);
#define PHASE_LOCALS() \
    unsigned long long zero_ = 0ull; asm volatile("" : "+s"(zero_)); unsigned char* ws = ws0 + zero_; \
    int tid = threadIdx.x; asm volatile("" : "+v"(tid)); \
    const int lane = tid & 63, wave = __builtin_amdgcn_readfirstlane(tid >> 6); \
    const int gw = vcu * NWAVES + wave, NGW = G * NWAVES; \
    float* out = args.out; \
    bf16_t* hb = (bf16_t*)(ws + WS_HB); bf16_t* proj = (bf16_t*)(ws + WS_PROJ); bf16_t* merged = (bf16_t*)(ws + WS_MERGED); \
    bf16_t* hid = (bf16_t*)(ws + WS_HID); bf16_t* ybuf = (bf16_t*)(ws + WS_YBUF); float* rrow = (float*)(ws + WS_RROW); \
    unsigned* slot_of = (unsigned*)(ws + WS_SLOT); int* tok_list = (int*)(ws + WS_TOK); float* gate_list = (float*)(ws + WS_GATE); float* rs_list = (float*)(ws + WS_RS); \
    (void)lane; (void)wave; (void)gw; (void)NGW; (void)out; (void)hb; (void)proj; (void)merged; (void)hid; (void)ybuf; (void)rrow; (void)slot_of; (void)tok_list; (void)gate_list; (void)rs_list;

    if (threadIdx.x < 64) MISC[threadIdx.x] = 0u;
    __syncthreads();
#if MK_N_LAUNCHES == 1
    XcdBarrier bar = xcd_barrier_post((unsigned*)(ctl + CW_BAR), MISC + 40);
#define GRID_BAR() xcd_barrier(bar)
#else
#define GRID_BAR() do {} while (0)
#endif
    const int lo = args.ph_lo, hi_ph = args.ph_hi;
#ifndef PH_MASK
#define PH_MASK 0xff
#endif
#define IN(k) (lo <= (k) && (k) < hi_ph && ((PH_MASK >> ((k) == 0 ? 0 : (((k) - 1) % 7) + 1)) & 1))
#define BOTH(k) (IN(k) && IN((k) + 1))
#ifndef DUP_MASK
#define DUP_MASK 0
#endif
#define REPS(kind) (((DUP_MASK >> (kind)) & 1) ? 2 : 1)

    if (IN(0)) for (int rep_ = 0; rep_ < REPS(0); ++rep_) {
        PHASE_LOCALS();
        constexpr int I_IN = 16 * 48, I_OUT = 16 * 16, I_E = 128;
        constexpr int N_A = DEPTH * I_IN, N_B = DEPTH * I_OUT, N_C = DEPTH * NEXP * I_E;
        constexpr int NITEMS = N_A + N_B + 3 * N_C;
        for (int it = gw; it < NITEMS; it += NGW) {
            int r = it;
            if (r < N_A) { const int l = r / I_IN; transpose_item(args.in[I_WIN] + (size_t)l * DM * QKVW, DM, QKVW, args.in[I_ANORM] + l * DM, (bf16_t*)(ws + WS_WIN) + (size_t)l * QKVW * DM, 1, r % I_IN, lane); continue; } r -= N_A;
            if (r < N_B) { const int l = r / I_OUT; transpose_item(args.in[I_WOUT] + (size_t)l * DM * DM, DM, DM, nullptr, (bf16_t*)(ws + WS_WOUT) + (size_t)l * DM * DM, 0, r % I_OUT, lane); continue; } r -= N_B;
            const int which = r / N_C, r2 = r % N_C, le = r2 / I_E, item = r2 % I_E, l = le / NEXP;
            if (which == 0) transpose_item(args.in[I_WG] + (size_t)le * DM * DEXP, DM, DEXP, args.in[I_FNORM] + l * DM, (bf16_t*)(ws + WS_WGU) + (size_t)le * 1024 * DM, 2, item, lane);
            else if (which == 1) transpose_item(args.in[I_WU] + (size_t)le * DM * DEXP, DM, DEXP, args.in[I_FNORM] + l * DM, (bf16_t*)(ws + WS_WGU) + (size_t)le * 1024 * DM, 3, item, lane);
            else transpose_item(args.in[I_WD] + (size_t)le * DEXP * DM, DEXP, DM, nullptr, (bf16_t*)(ws + WS_WD) + (size_t)le * DM * DEXP, 0, item, lane);
        }
        for (int i = (vcu * NWAVES * 64 + tid); i < DEPTH * 48 * 1024; i += G * NWAVES * 64) {
            const int l = i / (48 * 1024), n = (i / 1024) % 48, k = i % 1024;
            float w = 0.f;
            if (n < 4) w = args.in[I_RGW][((size_t)l * DM + k) * 4 + n]; else if (n < 36) w = args.in[I_REW][((size_t)l * DM + k) * 32 + (n - 4)];
            w *= args.in[I_FNORM][l * DM + k];
            const unsigned hb_ = f2bf(w); const float wl = w - __builtin_bit_cast(float, hb_ << 16);
            ((bf16_t*)(ws + WS_WRH))[i] = (bf16_t)hb_; ((bf16_t*)(ws + WS_WRL))[i] = (bf16_t)f2bf(wl);
        }
        const float* x = args.in[I_X];
        for (int row = gw; row < NTOK; row += NGW) {
            const f32x4* xr = (const f32x4*)(x + (size_t)row * DM) + lane; float ss = 0.f; u32x2* o8 = (u32x2*)(hb + (size_t)row * DM) + lane;
#pragma unroll
            for (int j = 0; j < 4; ++j) { const f32x4 v = xr[64 * j]; ss += (v[0] * v[0] + v[1] * v[1]) + (v[2] * v[2] + v[3] * v[3]); u32x2 w; w.x = pk2(v[0], v[1]); w.y = pk2(v[2], v[3]); o8[64 * j] = w; }
            ss = wave_sum(ss);
            if (lane == 0) rrow[row] = __builtin_amdgcn_rsqf(ss * (1.0f / DM) + EPS);
        }
        if (rep_ == REPS(0) - 1) { if (BOTH(0)) GRID_BAR(); } else __syncthreads();
    }

    for (int l = 0; l < DEPTH; ++l) {
        const int pb = 1 + 7 * l;
        const float lam_init = 0.8f - 0.6f * __expf(-0.3f * (float)l);
        const unsigned* cntl = (const unsigned*)(ctl + CW_CNT) + l * 32 * 64;
        if (IN(pb + 0)) for (int rep_ = 0; rep_ < ((1 == 3 && l != 0) ? 1 : REPS(1)); ++rep_) {
            PHASE_LOCALS();
            pg8::DenseSched S; S.init(NTOK, QKVW, DM, (const bf16_t*)(ws + WS_WIN) + (size_t)l * QKVW * DM, G, bx);
            pg8::EpiWin E{proj, rrow, args.in[I_DQN] + l * 128, args.in[I_CQN] + l * 128};
            pg8::gemm_phase<pg8::EpiWin, pg8::DenseSched>(lds, hb, DM, S, E);
            if (rep_ == ((1 == 3 && l != 0) ? 1 : REPS(1)) - 1) { if (BOTH(pb + 0)) GRID_BAR(); } else __syncthreads();
        }
        if (IN(pb + 1)) for (int rep_ = 0; rep_ < ((2 == 3 && l != 0) ? 1 : REPS(2)); ++rep_) {
            PHASE_LOCALS();
            for (int rb_ = 0; rb_ < REPS(8); ++rb_)
            for (int P = vcu; P < 512; P += G) {
                const int bh = P >> 4, s = P & 15;
                attnB_unit(lds, proj, merged, args.in[I_T5], args.in[I_DLAM] + l * 256, args.in[I_DSUB] + l * 128, lam_init, bh >> 2, bh & 3, 31 - s, ((DUP_MASK >> 11) & 1) && rb_ == 0);
                attnB_unit(lds, proj, merged, args.in[I_T5], args.in[I_DLAM] + l * 256, args.in[I_DSUB] + l * 128, lam_init, bh >> 2, bh & 3, s, ((DUP_MASK >> 11) & 1) && rb_ == 0);
            }
            for (int rc_ = 0; rc_ < REPS(9); ++rc_)
            for (int U = vcu; U < 512; U += G) { const int bh = U >> 4; attnC_unit(lds, proj, merged, args.in[I_CRB] + l * 257 * 4, bh >> 2, bh & 3, U & 15); __syncthreads(); }
            for (int ra_ = 0; ra_ < REPS(10); ++ra_)
            for (int U = vcu; U < 512; U += G) { const int bh = U >> 4; attnA_unit(lds, proj, merged, bh >> 2, bh & 3, U & 15); }
            __syncthreads();
            if (rep_ == ((2 == 3 && l != 0) ? 1 : REPS(2)) - 1) { if (BOTH(pb + 1)) GRID_BAR(); } else __syncthreads();
        }
        if (IN(pb + 2)) for (int rep_ = 0; rep_ < ((3 == 3 && l != 0) ? 1 : REPS(3)); ++rep_) {
            PHASE_LOCALS();
            pg8::DenseSched S; S.init(NTOK, DM, DM, (const bf16_t*)(ws + WS_WOUT) + (size_t)l * DM * DM, G, bx);
            pg8::EpiWout E{hb};
            pg8::gemm_phase<pg8::EpiWout, pg8::DenseSched>(lds, merged, DM, S, E);
            if (rep_ == ((3 == 3 && l != 0) ? 1 : REPS(3)) - 1) { if (BOTH(pb + 2)) GRID_BAR(); } else __syncthreads();
        }
        if (IN(pb + 3)) {
            PHASE_LOCALS();
            LAS float* lg = (LAS float*)lds;
            LAS float* rrl = (LAS float*)(lds + 128 * 49 * 4);
            LAS int* hist = (LAS int*)(lds + 128 * 49 * 4 + 512);
            const bf16_t* wrh = (const bf16_t*)(ws + WS_WRH) + (size_t)l * 48 * 1024;
            const bf16_t* wrl = (const bf16_t*)(ws + WS_WRL) + (size_t)l * 48 * 1024;
            const float* rgb = args.in[I_RGB] + l * 4; const float* reb = args.in[I_REB] + l * 32;
            const int fr = lane & 15, fq = lane >> 4;
            for (int chunk = vcu; chunk < NTOK / 128; chunk += G) {
                if (tid < 32) hist[tid] = 0;
                const int row = chunk * 128 + wave * 16 + fr;
                const bf16_t* hp = hb + (size_t)row * DM + 8 * fq;
                f32x4 acc[3]; acc[0] = acc[1] = acc[2] = (f32x4){0.f, 0.f, 0.f, 0.f};
                float ss = 0.f;
#pragma unroll 4
                for (int k0 = 0; k0 < DM; k0 += 32) {
                    const u32x4 ah = *(const u32x4*)(hp + k0);
                    { const float x0 = bflo(ah.x), x1 = bfhi(ah.x), x2 = bflo(ah.y), x3 = bfhi(ah.y), x4 = bflo(ah.z), x5 = bfhi(ah.z), x6 = bflo(ah.w), x7 = bfhi(ah.w);
                      ss += (x0 * x0 + x1 * x1) + (x2 * x2 + x3 * x3) + (x4 * x4 + x5 * x5) + (x6 * x6 + x7 * x7); }
                    const bf16x8 aH = __builtin_bit_cast(bf16x8, ah);
#pragma unroll
                    for (int cbk = 0; cbk < 3; ++cbk) {
                        const bf16x8 bH = *(const bf16x8*)(wrh + (size_t)(cbk * 16 + fr) * DM + k0 + 8 * fq), bL = *(const bf16x8*)(wrl + (size_t)(cbk * 16 + fr) * DM + k0 + 8 * fq);
                        acc[cbk] = __builtin_amdgcn_mfma_f32_16x16x32_bf16(aH, bH, acc[cbk], 0, 0, 0);
                        acc[cbk] = __builtin_amdgcn_mfma_f32_16x16x32_bf16(aH, bL, acc[cbk], 0, 0, 0);
                    }
                }
                ss += __shfl_xor(ss, 16); ss += __shfl_xor(ss, 32);
                if (fq == 0) rrl[wave * 16 + fr] = __builtin_amdgcn_rsqf(ss * (1.0f / DM) + EPS);
#pragma unroll
                for (int cbk = 0; cbk < 3; ++cbk)
#pragma unroll
                    for (int rg = 0; rg < 4; ++rg) lg[(wave * 16 + 4 * fq + rg) * 49 + cbk * 16 + fr] = acc[cbk][rg];
                __syncthreads();
                int e1 = 0, e2 = 0, lr1 = 0, lr2 = 0; float g1 = 0.f, g2 = 0.f, rr = 0.f;
                if (tid < 128) {
                    rr = rrl[tid];
                    const LAS float* lp = lg + tid * 49;
                    float gl[4]; int gs = 0; float gmax = -3.0e38f;
#pragma unroll
                    for (int i = 0; i < 4; ++i) { gl[i] = lp[i] * rr + rgb[i]; if (gl[i] > gmax) { gmax = gl[i]; gs = i; } }
                    float den = 0.f;
#pragma unroll
                    for (int i = 0; i < 4; ++i) den += __expf(gl[i] - gmax);
                    const float gwt = 1.0f / den;
                    float el[8]; int i1 = 0; float m1 = -3.0e38f;
#pragma unroll
                    for (int i = 0; i < 8; ++i) { el[i] = lp[4 + gs * 8 + i] * rr + reb[gs * 8 + i]; if (el[i] > m1) { m1 = el[i]; i1 = i; } }
                    int i2 = 0; float m2 = -3.0e38f;
#pragma unroll
                    for (int i = 0; i < 8; ++i) { if (i != i1 && el[i] > m2) { m2 = el[i]; i2 = i; } }
                    const float ex = __expf(m2 - m1), p1 = 1.0f / (1.0f + ex), p2 = ex * p1;
                    g1 = gwt * p1; g2 = gwt * p2; e1 = gs * 8 + i1; e2 = gs * 8 + i2;
                    lr1 = __hip_atomic_fetch_add(&hist[e1], 1, __ATOMIC_RELAXED, __HIP_MEMORY_SCOPE_WORKGROUP); lr2 = __hip_atomic_fetch_add(&hist[e2], 1, __ATOMIC_RELAXED, __HIP_MEMORY_SCOPE_WORKGROUP);
                }
                __syncthreads();
                if (tid < 32) { const int c_ = hist[tid]; hist[32 + tid] = c_ ? (int)__hip_atomic_fetch_add((unsigned*)cntl + 64 * tid, (unsigned)c_, __ATOMIC_RELAXED, __HIP_MEMORY_SCOPE_AGENT) : 0; }
                __syncthreads();
                if (tid < 128) {
                    const int tok = chunk * 128 + tid;
                    const int pos1 = hist[32 + e1] + lr1, pos2 = hist[32 + e2] + lr2;
                    tok_list[e1 * ECAP + pos1] = tok; gate_list[e1 * ECAP + pos1] = g1; rs_list[e1 * ECAP + pos1] = rr;
                    tok_list[e2 * ECAP + pos2] = tok; gate_list[e2 * ECAP + pos2] = g2; rs_list[e2 * ECAP + pos2] = rr;
                    slot_of[tok * 2] = ((unsigned)e1 << 16) | (unsigned)pos1; slot_of[tok * 2 + 1] = ((unsigned)e2 << 16) | (unsigned)pos2;
                }
                __syncthreads();
            }
            if (BOTH(pb + 3)) GRID_BAR();
        }
        if (IN(pb + 4) || IN(pb + 5) || IN(pb + 6)) {
            if (threadIdx.x == 0) { int s_ = 0; for (int e = 0; e < 32; ++e) { MISC[e] = (unsigned)s_; s_ += ((int)ld_agent(cntl + 64 * e) + 255) >> 8; } MISC[32] = (unsigned)s_; }
            __syncthreads();
        }
        if (IN(pb + 4)) for (int rep_ = 0; rep_ < ((5 == 3 && l != 0) ? 1 : REPS(5)); ++rep_) {
            PHASE_LOCALS();
            pg8::MoeSched<true> S{(const volatile LAS int*)MISC, cntl, tok_list, (const bf16_t*)(ws + WS_WGU) + (size_t)l * NEXP * 1024 * DM, DM, G, bx};
            pg8::EpiGU E{hid, rs_list};
            pg8::gemm_phase<pg8::EpiGU, pg8::MoeSched<true>>(lds, hb, DM, S, E);
            if (rep_ == ((5 == 3 && l != 0) ? 1 : REPS(5)) - 1) { if (BOTH(pb + 4)) GRID_BAR(); } else __syncthreads();
        }
        if (IN(pb + 5)) for (int rep_ = 0; rep_ < ((6 == 3 && l != 0) ? 1 : REPS(6)); ++rep_) {
            PHASE_LOCALS();
            pg8::MoeSched<false> S{(const volatile LAS int*)MISC, cntl, tok_list, (const bf16_t*)(ws + WS_WD) + (size_t)l * NEXP * DM * DEXP, DEXP, G, bx};
            pg8::EpiDown E{ybuf, gate_list};
            pg8::gemm_phase<pg8::EpiDown, pg8::MoeSched<false>>(lds, hid, DEXP, S, E);
            if (rep_ == ((6 == 3 && l != 0) ? 1 : REPS(6)) - 1) { if (BOTH(pb + 5)) GRID_BAR(); } else __syncthreads();
        }
        if (IN(pb + 6)) {
            PHASE_LOCALS();
            for (int row = gw; row < NTOK; row += NGW) {
                const unsigned s0 = ld_agent(slot_of + row * 2), s1 = ld_agent(slot_of + row * 2 + 1);
                const size_t y0 = (size_t)(MISC[s0 >> 16] * 256u + (s0 & 0xffffu)), y1 = (size_t)(MISC[s1 >> 16] * 256u + (s1 & 0xffffu));
                const u32x2* ya = (const u32x2*)(ybuf + y0 * DM) + lane; const u32x2* yb = (const u32x2*)(ybuf + y1 * DM) + lane;
                u32x2* o8 = (u32x2*)(hb + (size_t)row * DM) + lane;
                f32x4* of = (f32x4*)(out + (size_t)row * DM) + lane;
                float ss = 0.f;
#pragma unroll
                for (int j = 0; j < 4; ++j) { const u32x2 hv = o8[64 * j], a = ya[64 * j], b2 = yb[64 * j]; f32x4 v;
                    v[0] = bflo(hv.x) + (bflo(a.x) + bflo(b2.x)); v[1] = bfhi(hv.x) + (bfhi(a.x) + bfhi(b2.x)); v[2] = bflo(hv.y) + (bflo(a.y) + bflo(b2.y)); v[3] = bfhi(hv.y) + (bfhi(a.y) + bfhi(b2.y));
                    if (l == DEPTH - 1) of[64 * j] = v;
                    else { ss += (v[0] * v[0] + v[1] * v[1]) + (v[2] * v[2] + v[3] * v[3]); u32x2 w; w.x = pk2(v[0], v[1]); w.y = pk2(v[2], v[3]); o8[64 * j] = w; } }
                if (l != DEPTH - 1) { ss = wave_sum(ss); if (lane == 0) rrow[row] = __builtin_amdgcn_rsqf(ss * (1.0f / DM) + EPS); }
            }
            if (BOTH(pb + 6)) GRID_BAR();
        }
    }
#undef IN
#undef BOTH
}

extern "C" void kernel_launch(void* const* d_in, const int* in_sizes, int n_in, void* d_out, int out_size, void* d_ws, size_t ws_size, hipStream_t stream) {
    static int grid = 0;
    if (grid == 0) {
        if (n_in != 18 || out_size != NTOK * DM || ws_size < WS_END) { fprintf(stderr, "kernel_launch: unexpected shapes (n_in %d, out %d, ws %zu < %zu)\n", n_in, out_size, ws_size, (size_t)WS_END); grid = -1; return; }
        int dev = 0, cus = 0, per_cu = 0;
        if (hipGetDevice(&dev) != hipSuccess || hipDeviceGetAttribute(&cus, hipDeviceAttributeMultiprocessorCount, dev) != hipSuccess) { grid = -1; return; }
        if (hipFuncSetAttribute((const void*)fwd_kernel, hipFuncAttributeMaxDynamicSharedMemorySize, LDS_BYTES) != hipSuccess) { fprintf(stderr, "kernel_launch: hipFuncSetAttribute failed\n"); grid = -1; return; }
        if (hipOccupancyMaxActiveBlocksPerMultiprocessor(&per_cu, (const void*)fwd_kernel, NWAVES * 64, LDS_BYTES) != hipSuccess || per_cu < 1) fprintf(stderr, "kernel_launch: occupancy query says %d\n", per_cu);
        (void)hipGetLastError();
        grid = cus;
    }
    if (grid < 0) return;
    if (hipMemsetAsync((char*)d_ws + WS_CTL, 0, CTL_ZERO_BYTES, stream) != hipSuccess) return;
    Args a{};
    for (int i = 0; i < 18; ++i) a.in[i] = (const float*)d_in[i];
    a.out = (float*)d_out; a.ws = (unsigned char*)d_ws;
#if MK_N_LAUNCHES == 1
    a.ph_lo = 0; a.ph_hi = NPHASES;
    hipLaunchKernelGGL(fwd_kernel, dim3(grid), dim3(NWAVES * 64), LDS_BYTES, stream, a);
#else
    for (int p = 0; p < NPHASES; ++p) { a.ph_lo = p; a.ph_hi = p + 1; hipLaunchKernelGGL(fwd_kernel, dim3(grid), dim3(NWAVES * 64), LDS_BYTES, stream, a); }
#endif
}
```

```cpp
#include <hip/hip_runtime.h>
#include <cstdio>
#include <cstdint>

#ifndef MK_N_LAUNCHES
#define MK_N_LAUNCHES 1
#endif

#define LAS __attribute__((address_space(3)))
#define GAS __attribute__((address_space(1)))
typedef unsigned short bf16_t;
typedef short bf16x8 __attribute__((ext_vector_type(8)));
typedef short v4i16 __attribute__((ext_vector_type(4)));
typedef float f32x4 __attribute__((ext_vector_type(4)));
typedef float f32x16 __attribute__((ext_vector_type(16)));
typedef unsigned u32x4 __attribute__((ext_vector_type(4)));
typedef unsigned u32x2 __attribute__((ext_vector_type(2)));
typedef float f32x2_t __attribute__((ext_vector_type(2)));
typedef __bf16 bf16x2_t __attribute__((ext_vector_type(2)));
typedef GAS unsigned gu32;

constexpr int DM = 1024, BATCH = 8, SEQ = 4096, NTOK = BATCH * SEQ, DEPTH = 2;
constexpr int QKVW = 3072, NEXP = 32, DEXP = 512, ECAP = 32768;
constexpr int MAXROWS = 73728;
constexpr float EPS = 1e-6f;
constexpr float LOG2E = 1.4426950408889634f;
constexpr float QSCALE = 0.125f * LOG2E;
constexpr int NWAVES = 8;
constexpr int NPHASES = 1 + 7 * DEPTH;

constexpr size_t MiB = 1u << 20;
constexpr size_t WS_CTL = 0, CTL_ZERO_BYTES = 1 * MiB;
constexpr size_t WS_WIN = 1 * MiB;
constexpr size_t WS_WOUT = 13 * MiB;
constexpr size_t WS_WGU = 17 * MiB;
constexpr size_t WS_WD = 145 * MiB;
constexpr size_t WS_WRH = 209 * MiB;
constexpr size_t WS_WRL = WS_WRH + 256 * 1024;
constexpr size_t WS_RROW = 210 * MiB;
constexpr size_t WS_SLOT = WS_RROW + 256 * 1024;
constexpr size_t WS_TOK = 211 * MiB;
constexpr size_t WS_GATE = 215 * MiB;
constexpr size_t WS_RS = 219 * MiB;
constexpr size_t WS_HB = 223 * MiB;
constexpr size_t WS_R = 287 * MiB;
constexpr size_t WS_PROJ = WS_R, WS_MERGED = WS_R + 192 * MiB;
constexpr size_t WS_HID = WS_R;
constexpr size_t WS_YBUF = WS_R + 72 * MiB;
constexpr size_t WS_END = 543 * MiB;
constexpr int CW_BAR = 4096;
constexpr int CW_CNT = 16384;

constexpr int RING_BYTES = 131072;
constexpr int MISC_OFF = RING_BYTES;
constexpr int TB_OFF = RING_BYTES + 4096;
constexpr int LDS_BYTES = 147456;

__device__ __forceinline__ unsigned f2bf(float f) { unsigned u = __builtin_bit_cast(unsigned, f); return (u + 0x7fffu + ((u >> 16) & 1u)) >> 16; }
__device__ __forceinline__ unsigned pk2(float lo, float hi) { f32x2_t v = {lo, hi}; bf16x2_t b = __builtin_convertvector(v, bf16x2_t); return __builtin_bit_cast(unsigned, b); }
__device__ __forceinline__ float bflo(unsigned w) { return __builtin_bit_cast(float, w << 16); }
__device__ __forceinline__ float bfhi(unsigned w) { return __builtin_bit_cast(float, w & 0xffff0000u); }
__device__ __forceinline__ unsigned ld_agent(const unsigned* p) { return __hip_atomic_load(p, __ATOMIC_RELAXED, __HIP_MEMORY_SCOPE_AGENT); }
#define LDS_WAIT() asm volatile("s_waitcnt lgkmcnt(0)" ::: "memory")
__device__ __forceinline__ int tid_of(int wv) { int ln; asm volatile("v_mbcnt_lo_u32_b32 %0, -1, 0\n\tv_mbcnt_hi_u32_b32 %0, -1, %0" : "=v"(ln)); return wv * 64 + ln; }

template <int M> __device__ __forceinline__ float swz_xor(float v) { return __builtin_bit_cast(float, __builtin_amdgcn_ds_swizzle(__builtin_bit_cast(int, v), (M << 10) | 0x1f)); }
__device__ __forceinline__ void pl32_swap(unsigned& a, unsigned& b) { asm("s_nop 1\n\tv_permlane32_swap_b32 %0, %1" : "+v"(a), "+v"(b)); }
__device__ __forceinline__ float sum_x32(float v) { unsigned a = __builtin_bit_cast(unsigned, v), b = a; pl32_swap(a, b); return __builtin_bit_cast(float, a) + __builtin_bit_cast(float, b); }
__device__ __forceinline__ float max_x32(float v) { unsigned a = __builtin_bit_cast(unsigned, v), b = a; pl32_swap(a, b); return __builtin_fmaxf(__builtin_bit_cast(float, a), __builtin_bit_cast(float, b)); }
__device__ __forceinline__ float other_x32(float v, int hi) { unsigned a = __builtin_bit_cast(unsigned, v), b = a; pl32_swap(a, b); return __builtin_bit_cast(float, hi ? a : b); }
__device__ __forceinline__ float wave_sum(float v) { v += swz_xor<1>(v); v += swz_xor<2>(v); v += swz_xor<4>(v); v += swz_xor<8>(v); v += swz_xor<16>(v); return sum_x32(v); }

#define XB_TMO      128
#define XB_XCNT(j)  (256  + 64 * (j))
#define XB_XSUB(j)  (1280 + 64 * (j))
#define XB_XGEN(j)  (2304 + 64 * (j))
#define XB_TOP      3328
#define XB_TOPGEN   3392
#define XCD_BAR_WORDS 3456
#define XB_SPIN_CAP (1u << 18)
__device__ __forceinline__ unsigned xb_ld(unsigned* p)              { return __hip_atomic_load(p, __ATOMIC_RELAXED, __HIP_MEMORY_SCOPE_AGENT); }
__device__ __forceinline__ unsigned xb_add(unsigned* p, unsigned v) { return __hip_atomic_fetch_add(p, v, __ATOMIC_RELAXED, __HIP_MEMORY_SCOPE_AGENT); }
__device__ __forceinline__ unsigned xb_xcc_id() { return (unsigned)__builtin_amdgcn_s_getreg((3 << 11) | 20) & 0xFu; }
#define XB_SPIN(cond, bar) do { unsigned _sp = 0; while (cond) { __builtin_amdgcn_s_sleep(1); \
    if ((++_sp & 255u) == 0u) { if (xb_ld(&(bar)[XB_TMO])) break; if (_sp > XB_SPIN_CAP) { atomicAdd(&(bar)[XB_TMO], 1u); break; } } } } while (0)
struct XcdBarrier { unsigned* bar; unsigned x; volatile LAS unsigned* st; int wv; };
__device__ __forceinline__ XcdBarrier xcd_barrier_post(unsigned* bar, volatile LAS unsigned* st, int wv) {
    XcdBarrier b; b.bar = bar; b.x = xb_xcc_id(); b.st = st; b.wv = wv;
    if (tid_of(wv) == 0) (void)xb_add(&bar[XB_XCNT(b.x)], 1u);
    return b;
}
__device__ __forceinline__ void xcd_barrier_complete(unsigned* bar, unsigned x, unsigned& nloc, unsigned& nx) {
    const unsigned G = gridDim.x * gridDim.y * gridDim.z;
    unsigned sum, cnt, mine, sp = 0u;
    for (;;) {
        sum = 0u; cnt = 0u; mine = 0u;
#pragma unroll
        for (unsigned j = 0; j < 16; ++j) { const unsigned c = xb_ld(&bar[XB_XCNT(j)]); sum += c; cnt += (c > 0u) ? 1u : 0u; mine = (j == x) ? c : mine; }
        if (sum == G) break;
        __builtin_amdgcn_s_sleep(1);
        if ((++sp & 255u) == 0u) { if (xb_ld(&bar[XB_TMO])) break; if (sp > XB_SPIN_CAP) { atomicAdd(&bar[XB_TMO], 1u); break; } }
    }
    nloc = mine > 0u ? mine : 1u; nx = cnt > 0u ? cnt : 1u;
}
__device__ __forceinline__ void xcd_barrier(const XcdBarrier& b) {
    asm volatile("s_waitcnt vmcnt(0)" ::: "memory");
    __syncthreads();
    if (tid_of(b.wv) == 0) {
        unsigned* bar = b.bar;
        __builtin_amdgcn_s_waitcnt(0);
        unsigned nloc = b.st[0], nx = b.st[1];
        if (nloc == 0u) { xcd_barrier_complete(bar, b.x, nloc, nx); b.st[0] = nloc; b.st[1] = nx; }
        const unsigned old = xb_add(&bar[XB_XSUB(b.x)], 1u);
        const unsigned gen = old / nloc;
        if (old + 1u == (gen + 1u) * nloc) {
            __builtin_amdgcn_fence(__ATOMIC_RELEASE, "agent");
            asm volatile("s_waitcnt vmcnt(0)" ::: "memory");
            const unsigned og = xb_add(&bar[XB_TOP], 1u);
            const unsigned tg = og / nx;
            if (og + 1u == (tg + 1u) * nx) xb_add(&bar[XB_TOPGEN], 1u);
            else XB_SPIN(xb_ld(&bar[XB_TOPGEN]) == tg, bar);
            __builtin_amdgcn_fence(__ATOMIC_ACQUIRE, "agent");
            xb_add(&bar[XB_XGEN(b.x)], 1u);
            asm volatile("s_waitcnt vmcnt(0)" ::: "memory");
        } else {
            XB_SPIN(xb_ld(&bar[XB_XGEN(b.x)]) == gen, bar);
            __builtin_amdgcn_fence(__ATOMIC_ACQUIRE, "agent");
            asm volatile("s_waitcnt vmcnt(0)" ::: "memory");
        }
    }
    __syncthreads();
}

namespace pg8 {
constexpr int BM = 256, BK = 64, HALF = 128, HTB = HALF * BK * 2, STAGE_BYTES = 8 * HTB, NXCD = 8, WGM = 8;
__device__ __forceinline__ int lds_byte(int r, int c) { const int st = (r >> 4) * 2 + (c >> 5), rr = r & 15, cc = c & 31, ob = rr * 64 + cc * 2; return st * 1024 + (ob ^ (((ob >> 9) & 1) << 5)); }
__device__ __forceinline__ void stage_rc(int b, int& R, int& C) { const int st = b / 1024, sb = b % 1024, swz = sb ^ (((sb >> 9) & 1) << 5); R = (st >> 1) * 16 + swz / 64; C = (st & 1) * 32 + (swz % 64) / 2; }
__device__ __forceinline__ int perm32(int rho) { const int n = rho >> 4, i = rho & 15; return 8 * (i >> 2) + 4 * n + (i & 3); }

struct Unit { int pm, pn, e, t0, cnt; };

struct DenseSched {
    static constexpr bool GATHER = false;
    int nM, nN, nwg, G, c, K; const bf16_t* Bt;
    __device__ void init(int M, int N, int K_, const bf16_t* Bt_, int G_, int c_) { nM = M / BM; nN = N / BM; nwg = nM * nN; G = G_; c = c_; K = K_; Bt = Bt_; }
    __device__ __forceinline__ bool next(int i, Unit& u) const {
        const long L = (long)i * G + c; if (L >= nwg) return false;
        int wgid = (int)L; { const int q = nwg / NXCD, r = nwg % NXCD, xcd = wgid % NXCD, off = wgid / NXCD; wgid = (xcd < r ? xcd * (q + 1) : r * (q + 1) + (xcd - r) * q) + off; }
        const int nig = WGM * nN, gid = wgid / nig, fm = gid * WGM, gsz = (nM - fm) < WGM ? (nM - fm) : WGM;
        u.pm = fm + ((wgid % nig) % gsz); u.pn = (wgid % nig) / gsz; u.e = 0; u.t0 = 0; u.cnt = 0; return true;
    }
    __device__ __forceinline__ int arow(const Unit& u, int r) const { return u.pm * BM + r; }
    __device__ __forceinline__ const bf16_t* bptr(const Unit& u) const { return Bt + (size_t)u.pn * BM * K; }
};
template <bool GATHER_> struct MoeSched {
    static constexpr bool GATHER = GATHER_;
    const volatile LAS int* pre; const unsigned* cnt; const int* tok; const bf16_t* W; int K, G, c;
    __device__ __forceinline__ bool next(int i, Unit& u) const {
        const int L = i * G + c, T = L >> 2; const int ntile = __builtin_amdgcn_readfirstlane(pre[32]);
        if (T >= ntile) return false;
        const volatile LAS int* tt = pre + 64 + 2 * T;
        const int w0 = __builtin_amdgcn_readfirstlane(tt[0]), w1 = __builtin_amdgcn_readfirstlane(tt[1]);
        u.e = (int)((unsigned)w0 >> 24); u.pm = T; u.pn = L & 3; u.t0 = w0 & 0xffffff; u.cnt = w1; return true;
    }
    __device__ __forceinline__ int arow(const Unit& u, int r) const {
        if (GATHER_) { const int pos = u.t0 + r; return pos < u.cnt ? tok[u.e * ECAP + pos] : 0; }
        return u.pm * BM + r;
    }
    __device__ __forceinline__ const bf16_t* bptr(const Unit& u) const { return W + ((size_t)u.e * 1024 + (size_t)u.pn * BM) * K; }
};

template <class Epi, class Sched>
__device__ __forceinline__ void gemm_phase(LAS unsigned char* lds, const bf16_t* Abase_, int K, const Sched& S, const Epi& E, int wv) {
    int tid = tid_of(wv); asm volatile("" : "+v"(tid));
    const int wid = __builtin_amdgcn_readfirstlane(tid >> 6), lane = tid & 63, wr = wid >> 2, wc = wid & 3, fr = lane & 15, fq = lane >> 4;
    constexpr bool GATHER = Sched::GATHER;
    const int nt = K / BK;
    int Rs[2], Cs[2]; unsigned voffA[2], voffB[2];
#pragma unroll
    for (int i = 0; i < 2; ++i) { int R, C; stage_rc(tid * 16 + i * 8192, R, C); Rs[i] = R; Cs[i] = C; const int Rb = Epi::PERM ? ((R & ~31) + perm32(R & 31)) : R;
        voffA[i] = (unsigned)(R * K + C) * 2u; voffB[i] = (unsigned)(Rb * K + C) * 2u; }
    const size_t kstep = (size_t)(BK * 2);
    const size_t hstep = (size_t)HALF * K * 2;
    const unsigned ldsw = (unsigned)wid * 1024u;
    const char* Abase = (const char*)Abase_;
    const int aoff = lds_byte(wr * 64 + fr, fq * 8), boff = lds_byte(wc * 32 + fr, fq * 8);
#define PG8_SA(b, h) (((b) * 2 + (h)) * HTB)
#define PG8_SB(b, h) ((4 + (b) * 2 + (h)) * HTB)
#define PG8_STAGE(bufoff, gbase, v0, v1) do { \
        __builtin_amdgcn_global_load_lds((const unsigned*)((const char*)(gbase) + (v0)), (LAS unsigned*)(lds + (bufoff) + ldsw), 16, 0, 0); \
        __builtin_amdgcn_global_load_lds((const unsigned*)((const char*)(gbase) + (v1)), (LAS unsigned*)(lds + (bufoff) + ldsw + 8192), 16, 0, 0); } while (0)
#define PG8_STAGE_AC(bufoff, h, koff) do { if constexpr (GATHER) PG8_STAGE(bufoff, Abase + (koff), cA[h][0], cA[h][1]); else PG8_STAGE(bufoff, cAp + (h) * hstep + (koff), voffA[0], voffA[1]); } while (0)
#define PG8_STAGE_AX(bufoff, h, koff) do { if constexpr (GATHER) PG8_STAGE(bufoff, a2p + (koff), (h) ? x10 : x00, (h) ? x11 : x01); else PG8_STAGE(bufoff, a2p + (h) * hstep + (koff), voffA[0], voffA[1]); } while (0)
#define PG8_STAGE_B(bufoff, gbase) PG8_STAGE(bufoff, gbase, voffB[0], voffB[1])
#define PG8_LDA(dst, b, h) do { _Pragma("unroll") for (int m = 0; m < 4; ++m) _Pragma("unroll") for (int k = 0; k < 2; ++k) dst[m][k] = *(const LAS bf16x8*)(lds + PG8_SA(b, h) + aoff + m * 2048 + k * 1024); } while (0)
#define PG8_LDB(dst, b, h) do { _Pragma("unroll") for (int n = 0; n < 2; ++n) _Pragma("unroll") for (int k = 0; k < 2; ++k) dst[n][k] = *(const LAS bf16x8*)(lds + PG8_SB(b, h) + boff + n * 2048 + k * 1024); } while (0)
#define PG8_MMA(ai, bj, At, Bt) do { __builtin_amdgcn_s_setprio(1); _Pragma("unroll") for (int m = 0; m < 4; ++m) _Pragma("unroll") for (int n = 0; n < 2; ++n) _Pragma("unroll") for (int k = 0; k < 2; ++k) \
        acc[ai][bj][m][n] = __builtin_amdgcn_mfma_f32_16x16x32_bf16(Bt[n][k], At[m][k], acc[ai][bj][m][n], 0, 0, 0); __builtin_amdgcn_s_setprio(0); } while (0)
#define PG8_WAIT_V(n) asm volatile("s_waitcnt vmcnt(" #n ")" ::: "memory")
#define PG8_WAIT_L(n) asm volatile("s_waitcnt lgkmcnt(" #n ")" ::: "memory")
#define PG8_BAR __builtin_amdgcn_s_barrier()
#define PG8_SCHED __builtin_amdgcn_sched_barrier(0)
#define PG8_MKA(dst, u) do { _Pragma("unroll") for (int h_ = 0; h_ < 2; ++h_) _Pragma("unroll") for (int i_ = 0; i_ < 2; ++i_) dst[h_][i_] = ((unsigned)S.arow(u, h_ * HALF + Rs[i_]) * (unsigned)K + (unsigned)Cs[i_]) * 2u; } while (0)
    Unit cur, nxt; int ui = 0;
    if (!S.next(0, cur)) return;
    f32x4 acc[2][2][4][2];
#pragma unroll
    for (int a = 0; a < 2; ++a)
#pragma unroll
        for (int b = 0; b < 2; ++b)
#pragma unroll
            for (int m = 0; m < 4; ++m)
#pragma unroll
                for (int n = 0; n < 2; ++n) acc[a][b][m][n] = (f32x4){0.f, 0.f, 0.f, 0.f};
    bf16x8 At[4][2], B0[2][2], B1[2][2];
    unsigned cA[2][2] = {{0u, 0u}, {0u, 0u}}, nA[2][2] = {{0u, 0u}, {0u, 0u}};
    const char* cAp = Abase; const char* nAp = Abase;
    if constexpr (GATHER) { PG8_MKA(cA, cur); } else { cAp = Abase + (size_t)S.arow(cur, 0) * K * 2; }
    const char* cB = (const char*)S.bptr(cur);
    PG8_STAGE_B(PG8_SB(0, 0), cB); PG8_STAGE_B(PG8_SB(0, 1), cB + hstep); PG8_STAGE_AC(PG8_SA(0, 0), 0, 0); PG8_STAGE_AC(PG8_SA(0, 1), 1, 0);
    if (wr == 1) PG8_BAR;
    PG8_WAIT_V(2); PG8_BAR;
    PG8_STAGE_B(PG8_SB(1, 0), cB + kstep); PG8_STAGE_AC(PG8_SA(1, 0), 0, kstep); PG8_STAGE_B(PG8_SB(1, 1), cB + hstep + kstep);
    PG8_WAIT_V(6); PG8_BAR;
    for (;;) {
        const bool has_next = S.next(ui + 1, nxt);
        const char* nB = cB; nAp = cAp;
        if (has_next) { nB = (const char*)S.bptr(nxt); if constexpr (GATHER) { PG8_MKA(nA, nxt); } else { nAp = Abase + (size_t)S.arow(nxt, 0) * K * 2; } }
        else { if constexpr (GATHER) {
#pragma unroll
            for (int h_ = 0; h_ < 2; ++h_)
#pragma unroll
                for (int i_ = 0; i_ < 2; ++i_) nA[h_][i_] = cA[h_][i_]; } }
        for (int t = 0; t < nt; t += 2) {
            const bool last = (t == nt - 2);
            const size_t k1 = (size_t)(t + 1) * kstep, k2 = last ? (size_t)0 : (size_t)(t + 2) * kstep;
            const char* a2p = (GATHER ? Abase : (last ? nAp : cAp)) + k2; const char* b2 = (last ? nB : cB) + k2;
            const char* b3 = b2 + kstep;
            const unsigned x00 = last ? nA[0][0] : cA[0][0], x01 = last ? nA[0][1] : cA[0][1], x10 = last ? nA[1][0] : cA[1][0], x11 = last ? nA[1][1] : cA[1][1];
            PG8_LDB(B0, 0, 0); PG8_LDB(B1, 0, 1); PG8_SCHED; PG8_LDA(At, 0, 0); PG8_STAGE_AC(PG8_SA(1, 1), 1, k1);
            PG8_WAIT_V(8); PG8_WAIT_L(0); PG8_BAR; PG8_MMA(0, 0, At, B0); PG8_MMA(0, 1, At, B1); PG8_BAR; PG8_SCHED;
            PG8_LDA(At, 0, 1); PG8_STAGE_B(PG8_SB(0, 0), b2); PG8_STAGE_B(PG8_SB(0, 1), b2 + hstep); PG8_STAGE_AX(PG8_SA(0, 0), 0, 0);
            PG8_WAIT_V(8); PG8_WAIT_L(0); PG8_BAR; PG8_MMA(1, 0, At, B0); PG8_MMA(1, 1, At, B1); PG8_BAR; PG8_SCHED;
            PG8_LDB(B0, 1, 0); PG8_LDB(B1, 1, 1); PG8_SCHED; PG8_LDA(At, 1, 0); PG8_STAGE_AX(PG8_SA(0, 1), 1, 0);
            PG8_WAIT_V(8); PG8_WAIT_L(0); PG8_BAR; PG8_MMA(0, 0, At, B0); PG8_MMA(0, 1, At, B1); PG8_BAR; PG8_SCHED;
            PG8_LDA(At, 1, 1); PG8_STAGE_B(PG8_SB(1, 0), b3); PG8_STAGE_B(PG8_SB(1, 1), b3 + hstep); PG8_STAGE_AX(PG8_SA(1, 0), 0, kstep);
            PG8_WAIT_V(8); PG8_WAIT_L(0); PG8_BAR; PG8_MMA(1, 0, At, B0); PG8_MMA(1, 1, At, B1); PG8_BAR; PG8_SCHED;
        }
        if (wr == 0) PG8_BAR;
        E(acc, cur, wr, wc, fr, fq);
        if (!has_next) break;
#pragma unroll
        for (int a = 0; a < 2; ++a)
#pragma unroll
            for (int b = 0; b < 2; ++b)
#pragma unroll
                for (int m = 0; m < 4; ++m)
#pragma unroll
                    for (int n = 0; n < 2; ++n) acc[a][b][m][n] = (f32x4){0.f, 0.f, 0.f, 0.f};
        cur = nxt; cB = nB; cAp = nAp; ++ui;
        if constexpr (GATHER) {
#pragma unroll
        for (int h_ = 0; h_ < 2; ++h_)
#pragma unroll
            for (int i_ = 0; i_ < 2; ++i_) cA[h_][i_] = nA[h_][i_]; }
        if (wr == 1) PG8_BAR;
    }
    PG8_WAIT_V(0);
    PG8_BAR;
#undef PG8_SA
#undef PG8_SB
#undef PG8_STAGE
#undef PG8_STAGE_AC
#undef PG8_STAGE_AX
#undef PG8_STAGE_B
#undef PG8_LDA
#undef PG8_LDB
#undef PG8_MMA
#undef PG8_WAIT_V
#undef PG8_WAIT_L
#undef PG8_BAR
#undef PG8_SCHED
#undef PG8_MKA
}

struct EpiWin {
    static constexpr bool PERM = true;
    bf16_t* proj; const float* rrow; const float* dqn; const float* cqn;
    __device__ __forceinline__ void operator()(const f32x4 (&acc)[2][2][4][2], const Unit& u, int wr, int wc, int fr, int fq) const {
        const int pn = u.pn;
        const float* g = nullptr;
        if (pn == 3 || pn == 4) g = dqn; else if (pn == 5 || pn == 6) g = dqn + 64; else if (pn == 9) g = cqn; else if (pn == 10) g = cqn + 64;
        const float qs = (pn == 0 || pn == 3 || pn == 4 || pn == 9) ? QSCALE : 1.0f;
        f32x4 gv[2][2];
#pragma unroll
        for (int bj = 0; bj < 2; ++bj)
#pragma unroll
            for (int n = 0; n < 2; ++n) { f32x4 t = g ? *(const f32x4*)(g + 32 * bj + 8 * fq + 4 * n) : (f32x4){1.f, 1.f, 1.f, 1.f}; gv[bj][n] = t * qs; }
        const bool donorm = (g != nullptr);
#pragma unroll
        for (int ai = 0; ai < 2; ++ai)
#pragma unroll
            for (int m = 0; m < 4; ++m) {
                const int row = u.pm * BM + ai * HALF + wr * 64 + m * 16 + fr;
                const float rs = rrow[row];
                f32x4 v[2][2]; float ss = 0.f;
#pragma unroll
                for (int bj = 0; bj < 2; ++bj)
#pragma unroll
                    for (int n = 0; n < 2; ++n) { v[bj][n] = acc[ai][bj][m][n] * rs; const f32x4 q = v[bj][n] * v[bj][n]; ss += (q[0] + q[1]) + (q[2] + q[3]); }
                float rn = 1.0f;
                if (donorm) { ss += swz_xor<16>(ss); ss = sum_x32(ss); rn = __builtin_amdgcn_rsqf(ss * (1.0f / 64.0f) + EPS); }
                bf16_t* rowp = proj + (size_t)row * QKVW + pn * BM + 64 * wc + 8 * fq;
#pragma unroll
                for (int bj = 0; bj < 2; ++bj) { const f32x4 a = v[bj][0] * rn * gv[bj][0], b = v[bj][1] * rn * gv[bj][1];
                    u32x4 w; w.x = pk2(a[0], a[1]); w.y = pk2(a[2], a[3]); w.z = pk2(b[0], b[1]); w.w = pk2(b[2], b[3]);
                    *(u32x4*)(rowp + 32 * bj) = w; }
            }
    }
};
struct EpiWout {
    static constexpr bool PERM = true;
    bf16_t* h;
    __device__ __forceinline__ void operator()(const f32x4 (&acc)[2][2][4][2], const Unit& u, int wr, int wc, int fr, int fq) const {
#pragma unroll
        for (int ai = 0; ai < 2; ++ai)
#pragma unroll
            for (int m = 0; m < 4; ++m) { bf16_t* rowp = h + (size_t)(u.pm * BM + ai * HALF + wr * 64 + m * 16 + fr) * DM + u.pn * BM + wc * 32 + 8 * fq;
#pragma unroll
                for (int bj = 0; bj < 2; ++bj) { const u32x4 b = *(const u32x4*)(rowp + bj * HALF); const f32x4 a0 = acc[ai][bj][m][0], a1 = acc[ai][bj][m][1];
                    u32x4 w; w.x = pk2(bflo(b.x) + a0[0], bfhi(b.x) + a0[1]); w.y = pk2(bflo(b.y) + a0[2], bfhi(b.y) + a0[3]); w.z = pk2(bflo(b.z) + a1[0], bfhi(b.z) + a1[1]); w.w = pk2(bflo(b.w) + a1[2], bfhi(b.w) + a1[3]);
                    *(u32x4*)(rowp + bj * HALF) = w; }
                if (m == 3) asm volatile("" ::: "memory"); }
    }
};
struct EpiGU {
    static constexpr bool PERM = true;
    bf16_t* hid; const float* rsl;
    __device__ __forceinline__ void operator()(const f32x4 (&acc)[2][2][4][2], const Unit& u, int wr, int wc, int fr, int fq) const {
#pragma unroll
        for (int ai = 0; ai < 2; ++ai)
#pragma unroll
            for (int m = 0; m < 4; ++m) {
                const int rl = ai * HALF + wr * 64 + m * 16 + fr, pos = u.t0 + rl;
                const float rs = pos < u.cnt ? rsl[u.e * ECAP + pos] : 0.f;
                float o[8];
#pragma unroll
                for (int n = 0; n < 2; ++n)
#pragma unroll
                    for (int i = 0; i < 4; ++i) { const float gt = acc[ai][0][m][n][i] * rs, up = acc[ai][1][m][n][i] * rs;
                        const float sg = gt * __builtin_amdgcn_rcpf(1.0f + __builtin_amdgcn_exp2f(-gt * LOG2E)); o[n * 4 + i] = sg * up; }
                u32x4 w; w.x = pk2(o[0], o[1]); w.y = pk2(o[2], o[3]); w.z = pk2(o[4], o[5]); w.w = pk2(o[6], o[7]);
                *(u32x4*)(hid + (size_t)(u.pm * BM + rl) * DEXP + u.pn * HALF + 32 * wc + 8 * fq) = w;
            }
    }
};
struct EpiDown {
    static constexpr bool PERM = true;
    bf16_t* ybuf; const float* gl;
    __device__ __forceinline__ void operator()(const f32x4 (&acc)[2][2][4][2], const Unit& u, int wr, int wc, int fr, int fq) const {
#pragma unroll
        for (int ai = 0; ai < 2; ++ai)
#pragma unroll
            for (int m = 0; m < 4; ++m) {
                const int rl = ai * HALF + wr * 64 + m * 16 + fr, pos = u.t0 + rl;
                const float gt = pos < u.cnt ? gl[u.e * ECAP + pos] : 0.f;
                bf16_t* rowp = ybuf + (size_t)(u.pm * BM + rl) * DM + u.pn * BM + wc * 32 + 8 * fq;
#pragma unroll
                for (int bj = 0; bj < 2; ++bj) { const f32x4 a = acc[ai][bj][m][0] * gt, b = acc[ai][bj][m][1] * gt;
                    u32x4 w; w.x = pk2(a[0], a[1]); w.y = pk2(a[2], a[3]); w.z = pk2(b[0], b[1]); w.w = pk2(b[2], b[3]);
                    *(u32x4*)(rowp + bj * HALF) = w; }
            }
    }
};
}

template <int IMM = 0> __device__ __forceinline__ void glds16_asm(const void* gsrc, unsigned lds_dst) {
    unsigned keep;
    asm volatile("s_mov_b32 %0, m0\n\ts_mov_b32 m0, %2\n\ts_nop 0\n\tglobal_load_lds_dwordx4 %1, off offset:%3\n\ts_mov_b32 m0, %0" : "=&s"(keep) : "v"(gsrc), "s"(lds_dst), "i"(IMM) : "memory");
}
__device__ __forceinline__ void glds16s_asm(const void* sbase, unsigned voff, unsigned lds_dst) {
    unsigned keep;
    asm volatile("s_mov_b32 %0, m0\n\ts_mov_b32 m0, %3\n\ts_nop 0\n\tglobal_load_lds_dwordx4 %1, %2\n\ts_mov_b32 m0, %0" : "=&s"(keep) : "v"(voff), "s"(sbase), "s"(lds_dst) : "memory");
}
__device__ __forceinline__ int crow(int r, int hi) { return (r & 3) + 8 * (r >> 2) + 4 * hi; }
__device__ __forceinline__ v4i16 vtr(const LAS unsigned char* p) { return __builtin_amdgcn_ds_read_tr16_b64_v4i16((LAS v4i16*)p); }
__device__ __forceinline__ bf16x8 mk8(v4i16 lo, v4i16 hi) { return (bf16x8){lo[0], lo[1], lo[2], lo[3], hi[0], hi[1], hi[2], hi[3]}; }
__device__ __forceinline__ void qk_tile(f32x16& p0, f32x16& p1, const LAS unsigned char* kt, const bf16x8* qr, int r32, int hi) {
    const int x = (r32 >> 1) & 7, y = x >> 1;
    const LAS unsigned char* kb = kt + r32 * 128 + ((hi ^ (x & 1)) << 4);
#pragma unroll
    for (int d0 = 0; d0 < 4; ++d0) {
        const bf16x8 a0 = *(const LAS bf16x8*)(kb + ((d0 ^ y) << 5)), a1 = *(const LAS bf16x8*)(kb + ((d0 ^ y) << 5) + 4096);
        p0 = __builtin_amdgcn_mfma_f32_32x32x16_bf16(a0, qr[d0], p0, 0, 0, 0);
        p1 = __builtin_amdgcn_mfma_f32_32x32x16_bf16(a1, qr[d0], p1, 0, 0, 0);
    }
}
template <int ND> __device__ __forceinline__ void pv_tile(f32x16* o, const LAS unsigned char* vt, const bf16x8* pa, int lane, int hi) {
    const LAS unsigned char* vb = vt + ((lane >> 4) & 1) * 32 + (lane & 3) * 8 + (4 * hi + ((lane & 15) >> 2)) * 64;
#pragma unroll
    for (int d0 = 0; d0 < ND; ++d0) {
        v4i16 lo[4], h2[4];
#pragma unroll
        for (int ks = 0; ks < 4; ++ks) { lo[ks] = vtr(vb + d0 * 4096 + ks * 1024); h2[ks] = vtr(vb + d0 * 4096 + ks * 1024 + 512); }
#pragma unroll
        for (int ks = 0; ks < 4; ++ks) o[d0] = __builtin_amdgcn_mfma_f32_32x32x16_bf16(mk8(lo[ks], h2[ks]), pa[ks], o[d0], 0, 0, 0);
        __builtin_amdgcn_sched_barrier(0);
    }
}
__device__ __forceinline__ void pack_p(bf16x8* pa, const f32x16& p0, const f32x16& p1) {
    u32x4 w;
    w.x = pk2(p0[0], p0[1]); w.y = pk2(p0[2], p0[3]); w.z = pk2(p0[4], p0[5]); w.w = pk2(p0[6], p0[7]); pa[0] = __builtin_bit_cast(bf16x8, w);
    w.x = pk2(p0[8], p0[9]); w.y = pk2(p0[10], p0[11]); w.z = pk2(p0[12], p0[13]); w.w = pk2(p0[14], p0[15]); pa[1] = __builtin_bit_cast(bf16x8, w);
    w.x = pk2(p1[0], p1[1]); w.y = pk2(p1[2], p1[3]); w.z = pk2(p1[4], p1[5]); w.w = pk2(p1[6], p1[7]); pa[2] = __builtin_bit_cast(bf16x8, w);
    w.x = pk2(p1[8], p1[9]); w.y = pk2(p1[10], p1[11]); w.z = pk2(p1[12], p1[13]); w.w = pk2(p1[14], p1[15]); pa[3] = __builtin_bit_cast(bf16x8, w);
}
#define SM_THR 8.0f
#ifndef PROBE_VAR
#define PROBE_VAR 0
#endif
template <int ND> __device__ __forceinline__ void sm_update(f32x16& p0, f32x16& p1, float& mref, float& l, f32x16* o, f32x16& cm, float cb, bool first, float& adj) {
    if (__any(adj != 0.f)) {
#pragma unroll
        for (int r = 0; r < 16; ++r) { p0[r] -= adj; p1[r] -= adj; }
    }
    adj = 0.f;
    float a = __builtin_fmaxf(__builtin_fmaxf(p0[0], p0[1]), p1[0]), b = __builtin_fmaxf(__builtin_fmaxf(p0[2], p0[3]), p1[1]); a = __builtin_fmaxf(__builtin_fmaxf(a, p1[2]), p1[3]);
#pragma unroll
    for (int r = 4; r < 16; r += 4) { a = __builtin_fmaxf(__builtin_fmaxf(a, p0[r]), p0[r + 1]); b = __builtin_fmaxf(__builtin_fmaxf(b, p0[r + 2]), p0[r + 3]);
        a = __builtin_fmaxf(__builtin_fmaxf(a, p1[r]), p1[r + 1]); b = __builtin_fmaxf(__builtin_fmaxf(b, p1[r + 2]), p1[r + 3]); }
    float mx = __builtin_fmaxf(a, b);
    if (first) {
        mx = max_x32(mx);
        mref = mx; adj = mx;
#pragma unroll
        for (int r = 0; r < 16; ++r) { p0[r] -= mx; p1[r] -= mx; cm[r] = cb - mx; }
    } else if (__any(mx > SM_THR)) {
        mx = max_x32(mx);
        const float d = __builtin_fmaxf(mx, 0.f);
        mref += d; adj = d;
        const float alpha = __builtin_amdgcn_exp2f(-d);
        l *= alpha;
#pragma unroll
        for (int r = 0; r < 16; ++r) { p0[r] -= d; p1[r] -= d; cm[r] = cb - mref; }
#pragma unroll
        for (int d0 = 0; d0 < ND; ++d0)
#pragma unroll
            for (int r = 0; r < 16; ++r) o[d0][r] *= alpha;
    }
    float s0 = 0.f, s1 = 0.f;
#pragma unroll
    for (int r = 0; r < 16; ++r) { p0[r] = __builtin_amdgcn_exp2f(p0[r]); p1[r] = __builtin_amdgcn_exp2f(p1[r]); s0 += p0[r]; s1 += p1[r]; }
    l += s0 + s1;
}
template <bool DUM = false> __device__ __forceinline__ void qk_tile_c(f32x16& p0, f32x16& p1, const LAS unsigned char* kt, const bf16x8* qr, const f32x16& cm, int r32, int hi) {
    if (DUM && PROBE_VAR == 3) { p0 = cm; p1 = cm;
#pragma unroll
        for (int d0 = 0; d0 < 4; ++d0) { p0 = __builtin_amdgcn_mfma_f32_32x32x16_bf16(qr[d0], qr[0], p0, 0, 0, 0); p1 = __builtin_amdgcn_mfma_f32_32x32x16_bf16(qr[d0], qr[1], p1, 0, 0, 0); }
        return; }
    const int x = (r32 >> 1) & 7;
    const LAS unsigned char* kb = kt + r32 * 128 + ((hi ^ (x & 1)) << 4);
    const int y = x >> 1;
#define K_PAIR(a_, b_, d0_) do { a_ = *(const LAS bf16x8*)(kb + (((d0_) ^ y) << 5)); b_ = *(const LAS bf16x8*)(kb + (((d0_) ^ y) << 5) + 4096); } while (0)
    bf16x8 ka0, kb0, ka1, kb1;
    K_PAIR(ka0, kb0, 0); K_PAIR(ka1, kb1, 1);
    __builtin_amdgcn_sched_barrier(0);
    if (DUM && PROBE_VAR == 2) { asm volatile("" :: "v"(ka0), "v"(kb0), "v"(ka1), "v"(kb1)); K_PAIR(ka0, kb0, 2); K_PAIR(ka1, kb1, 3); asm volatile("" :: "v"(ka0), "v"(kb0), "v"(ka1), "v"(kb1)); p0 = cm; p1 = cm; return; }
    p0 = __builtin_amdgcn_mfma_f32_32x32x16_bf16(ka0, qr[0], cm, 0, 0, 0); p1 = __builtin_amdgcn_mfma_f32_32x32x16_bf16(kb0, qr[0], cm, 0, 0, 0);
    __builtin_amdgcn_sched_barrier(0);
    K_PAIR(ka0, kb0, 2);
    __builtin_amdgcn_sched_barrier(0);
    p0 = __builtin_amdgcn_mfma_f32_32x32x16_bf16(ka1, qr[1], p0, 0, 0, 0); p1 = __builtin_amdgcn_mfma_f32_32x32x16_bf16(kb1, qr[1], p1, 0, 0, 0);
    __builtin_amdgcn_sched_barrier(0);
    K_PAIR(ka1, kb1, 3);
    __builtin_amdgcn_sched_barrier(0);
    p0 = __builtin_amdgcn_mfma_f32_32x32x16_bf16(ka0, qr[2], p0, 0, 0, 0); p1 = __builtin_amdgcn_mfma_f32_32x32x16_bf16(kb0, qr[2], p1, 0, 0, 0);
    p0 = __builtin_amdgcn_mfma_f32_32x32x16_bf16(ka1, qr[3], p0, 0, 0, 0); p1 = __builtin_amdgcn_mfma_f32_32x32x16_bf16(kb1, qr[3], p1, 0, 0, 0);
#undef K_PAIR
}
__device__ __forceinline__ void v_read8(v4i16* vf, const LAS unsigned char* vb, int d0) {
#pragma unroll
    for (int ks = 0; ks < 4; ++ks) { vf[2 * ks] = vtr(vb + d0 * 4096 + ks * 1024); vf[2 * ks + 1] = vtr(vb + d0 * 4096 + ks * 1024 + 512); }
}
__device__ __forceinline__ void pv_block(f32x16& o, const v4i16* vf, const bf16x8* pa) {
#pragma unroll
    for (int ks = 0; ks < 4; ++ks) o = __builtin_amdgcn_mfma_f32_32x32x16_bf16(mk8(vf[2 * ks], vf[2 * ks + 1]), pa[ks], o, 0, 0, 0);
}
template <int ND, bool DUM = false> __device__ __forceinline__ void attn_sm(f32x16& p0, f32x16& p1, f32x16& cm, float cb, const LAS float* tp, bool near, bool first,
                                                          float& mref, float& l, f32x16* o, bf16x8* pa, float& adj) {
    if (DUM && PROBE_VAR == 1) { asm volatile("" : "+v"(p0), "+v"(p1)); u32x4 w0 = {__builtin_bit_cast(unsigned, p0[0]), __builtin_bit_cast(unsigned, p0[1]), __builtin_bit_cast(unsigned, p0[2]), __builtin_bit_cast(unsigned, p0[3])}; pa[0] = pa[1] = pa[2] = pa[3] = __builtin_bit_cast(bf16x8, w0); return; }
    if (near) {
#pragma unroll
        for (int g = 0; g < 4; ++g) {
#pragma unroll
            for (int i = 0; i < 4; ++i) { const int r = 4 * g + i; p0[r] += tp[(r & 3) + 8 * (r >> 2)]; p1[r] += tp[(r & 3) + 8 * (r >> 2) + 32]; }
            __builtin_amdgcn_sched_barrier(0);
        }
    }
    sm_update<ND>(p0, p1, mref, l, o, cm, cb, first, adj);
    pack_p(pa, p0, p1);
}
template <int ND, bool DUM = false> __device__ __forceinline__ void attn_s2(const LAS unsigned char* vt, const bf16x8* pa, f32x16* o, int lane, int hi) {
    const LAS unsigned char* vb = vt + ((lane >> 4) & 1) * 32 + (lane & 3) * 8 + (4 * hi + ((lane & 15) >> 2)) * 64;
    if (DUM && PROBE_VAR == 3) {
#pragma unroll
        for (int d0 = 0; d0 < ND; ++d0)
#pragma unroll
            for (int ks = 0; ks < 4; ++ks) o[d0] = __builtin_amdgcn_mfma_f32_32x32x16_bf16(pa[(ks + 1) & 3], pa[ks], o[d0], 0, 0, 0);
        return; }
    v4i16 hA[4], hB[4];
#define PV_MFMA(X, Y, PA, O) do { if (DUM && PROBE_VAR == 2) { asm volatile("" :: "v"(X), "v"(Y)); } else O = __builtin_amdgcn_mfma_f32_32x32x16_bf16(mk8(X, Y), PA, O, 0, 0, 0); } while (0)
#define V_HALF(dst, d0_, half_) do { _Pragma("unroll") for (int q_ = 0; q_ < 2; ++q_) { dst[2 * q_] = vtr(vb + (d0_) * 4096 + (2 * (half_) + q_) * 1024); dst[2 * q_ + 1] = vtr(vb + (d0_) * 4096 + (2 * (half_) + q_) * 1024 + 512); } } while (0)
    V_HALF(hA, 0, 0); V_HALF(hB, 0, 1);
#pragma unroll
    for (int d0 = 0; d0 < ND; ++d0) {
        __builtin_amdgcn_sched_barrier(0);
        PV_MFMA(hA[0], hA[1], pa[0], o[d0]);
        PV_MFMA(hA[2], hA[3], pa[1], o[d0]);
        __builtin_amdgcn_sched_barrier(0);
        if (d0 + 1 < ND) V_HALF(hA, d0 + 1, 0);
        __builtin_amdgcn_sched_barrier(0);
        PV_MFMA(hB[0], hB[1], pa[2], o[d0]);
        PV_MFMA(hB[2], hB[3], pa[3], o[d0]);
        __builtin_amdgcn_sched_barrier(0);
        if (d0 + 1 < ND) V_HALF(hB, d0 + 1, 1);
    }
#undef V_HALF
#undef PV_MFMA
}
__device__ __forceinline__ float rowmax32(const f32x16& p0, const f32x16& p1) {
    float a = __builtin_fmaxf(__builtin_fmaxf(p0[0], p0[1]), p1[0]), b = __builtin_fmaxf(__builtin_fmaxf(p0[2], p0[3]), p1[1]); a = __builtin_fmaxf(__builtin_fmaxf(a, p1[2]), p1[3]);
#pragma unroll
    for (int r = 4; r < 16; r += 4) { a = __builtin_fmaxf(__builtin_fmaxf(a, p0[r]), p0[r + 1]); b = __builtin_fmaxf(__builtin_fmaxf(b, p0[r + 2]), p0[r + 3]);
        a = __builtin_fmaxf(__builtin_fmaxf(a, p1[r]), p1[r + 1]); b = __builtin_fmaxf(__builtin_fmaxf(b, p1[r + 2]), p1[r + 3]); }
    return __builtin_fmaxf(a, b);
}
template <int ND> __device__ __forceinline__ void attn_fast(const f32x16& p0, const f32x16& p1, float& l, f32x16* o, const LAS unsigned char* vt, bf16x8* pa, int lane, int hi) {
    const bf16x8* pa_prev = pa; bf16x8* pa_cur = pa;
    const LAS unsigned char* vb = vt + ((lane >> 4) & 1) * 32 + (lane & 3) * 8 + (4 * hi + ((lane & 15) >> 2)) * 64;
    v4i16 hA[4], hB[4];
    unsigned w[16]; float s0 = 0.f, s1 = 0.f;
#define V_HALF(dst, d0_, half_) do { _Pragma("unroll") for (int q_ = 0; q_ < 2; ++q_) { dst[2 * q_] = vtr(vb + (d0_) * 4096 + (2 * (half_) + q_) * 1024); dst[2 * q_ + 1] = vtr(vb + (d0_) * 4096 + (2 * (half_) + q_) * 1024 + 512); } } while (0)
#define PAIR(j_) do { const int j__ = (j_), i0_ = (2 * j__) & 15, i1_ = (2 * j__ + 1) & 15; float x0_ = j__ < 8 ? p0[i0_] : p1[i0_], x1_ = j__ < 8 ? p0[i1_] : p1[i1_]; \
        asm volatile("" : "+v"(x0_), "+v"(x1_));     \
        const float e0 = __builtin_amdgcn_exp2f(x0_), e1 = __builtin_amdgcn_exp2f(x1_); s0 += e0; s1 += e1; w[j__] = pk2(e0, e1); \
        asm volatile("" : "+v"(w[j__]), "+v"(s0), "+v"(s1)); } while (0)
#define GAPV(g_) do { if (ND == 4) { PAIR(g_); } else { PAIR(2 * (g_)); PAIR(2 * (g_) + 1); } } while (0)
    V_HALF(hA, 0, 0); V_HALF(hB, 0, 1);
#pragma unroll
    for (int d0 = 0; d0 < ND; ++d0) {
        __builtin_amdgcn_sched_barrier(0);
        o[d0] = __builtin_amdgcn_mfma_f32_32x32x16_bf16(mk8(hA[0], hA[1]), pa_prev[0], o[d0], 0, 0, 0); GAPV(4 * d0 + 0);
        __builtin_amdgcn_sched_barrier(0);
        o[d0] = __builtin_amdgcn_mfma_f32_32x32x16_bf16(mk8(hA[2], hA[3]), pa_prev[1], o[d0], 0, 0, 0); GAPV(4 * d0 + 1);
        __builtin_amdgcn_sched_barrier(0);
        if (d0 + 1 < ND) V_HALF(hA, d0 + 1, 0);
        o[d0] = __builtin_amdgcn_mfma_f32_32x32x16_bf16(mk8(hB[0], hB[1]), pa_prev[2], o[d0], 0, 0, 0); GAPV(4 * d0 + 2);
        __builtin_amdgcn_sched_barrier(0);
        o[d0] = __builtin_amdgcn_mfma_f32_32x32x16_bf16(mk8(hB[2], hB[3]), pa_prev[3], o[d0], 0, 0, 0); GAPV(4 * d0 + 3);
        __builtin_amdgcn_sched_barrier(0);
        if (d0 + 1 < ND) V_HALF(hB, d0 + 1, 1);
    }
#undef V_HALF
#undef PAIR
#undef GAPV
    l += s0 + s1;
#pragma unroll
    for (int k = 0; k < 4; ++k) { u32x4 t4; t4.x = w[4 * k]; t4.y = w[4 * k + 1]; t4.z = w[4 * k + 2]; t4.w = w[4 * k + 3]; pa_cur[k] = __builtin_bit_cast(bf16x8, t4); }
}
__device__ __forceinline__ int t5_bucket_past_or_future(int rel) {
    const int n = rel < 0 ? -rel : rel;
    int v;
    if (n < 8) v = n;
    else v = 8 + (n >= 13) + (n >= 20) + (n >= 30) + (n >= 46) + (n >= 70) + (n >= 108) + (n >= 166);
    return (rel > 0 ? 16 : 0) + v;
}

template <bool DUM> __device__ __forceinline__ void attnB_unit(LAS unsigned char* lds, const bf16_t* proj, bf16_t* merged, const float* t5_bias, const float* dlam, const float* subln, float lam_init, float one_m_lam, int b, int h, int qb, int wv) {
    constexpr bool kvdummy = DUM;
    int tid = tid_of(wv); asm volatile("" : "+v"(tid)); const int lane = tid & 63, r32 = lane & 31, hi = lane >> 5; const int wid = __builtin_amdgcn_readfirstlane(tid >> 6);
    const int m = wid >> 2, s = wid & 3, q0w = qb * 128 + s * 32;
    const size_t tokbase = (size_t)b * SEQ;
    LAS float* tb = (LAS float*)(lds + TB_OFF);
    const float cb = t5_bias[15 * 4 + h] * LOG2E;
    for (int i = tid; i < 324; i += NWAVES * 64) tb[i] = t5_bias[t5_bucket_past_or_future(i - 260) * 4 + h] * LOG2E - cb;
    float lam;
    { float a = dlam[lane] * dlam[64 + lane], c = dlam[128 + lane] * dlam[192 + lane];
      a = wave_sum(a); c = wave_sum(c);
      lam = __expf(a) - __expf(c) + lam_init; }
    bf16x8 qr[4];
    { const bf16_t* qp = proj + (tokbase + q0w + r32) * QKVW + 768 + h * 128 + m * 64 + hi * 8;
#pragma unroll
      for (int d0 = 0; d0 < 4; ++d0) qr[d0] = *(const bf16x8*)(qp + d0 * 16); }
    const int ntiles = 2 * qb + 2, mylast = q0w >> 6;
    const int pid0 = wid, pid1 = wid + 8;
    const int kkey = 8 * wid + (lane >> 3), kch = (lane & 7) ^ ((kkey >> 1) & 7);
    const size_t tokkv = kvdummy ? (size_t)0 : tokbase; const int hkv = kvdummy ? 0 : h;
    const unsigned offK = (unsigned)(((tokkv + kkey) * QKVW + 1280 + hkv * 128 + 8 * kch) * 2);
    const unsigned offV = (unsigned)(((tokkv + 16 * (pid0 & 3) + (lane >> 2)) * QKVW + 1792 + hkv * 128 + 32 * (pid0 >> 2) + 8 * (lane & 3)) * 2);
    const size_t tstep = (size_t)64 * QKVW;
#define GLDS16(src, dstoff) glds16_asm<0>((const void*)(src), (unsigned)__builtin_amdgcn_readfirstlane((int)(ldsbase + (unsigned)(dstoff))))
#define GLDS16S(sbase, voff, dstoff) glds16s_asm((const void*)(sbase), (unsigned)(voff), (unsigned)__builtin_amdgcn_readfirstlane((int)(ldsbase + (unsigned)(dstoff))))
#define WAIT_BAR() asm volatile("s_waitcnt vmcnt(0) lgkmcnt(0)\n\ts_barrier" ::: "memory")
    const unsigned ldsbase = (unsigned)(size_t)lds;
    const int uK1 = wid * 1024, uK2 = 8192 + uK1, uV0 = 16384 + pid0 * 1024, uV1 = 16384 + pid1 * 1024;
#define B_ISSUE(t_, boff) do { const char* sb_ = (const char*)proj + (size_t)(t_) * tstep * 2; GLDS16S(sb_, offK, (boff) + uK1); GLDS16S(sb_ + 128, offK, (boff) + uK2); GLDS16S(sb_, offV, (boff) + uV0); GLDS16S(sb_ + 128, offV, (boff) + uV1); } while (0)
#define B_ISSUE_C(u_) do { const int u__ = (u_); if (u__ < ntiles && !(kvdummy && u__ >= 4)) B_ISSUE(u__, (u__ & 3) * 32768); } while (0)
    B_ISSUE_C(0); B_ISSUE_C(1);
    asm volatile("s_waitcnt vmcnt(4) lgkmcnt(0)\n\ts_barrier" ::: "memory");
    float mref = 0.f, l = 0.f, adj = 0.f; f32x16 o[4]; f32x16 cm;
#pragma unroll
    for (int d0 = 0; d0 < 4; ++d0) o[d0] = f32x16{};
#pragma unroll
    for (int r = 0; r < 16; ++r) cm[r] = cb;
    bf16x8 pa[4];
    f32x16 pA0, pA1;
    qk_tile_c<DUM>(pA0, pA1, lds + m * 8192, qr, cm, r32, hi);
#define STEP_PRE(tt) do { if ((tt) + 1 < ntiles) asm volatile("s_waitcnt vmcnt(0) lgkmcnt(0)\n\ts_barrier" ::: "memory"); B_ISSUE_C((tt) + 2); } while (0)
#define VPREV(tt) (lds + (((tt) - 1) & 3) * 32768 + 16384)
#define QK_NEXT(tt) do { __builtin_amdgcn_sched_barrier(0); if ((tt) + 1 <= mylast) qk_tile_c<DUM>(pA0, pA1, lds + (((tt) + 1) & 3) * 32768 + m * 8192, qr, cm, r32, hi); } while (0)
    const int tnear = (q0w < 229) ? 0 : ((q0w - 229) >> 6) + 1;
    const int tF = tnear < mylast + 1 ? tnear : mylast + 1;
    STEP_PRE(0);
    adj = 0.f; attn_sm<4, DUM>(pA0, pA1, cm, cb, tb + (0 - (q0w + r32) + 260 + 4 * hi), tnear == 0, true, mref, l, o, pa, adj);
    QK_NEXT(0);
    int t = 1;
    for (; t < tF; ++t) {
        if (__any(rowmax32(pA0, pA1) > SM_THR)) break;
        STEP_PRE(t);
        attn_fast<4>(pA0, pA1, l, o, VPREV(t), pa, lane, hi);
        QK_NEXT(t);
    }
    for (; t < tF; ++t) {
        STEP_PRE(t);
        attn_s2<4, DUM>(VPREV(t), pa, o, lane, hi);
        adj = 0.f; attn_sm<4, DUM>(pA0, pA1, cm, cb, tb, false, false, mref, l, o, pa, adj);
        QK_NEXT(t);
    }
    for (; t <= mylast; ++t) {
        STEP_PRE(t);
        attn_s2<4, DUM>(VPREV(t), pa, o, lane, hi);
        adj = 0.f; attn_sm<4, DUM>(pA0, pA1, cm, cb, tb + (64 * t - (q0w + r32) + 260 + 4 * hi), true, false, mref, l, o, pa, adj);
        QK_NEXT(t);
    }
    if (t < ntiles) { STEP_PRE(t); attn_s2<4, DUM>(VPREV(t), pa, o, lane, hi); for (++t; t < ntiles; ++t) STEP_PRE(t); }
    else attn_s2<4, DUM>(VPREV(t), pa, o, lane, hi);
    asm volatile("s_waitcnt lgkmcnt(0)\n\ts_barrier" ::: "memory");
#undef STEP_PRE
#undef VPREV
#undef QK_NEXT
#undef B_ISSUE_C
#undef B_ISSUE
    const float lt = sum_x32(l), inv = 1.0f / lt;
    LAS float* X = (LAS float*)lds;
    if (m == 1) {
#pragma unroll
        for (int d0 = 0; d0 < 4; ++d0)
#pragma unroll
            for (int r = 0; r < 16; ++r) X[((s * 64 + d0 * 16 + r) * 64) + lane] = o[d0][r] * inv;
    }
    __syncthreads();
    if (m == 0) {
        float ss = 0.f;
#pragma unroll
        for (int d0 = 0; d0 < 4; ++d0)
#pragma unroll
            for (int r = 0; r < 16; ++r) { const float y = o[d0][r] * inv - lam * X[((s * 64 + d0 * 16 + r) * 64) + lane]; o[d0][r] = y; ss += y * y; }
        ss = sum_x32(ss);
        const float rn = __builtin_amdgcn_rsqf(ss * (1.0f / 128.0f) + EPS) * one_m_lam;
        bf16_t* op = merged + (tokbase + q0w + r32) * DM + 256 + h * 128 + 4 * hi;
#pragma unroll
        for (int d0 = 0; d0 < 4; ++d0)
#pragma unroll
            for (int a = 0; a < 4; ++a) { const f32x4 g = *(const f32x4*)(subln + 32 * d0 + 8 * a + 4 * hi);
                u32x2 w; w.x = pk2(o[d0][4 * a] * rn * g[0], o[d0][4 * a + 1] * rn * g[1]); w.y = pk2(o[d0][4 * a + 2] * rn * g[2], o[d0][4 * a + 3] * rn * g[3]);
                *(u32x2*)(op + 32 * d0 + 8 * a) = w; }
    }
    __syncthreads();
}

__device__ __forceinline__ void attnC_unit(LAS unsigned char* lds, const bf16_t* proj, bf16_t* merged, const float* relb  , int b, int h, int qb, int wv) {
    int tid = tid_of(wv); asm volatile("" : "+v"(tid)); const int lane = tid & 63, r32 = lane & 31, hi = lane >> 5; const int wid = __builtin_amdgcn_readfirstlane(tid >> 6);
    const int c0 = 4 * qb, cw = c0 + (wid >> 1), q0w = 64 * cw + 32 * (wid & 1);
    const size_t tokbase = (size_t)b * SEQ;
    LAS float* tb = (LAS float*)(lds + TB_OFF);
    const float cb = relb[h] * LOG2E;
    for (int i = tid; i < 288; i += NWAVES * 64) { int rel = i - 224; rel = rel < -128 ? -128 : rel; tb[i] = relb[(rel + 128) * 4 + h] * LOG2E - cb; }
    bf16x8 qr[4];
    { const bf16_t* qp = proj + (tokbase + q0w + r32) * QKVW + 2304 + h * 64 + hi * 8;
#pragma unroll
      for (int d0 = 0; d0 < 4; ++d0) qr[d0] = *(const bf16x8*)(qp + d0 * 16); }
    const int tlo = c0 - 8 < 0 ? 0 : c0 - 8, thi = c0 + 3;
    const int kkey = 8 * wid + (lane >> 3), kch = (lane & 7) ^ ((kkey >> 1) & 7);
    const bf16_t* srcK = proj + (tokbase + kkey) * QKVW + 2560 + h * 64 + 8 * kch;
    const bf16_t* srcV = proj + (tokbase + 16 * (wid & 3) + (lane >> 2)) * QKVW + 2816 + h * 64 + 32 * (wid >> 2) + 8 * (lane & 3);
    const int uK = wid * 1024, uV = 8192 + uK;
    const unsigned ldsbase = (unsigned)(size_t)lds;
    const size_t tstep = (size_t)64 * QKVW;
#define C_ISSUE(t_, boff) do { const size_t off_ = (size_t)(t_) * tstep; GLDS16(srcK + off_, (boff) + uK); GLDS16(srcV + off_, (boff) + uV); } while (0)
    C_ISSUE(tlo, 0); C_ISSUE(tlo + 1, 16384);
    asm volatile("s_waitcnt vmcnt(2) lgkmcnt(0)\n\ts_barrier" ::: "memory");
    float mref = 0.f, l = 0.f, adj = 0.f; f32x16 o[2]; o[0] = f32x16{}; o[1] = f32x16{}; f32x16 cm;
#pragma unroll
    for (int r = 0; r < 16; ++r) cm[r] = cb;
    const int myfirst = cw - 8 < 0 ? 0 : cw - 8;
    int bc = 0, bn = 16384, bnn = 32768;
    bf16x8 pa[4];
    f32x16 pA0, pA1, pB0, pB1;
    if (tlo >= myfirst && tlo <= cw) qk_tile_c(pA0, pA1, lds, qr, cm, r32, hi);
#define C_STEP(PC0, PC1, PN0, PN1, t_) do { const int tt = (t_); const bool hasn = (tt + 1 <= thi); \
        if (hasn) asm volatile("s_waitcnt vmcnt(0) lgkmcnt(0)\n\ts_barrier" ::: "memory"); \
        if (tt + 2 <= thi) C_ISSUE(tt + 2, bnn); \
        if (hasn && tt + 1 >= myfirst && tt + 1 <= cw) qk_tile_c(PN0, PN1, lds + bn, qr, cm, r32, hi); \
        __builtin_amdgcn_sched_barrier(0); \
        if (tt >= myfirst && tt <= cw) { const bool near = (64 * tt + 63 - q0w > -128); \
            attn_sm<2>(PC0, PC1, cm, cb, tb + (64 * tt - (q0w + r32) + 224 + 4 * hi), near, tt == myfirst, mref, l, o, pa, adj); \
            attn_s2<2>(lds + bc + 8192, pa, o, lane, hi); } \
        const int tmp_ = bc; bc = bn; bn = bnn; bnn = tmp_; } while (0)
    for (int t = tlo; t <= thi; t += 2) { C_STEP(pA0, pA1, pB0, pB1, t); C_STEP(pB0, pB1, pA0, pA1, t + 1); }
#undef C_STEP
    asm volatile("s_waitcnt lgkmcnt(0)\n\ts_barrier" ::: "memory");
#undef C_ISSUE
    const float lt = sum_x32(l), inv = 1.0f / lt;
    bf16_t* op = merged + (tokbase + q0w + r32) * DM + 768 + h * 64 + 4 * hi;
#pragma unroll
    for (int d0 = 0; d0 < 2; ++d0)
#pragma unroll
        for (int a = 0; a < 4; ++a) { u32x2 w; w.x = pk2(o[d0][4 * a] * inv, o[d0][4 * a + 1] * inv); w.y = pk2(o[d0][4 * a + 2] * inv, o[d0][4 * a + 3] * inv); *(u32x2*)(op + 32 * d0 + 8 * a) = w; }
}

__device__ __forceinline__ void attnA_unit(LAS unsigned char* lds, const bf16_t* proj, bf16_t* merged, int b, int h, int qb, int wv) {
    int tid = tid_of(wv); asm volatile("" : "+v"(tid)); const int lane = tid & 63, r32 = lane & 31, hi = lane >> 5; const int wid = __builtin_amdgcn_readfirstlane(tid >> 6);
    const int q0w = 256 * qb + 32 * wid, td = q0w >> 6;
    const size_t tokbase = (size_t)b * SEQ;
    LAS unsigned char* wl = lds + wid * 16384;
    const unsigned ldsbase = (unsigned)(size_t)lds;
    bf16x8 qr[4];
    { const bf16_t* qp = proj + (tokbase + q0w + r32) * QKVW + h * 64 + hi * 8;
#pragma unroll
      for (int d0 = 0; d0 < 4; ++d0) qr[d0] = *(const bf16x8*)(qp + d0 * 16); }
    float carry = 0.f; f32x16 o[2]; o[0] = f32x16{}; o[1] = f32x16{};
    const int qpos = q0w + r32;
    const int wbase = wid * 16384;
    const bf16_t* kp0 = proj + (tokbase + (lane >> 3)) * QKVW + 256 + h * 64;
    const bf16_t* vp0 = proj + (tokbase + (lane >> 2)) * QKVW + 512 + h * 64 + 8 * (lane & 3);
#define A_ISSUE_K(t_) do { const bf16_t* kp = kp0 + (size_t)(64 * (t_)) * QKVW; _Pragma("unroll") for (int j = 0; j < 8; ++j) GLDS16(kp + (size_t)(8 * j) * QKVW + 8 * ((lane & 7) ^ (((8 * j + (lane >> 3)) >> 1) & 7)), wbase + j * 1024); } while (0)
#define A_ISSUE_V(t_) do { const bf16_t* vp = vp0 + (size_t)(64 * (t_)) * QKVW; _Pragma("unroll") for (int j = 0; j < 8; ++j) GLDS16(vp + (size_t)(16 * (j & 3)) * QKVW + 32 * (j >> 2), wbase + 8192 + j * 1024); } while (0)
    A_ISSUE_K(td); A_ISSUE_V(td);
    for (int t = td; t >= 0; --t) {
        asm volatile("s_waitcnt vmcnt(8)" ::: "memory");
        f32x16 p0 = f32x16{}, p1 = f32x16{};
        qk_tile(p0, p1, wl, qr, r32, hi);
        f32x16 k0, k1;
        const bool diag = (t == td);
#pragma unroll
        for (int r = 0; r < 16; ++r) {
            const float z0 = p0[r], z1 = p1[r];
            float a0 = -(fmaxf(z0, 0.f) + __builtin_amdgcn_logf(1.0f + __builtin_amdgcn_exp2f(-fabsf(z0))));
            float a1 = -(fmaxf(z1, 0.f) + __builtin_amdgcn_logf(1.0f + __builtin_amdgcn_exp2f(-fabsf(z1))));
            if (diag) { const int key = 64 * t + crow(r, hi); if (key >= qpos) a0 = 0.f; if (key + 32 >= qpos) a1 = 0.f; }
            k0[r] = a0; k1[r] = a1;
        }
        float G[2][4], Go[2][4];
#pragma unroll
        for (int a = 0; a < 4; ++a) { G[0][a] = (k0[4 * a] + k0[4 * a + 1]) + (k0[4 * a + 2] + k0[4 * a + 3]); G[1][a] = (k1[4 * a] + k1[4 * a + 1]) + (k1[4 * a + 2] + k1[4 * a + 3]); }
#pragma unroll
        for (int P = 0; P < 2; ++P)
#pragma unroll
            for (int a = 0; a < 4; ++a) Go[P][a] = other_x32(G[P][a], hi);
        float total = carry;
#pragma unroll
        for (int P = 1; P >= 0; --P)
#pragma unroll
            for (int a = 3; a >= 0; --a) total += G[P][a] + Go[P][a];
        const bool cont = (t > 0) && !__all(total < -150.0f);
        if (cont) A_ISSUE_K(t - 1);
        float accs = carry;
#pragma unroll
        for (int P = 1; P >= 0; --P)
#pragma unroll
            for (int a = 3; a >= 0; --a) {
                f32x16& kk_ = P ? k1 : k0; f32x16& pp = P ? p1 : p0;
                float bt = accs + (hi == 0 ? Go[P][a] : 0.f);
#pragma unroll
                for (int i = 3; i >= 0; --i) { const int r = 4 * a + i; const float lk = kk_[r]; pp[r] = __builtin_amdgcn_exp2f(pp[r] + lk + bt); bt += lk; }
                accs += G[P][a] + Go[P][a];
            }
        carry = accs;
        if (diag) {
#pragma unroll
            for (int r = 0; r < 16; ++r) { const int key = 64 * t + crow(r, hi); if (key >= qpos) p0[r] = 0.f; if (key + 32 >= qpos) p1[r] = 0.f; }
        }
        bf16x8 pa[4]; pack_p(pa, p0, p1);
        if (cont) asm volatile("s_waitcnt vmcnt(8)" ::: "memory"); else asm volatile("s_waitcnt vmcnt(0)" ::: "memory");
        pv_tile<2>(o, wl + 8192, pa, lane, hi);
        asm volatile("s_waitcnt lgkmcnt(0)" ::: "memory");
        if (!cont) break;
        A_ISSUE_V(t - 1);
    }
#undef A_ISSUE_K
#undef A_ISSUE_V
    bf16_t* op = merged + (tokbase + q0w + r32) * DM + h * 64 + 4 * hi;
#pragma unroll
    for (int d0 = 0; d0 < 2; ++d0)
#pragma unroll
        for (int a = 0; a < 4; ++a) { u32x2 w; w.x = pk2(o[d0][4 * a], o[d0][4 * a + 1]); w.y = pk2(o[d0][4 * a + 2], o[d0][4 * a + 3]); *(u32x2*)(op + 32 * d0 + 8 * a) = w; }
}

struct Args { const float* in[18]; float* out; unsigned char* ws; int ph_lo, ph_hi; };
enum { I_X = 0, I_T5, I_ANORM, I_WIN, I_DQN, I_DLAM, I_DSUB, I_CQN, I_CRB, I_WOUT, I_FNORM, I_RGW, I_RGB, I_REW, I_REB, I_WG, I_WU, I_WD };

__device__ __forceinline__ int rowmap(int kind, int n) {
    if (kind == 1) return (n & ~255) + 128 * ((n & 63) >> 5) + 32 * ((n >> 6) & 3) + (n & 31);
    if (kind == 2) return 256 * (n >> 7) + (n & 127);
    if (kind == 3) return 256 * (n >> 7) + 128 + (n & 127);
    return n;
}
__device__ __forceinline__ void transpose_item(const float* W, int K, int N, const float* gain, bf16_t* WT, int kind, LAS unsigned char* scr, int item, int lane) {
    const int nblk = N / 64, kb = item / nblk, nb = item % nblk, k0 = 64 * kb, n0 = 64 * nb;
    const float* src = W + (size_t)k0 * N + n0 + lane;
    float v[64];
#pragma unroll
    for (int k = 0; k < 64; ++k) v[k] = src[(size_t)k * N];
    if (gain) {
#pragma unroll
        for (int k = 0; k < 64; ++k) v[k] *= gain[k0 + k];
    }
#pragma unroll
    for (int j = 0; j < 8; ++j) { u32x4 o; o.x = pk2(v[8 * j], v[8 * j + 1]); o.y = pk2(v[8 * j + 2], v[8 * j + 3]); o.z = pk2(v[8 * j + 4], v[8 * j + 5]); o.w = pk2(v[8 * j + 6], v[8 * j + 7]);
        *(LAS u32x4*)(scr + lane * 144 + 16 * j) = o; }
    LDS_WAIT();
#pragma unroll
    for (int i = 0; i < 8; ++i) { const int n = 8 * i + (lane >> 3); const u32x4 o = *(const LAS u32x4*)(scr + n * 144 + 16 * (lane & 7));
        *(u32x4*)(WT + (size_t)rowmap(kind, n0 + n) * K + k0 + 8 * (lane & 7)) = o; }
    LDS_WAIT();
}

__global__ void __launch_bounds__(NWAVES * 64, 2) fwd_kernel(Args args) {
    extern __shared__ __attribute__((aligned(16))) unsigned char lds_raw[];
    LAS unsigned char* lds = (LAS unsigned char*)lds_raw;
    volatile LAS unsigned* MISC = (volatile LAS unsigned*)(lds + MISC_OFF);
    const int G = gridDim.x, bx = blockIdx.x;
    const int vcu = (G % 8 == 0) ? (bx % 8) * (G / 8) + bx / 8 : bx;
    unsigned char* ws0 = args.ws;
    gu32* ctl = (gu32*)(ws0 + WS_CTL);
#define PHASE_LOCALS() \
    unsigned long long zero_ = 0ull; asm volatile("" : "+s"(zero_)); unsigned char* ws = ws0 + zero_; \
    int tid = tid_of(wv0); asm volatile("" : "+v"(tid)); \
    const int lane = tid & 63, wave = __builtin_amdgcn_readfirstlane(tid >> 6); \
    const int gw = vcu * NWAVES + wave, NGW = G * NWAVES; \
    float* out = args.out; \
    bf16_t* hb = (bf16_t*)(ws + WS_HB); bf16_t* proj = (bf16_t*)(ws + WS_PROJ); bf16_t* merged = (bf16_t*)(ws + WS_MERGED); \
    bf16_t* hid = (bf16_t*)(ws + WS_HID); bf16_t* ybuf = (bf16_t*)(ws + WS_YBUF); float* rrow = (float*)(ws + WS_RROW); \
    unsigned* slot_of = (unsigned*)(ws + WS_SLOT); int* tok_list = (int*)(ws + WS_TOK); float* gate_list = (float*)(ws + WS_GATE); float* rs_list = (float*)(ws + WS_RS); \
    (void)lane; (void)wave; (void)gw; (void)NGW; (void)out; (void)hb; (void)proj; (void)merged; (void)hid; (void)ybuf; (void)rrow; (void)slot_of; (void)tok_list; (void)gate_list; (void)rs_list;

    const int wv0 = __builtin_amdgcn_readfirstlane((int)threadIdx.x >> 6);
    if (wv0 == 0) MISC[tid_of(0)] = 0u;
    __syncthreads();
#if MK_N_LAUNCHES == 1
    XcdBarrier bar = xcd_barrier_post((unsigned*)(ctl + CW_BAR), MISC + 40, wv0);
#define GRID_BAR() xcd_barrier(bar)
#else
#define GRID_BAR() do {} while (0)
#endif
    const int lo = args.ph_lo, hi_ph = args.ph_hi;
#ifndef PH_MASK
#define PH_MASK 0xff
#endif
#define IN(k) (lo <= (k) && (k) < hi_ph && ((PH_MASK >> ((k) == 0 ? 0 : (((k) - 1) % 7) + 1)) & 1))
#define BOTH(k) (IN(k) && IN((k) + 1))
#ifndef DUP_MASK
#define DUP_MASK 0
#endif
#define REPS(kind) (((DUP_MASK >> (kind)) & 1) ? 2 : 1)

    if (IN(0)) for (int rep_ = 0; rep_ < REPS(0); ++rep_) {
        PHASE_LOCALS();
        LAS unsigned char* scr = lds + wave * 9216;
        constexpr int I_IN = 16 * 48, I_OUT = 16 * 16, I_E = 128;
        constexpr int N_A = DEPTH * I_IN, N_B = DEPTH * I_OUT, N_C = DEPTH * NEXP * I_E;
        constexpr int NITEMS = N_A + N_B + 3 * N_C;
        for (int it = gw; it < NITEMS; it += NGW) {
            int r = it;
            if (r < N_A) { const int l = r / I_IN; transpose_item(args.in[I_WIN] + (size_t)l * DM * QKVW, DM, QKVW, args.in[I_ANORM] + l * DM, (bf16_t*)(ws + WS_WIN) + (size_t)l * QKVW * DM, 1, scr, r % I_IN, lane); continue; } r -= N_A;
            if (r < N_B) { const int l = r / I_OUT; transpose_item(args.in[I_WOUT] + (size_t)l * DM * DM, DM, DM, nullptr, (bf16_t*)(ws + WS_WOUT) + (size_t)l * DM * DM, 0, scr, r % I_OUT, lane); continue; } r -= N_B;
            const int which = r / N_C, r2 = r % N_C, le = r2 / I_E, item = r2 % I_E, l = le / NEXP;
            if (which == 0) transpose_item(args.in[I_WG] + (size_t)le * DM * DEXP, DM, DEXP, args.in[I_FNORM] + l * DM, (bf16_t*)(ws + WS_WGU) + (size_t)le * 1024 * DM, 2, scr, item, lane);
            else if (which == 1) transpose_item(args.in[I_WU] + (size_t)le * DM * DEXP, DM, DEXP, args.in[I_FNORM] + l * DM, (bf16_t*)(ws + WS_WGU) + (size_t)le * 1024 * DM, 3, scr, item, lane);
            else transpose_item(args.in[I_WD] + (size_t)le * DEXP * DM, DEXP, DM, nullptr, (bf16_t*)(ws + WS_WD) + (size_t)le * DM * DEXP, 0, scr, item, lane);
        }
        for (int i = (vcu * NWAVES * 64 + tid); i < DEPTH * 48 * 1024; i += G * NWAVES * 64) {
            const int l = i / (48 * 1024), n = (i / 1024) % 48, k = i % 1024;
            float w = 0.f;
            if (n < 4) w = args.in[I_RGW][((size_t)l * DM + k) * 4 + n]; else if (n < 36) w = args.in[I_REW][((size_t)l * DM + k) * 32 + (n - 4)];
            w *= args.in[I_FNORM][l * DM + k];
            const unsigned hb_ = f2bf(w); const float wl = w - __builtin_bit_cast(float, hb_ << 16);
            ((bf16_t*)(ws + WS_WRH))[i] = (bf16_t)hb_; ((bf16_t*)(ws + WS_WRL))[i] = (bf16_t)f2bf(wl);
        }
        const float* x = args.in[I_X];
        for (int row = gw; row < NTOK; row += NGW) {
            const f32x4* xr = (const f32x4*)(x + (size_t)row * DM) + lane; float ss = 0.f; u32x2* o8 = (u32x2*)(hb + (size_t)row * DM) + lane;
#pragma unroll
            for (int j = 0; j < 4; ++j) { const f32x4 v = xr[64 * j]; ss += (v[0] * v[0] + v[1] * v[1]) + (v[2] * v[2] + v[3] * v[3]); u32x2 w; w.x = pk2(v[0], v[1]); w.y = pk2(v[2], v[3]); o8[64 * j] = w; }
            ss = wave_sum(ss);
            if (lane == 0) rrow[row] = __builtin_amdgcn_rsqf(ss * (1.0f / DM) + EPS);
        }
        if (rep_ == REPS(0) - 1) { if (BOTH(0)) GRID_BAR(); } else __syncthreads();
    }

    for (int l = 0; l < DEPTH; ++l) {
        const int pb = 1 + 7 * l;
        const float lam_init = __builtin_bit_cast(float, __builtin_amdgcn_readfirstlane(l == 0 ? 0x3e4ccccd : 0x3eb60549));
        const float one_m_lam = __builtin_bit_cast(float, __builtin_amdgcn_readfirstlane(l == 0 ? 0x3f4ccccd : 0x3f24fd5c));
        const unsigned* cntl = (const unsigned*)(ctl + CW_CNT) + l * 32 * 64;
        if (IN(pb + 0)) for (int rep_ = 0; rep_ < ((1 == 3 && l != 0) ? 1 : REPS(1)); ++rep_) {
            PHASE_LOCALS();
            pg8::DenseSched S; S.init(NTOK, QKVW, DM, (const bf16_t*)(ws + WS_WIN) + (size_t)l * QKVW * DM, G, bx);
            pg8::EpiWin E{proj, rrow, args.in[I_DQN] + l * 128, args.in[I_CQN] + l * 128};
            pg8::gemm_phase<pg8::EpiWin, pg8::DenseSched>(lds, hb, DM, S, E, wv0);
            if (rep_ == ((1 == 3 && l != 0) ? 1 : REPS(1)) - 1) { if (BOTH(pb + 0)) GRID_BAR(); } else __syncthreads();
        }
        if (IN(pb + 1)) for (int rep_ = 0; rep_ < ((2 == 3 && l != 0) ? 1 : REPS(2)); ++rep_) {
            PHASE_LOCALS();
#if (DUP_MASK >> 11) & 1
            for (int P = vcu; P < 512; P += G) {
                const int bh = P >> 4, s = P & 15;
                attnB_unit<true>(lds, proj, merged, args.in[I_T5], args.in[I_DLAM] + l * 256, args.in[I_DSUB] + l * 128, lam_init, one_m_lam, bh >> 2, bh & 3, 31 - s, wv0);
                attnB_unit<true>(lds, proj, merged, args.in[I_T5], args.in[I_DLAM] + l * 256, args.in[I_DSUB] + l * 128, lam_init, one_m_lam, bh >> 2, bh & 3, s, wv0);
            }
#endif
            for (int rb_ = 0; rb_ < REPS(8); ++rb_)
            for (int P = vcu; P < 512; P += G) {
                const int bh = P >> 4, s = P & 15;
                attnB_unit<false>(lds, proj, merged, args.in[I_T5], args.in[I_DLAM] + l * 256, args.in[I_DSUB] + l * 128, lam_init, one_m_lam, bh >> 2, bh & 3, 31 - s, wv0);
                attnB_unit<false>(lds, proj, merged, args.in[I_T5], args.in[I_DLAM] + l * 256, args.in[I_DSUB] + l * 128, lam_init, one_m_lam, bh >> 2, bh & 3, s, wv0);
            }
            for (int rc_ = 0; rc_ < REPS(9); ++rc_)
            for (int U = vcu; U < 512; U += G) { const int bh = U >> 4; attnC_unit(lds, proj, merged, args.in[I_CRB] + l * 257 * 4, bh >> 2, bh & 3, U & 15, wv0); __syncthreads(); }
            for (int ra_ = 0; ra_ < REPS(10); ++ra_)
            for (int U = vcu; U < 512; U += G) { const int bh = U >> 4; attnA_unit(lds, proj, merged, bh >> 2, bh & 3, U & 15, wv0); }
            __syncthreads();
            if (rep_ == ((2 == 3 && l != 0) ? 1 : REPS(2)) - 1) { if (BOTH(pb + 1)) GRID_BAR(); } else __syncthreads();
        }
        if (IN(pb + 2)) for (int rep_ = 0; rep_ < ((3 == 3 && l != 0) ? 1 : REPS(3)); ++rep_) {
            PHASE_LOCALS();
            pg8::DenseSched S; S.init(NTOK, DM, DM, (const bf16_t*)(ws + WS_WOUT) + (size_t)l * DM * DM, G, bx);
            pg8::EpiWout E{hb};
            pg8::gemm_phase<pg8::EpiWout, pg8::DenseSched>(lds, merged, DM, S, E, wv0);
            if (rep_ == ((3 == 3 && l != 0) ? 1 : REPS(3)) - 1) { if (BOTH(pb + 2)) GRID_BAR(); } else __syncthreads();
        }
        if (IN(pb + 3)) {
            PHASE_LOCALS();
            LAS float* lg = (LAS float*)lds;
            LAS float* rrl = (LAS float*)(lds + 128 * 49 * 4);
            LAS int* hist = (LAS int*)(lds + 128 * 49 * 4 + 512);
            const bf16_t* wrh = (const bf16_t*)(ws + WS_WRH) + (size_t)l * 48 * 1024;
            const bf16_t* wrl = (const bf16_t*)(ws + WS_WRL) + (size_t)l * 48 * 1024;
            const float* rgb = args.in[I_RGB] + l * 4; const float* reb = args.in[I_REB] + l * 32;
            const int fr = lane & 15, fq = lane >> 4;
            for (int chunk = vcu; chunk < NTOK / 128; chunk += G) {
                if (tid < 32) hist[tid] = 0;
                const int row = chunk * 128 + wave * 16 + fr;
                const bf16_t* hp = hb + (size_t)row * DM + 8 * fq;
                f32x4 acc[3]; acc[0] = acc[1] = acc[2] = (f32x4){0.f, 0.f, 0.f, 0.f};
                float ss = 0.f;
#pragma unroll 4
                for (int k0 = 0; k0 < DM; k0 += 32) {
                    const u32x4 ah = *(const u32x4*)(hp + k0);
                    { const float x0 = bflo(ah.x), x1 = bfhi(ah.x), x2 = bflo(ah.y), x3 = bfhi(ah.y), x4 = bflo(ah.z), x5 = bfhi(ah.z), x6 = bflo(ah.w), x7 = bfhi(ah.w);
                      ss += (x0 * x0 + x1 * x1) + (x2 * x2 + x3 * x3) + (x4 * x4 + x5 * x5) + (x6 * x6 + x7 * x7); }
                    const bf16x8 aH = __builtin_bit_cast(bf16x8, ah);
#pragma unroll
                    for (int cbk = 0; cbk < 3; ++cbk) {
                        const bf16x8 bH = *(const bf16x8*)(wrh + (size_t)(cbk * 16 + fr) * DM + k0 + 8 * fq), bL = *(const bf16x8*)(wrl + (size_t)(cbk * 16 + fr) * DM + k0 + 8 * fq);
                        acc[cbk] = __builtin_amdgcn_mfma_f32_16x16x32_bf16(aH, bH, acc[cbk], 0, 0, 0);
                        acc[cbk] = __builtin_amdgcn_mfma_f32_16x16x32_bf16(aH, bL, acc[cbk], 0, 0, 0);
                    }
                }
                ss += swz_xor<16>(ss); ss = sum_x32(ss);
                if (fq == 0) rrl[wave * 16 + fr] = __builtin_amdgcn_rsqf(ss * (1.0f / DM) + EPS);
#pragma unroll
                for (int cbk = 0; cbk < 3; ++cbk)
#pragma unroll
                    for (int rg = 0; rg < 4; ++rg) lg[(wave * 16 + 4 * fq + rg) * 49 + cbk * 16 + fr] = acc[cbk][rg];
                __syncthreads();
                int e1 = 0, e2 = 0, lr1 = 0, lr2 = 0; float g1 = 0.f, g2 = 0.f, rr = 0.f;
                if (tid < 128) {
                    rr = rrl[tid];
                    const LAS float* lp = lg + tid * 49;
                    float gl[4]; int gs = 0; float gmax = -3.0e38f;
#pragma unroll
                    for (int i = 0; i < 4; ++i) { gl[i] = lp[i] * rr + rgb[i]; if (gl[i] > gmax) { gmax = gl[i]; gs = i; } }
                    float den = 0.f;
#pragma unroll
                    for (int i = 0; i < 4; ++i) den += __expf(gl[i] - gmax);
                    const float gwt = 1.0f / den;
                    float el[8]; int i1 = 0; float m1 = -3.0e38f;
#pragma unroll
                    for (int i = 0; i < 8; ++i) { el[i] = lp[4 + gs * 8 + i] * rr + reb[gs * 8 + i]; if (el[i] > m1) { m1 = el[i]; i1 = i; } }
                    int i2 = 0; float m2 = -3.0e38f;
#pragma unroll
                    for (int i = 0; i < 8; ++i) { if (i != i1 && el[i] > m2) { m2 = el[i]; i2 = i; } }
                    const float ex = __expf(m2 - m1), p1 = 1.0f / (1.0f + ex), p2 = ex * p1;
                    g1 = gwt * p1; g2 = gwt * p2; e1 = gs * 8 + i1; e2 = gs * 8 + i2;
                    lr1 = __hip_atomic_fetch_add(&hist[e1], 1, __ATOMIC_RELAXED, __HIP_MEMORY_SCOPE_WORKGROUP); lr2 = __hip_atomic_fetch_add(&hist[e2], 1, __ATOMIC_RELAXED, __HIP_MEMORY_SCOPE_WORKGROUP);
                }
                __syncthreads();
                if (tid < 32) { const int c_ = hist[tid]; hist[32 + tid] = c_ ? (int)__hip_atomic_fetch_add((unsigned*)cntl + 64 * tid, (unsigned)c_, __ATOMIC_RELAXED, __HIP_MEMORY_SCOPE_AGENT) : 0; }
                __syncthreads();
                if (tid < 128) {
                    const int tok = chunk * 128 + tid;
                    const int pos1 = hist[32 + e1] + lr1, pos2 = hist[32 + e2] + lr2;
                    tok_list[e1 * ECAP + pos1] = tok; gate_list[e1 * ECAP + pos1] = g1; rs_list[e1 * ECAP + pos1] = rr;
                    tok_list[e2 * ECAP + pos2] = tok; gate_list[e2 * ECAP + pos2] = g2; rs_list[e2 * ECAP + pos2] = rr;
                    slot_of[tok * 2] = ((unsigned)e1 << 16) | (unsigned)pos1; slot_of[tok * 2 + 1] = ((unsigned)e2 << 16) | (unsigned)pos2;
                }
                __syncthreads();
            }
            if (BOTH(pb + 3)) GRID_BAR();
        }
        if (IN(pb + 4) || IN(pb + 5) || IN(pb + 6)) {
            { const int t_ = tid_of(wv0);
              if (t_ < 32) MISC[704 + t_] = ld_agent(cntl + 64 * t_);
              __syncthreads();
              if (t_ == 0) { int s_ = 0;
                for (int e = 0; e < 32; ++e) { const int ce = (int)MISC[704 + e], nte = (ce + 255) >> 8; MISC[e] = (unsigned)s_;
                    for (int j = 0; j < nte; ++j) { MISC[64 + 2 * (s_ + j)] = ((unsigned)e << 24) | (unsigned)(j * 256); MISC[64 + 2 * (s_ + j) + 1] = (unsigned)ce; }
                    s_ += nte; }
                MISC[32] = (unsigned)s_; }
              __syncthreads(); }
        }
        if (IN(pb + 4)) for (int rep_ = 0; rep_ < ((5 == 3 && l != 0) ? 1 : REPS(5)); ++rep_) {
            PHASE_LOCALS();
            pg8::MoeSched<true> S{(const volatile LAS int*)MISC, cntl, tok_list, (const bf16_t*)(ws + WS_WGU) + (size_t)l * NEXP * 1024 * DM, DM, G, bx};
            pg8::EpiGU E{hid, rs_list};
            pg8::gemm_phase<pg8::EpiGU, pg8::MoeSched<true>>(lds, hb, DM, S, E, wv0);
            if (rep_ == ((5 == 3 && l != 0) ? 1 : REPS(5)) - 1) { if (BOTH(pb + 4)) GRID_BAR(); } else __syncthreads();
        }
        if (IN(pb + 5)) for (int rep_ = 0; rep_ < ((6 == 3 && l != 0) ? 1 : REPS(6)); ++rep_) {
            PHASE_LOCALS();
            pg8::MoeSched<false> S{(const volatile LAS int*)MISC, cntl, tok_list, (const bf16_t*)(ws + WS_WD) + (size_t)l * NEXP * DM * DEXP, DEXP, G, bx};
            pg8::EpiDown E{ybuf, gate_list};
            pg8::gemm_phase<pg8::EpiDown, pg8::MoeSched<false>>(lds, hid, DEXP, S, E, wv0);
            if (rep_ == ((6 == 3 && l != 0) ? 1 : REPS(6)) - 1) { if (BOTH(pb + 5)) GRID_BAR(); } else __syncthreads();
        }
        if (IN(pb + 6)) {
            PHASE_LOCALS();
            for (int row = gw; row < NTOK; row += NGW) {
                const unsigned s0 = ld_agent(slot_of + row * 2), s1 = ld_agent(slot_of + row * 2 + 1);
                const size_t y0 = (size_t)(MISC[s0 >> 16] * 256u + (s0 & 0xffffu)), y1 = (size_t)(MISC[s1 >> 16] * 256u + (s1 & 0xffffu));
                const u32x2* ya = (const u32x2*)(ybuf + y0 * DM) + lane; const u32x2* yb = (const u32x2*)(ybuf + y1 * DM) + lane;
                u32x2* o8 = (u32x2*)(hb + (size_t)row * DM) + lane;
                f32x4* of = (f32x4*)(out + (size_t)row * DM) + lane;
                float ss = 0.f;
#pragma unroll
                for (int j = 0; j < 4; ++j) { const u32x2 hv = o8[64 * j], a = ya[64 * j], b2 = yb[64 * j]; f32x4 v;
                    v[0] = bflo(hv.x) + (bflo(a.x) + bflo(b2.x)); v[1] = bfhi(hv.x) + (bfhi(a.x) + bfhi(b2.x)); v[2] = bflo(hv.y) + (bflo(a.y) + bflo(b2.y)); v[3] = bfhi(hv.y) + (bfhi(a.y) + bfhi(b2.y));
                    if (l == DEPTH - 1) of[64 * j] = v;
                    else { ss += (v[0] * v[0] + v[1] * v[1]) + (v[2] * v[2] + v[3] * v[3]); u32x2 w; w.x = pk2(v[0], v[1]); w.y = pk2(v[2], v[3]); o8[64 * j] = w; } }
                if (l != DEPTH - 1) { ss = wave_sum(ss); if (lane == 0) rrow[row] = __builtin_amdgcn_rsqf(ss * (1.0f / DM) + EPS); }
            }
            if (BOTH(pb + 6)) GRID_BAR();
        }
    }
#undef IN
#undef BOTH
}

extern "C" void kernel_launch(void* const* d_in, const int* in_sizes, int n_in, void* d_out, int out_size, void* d_ws, size_t ws_size, hipStream_t stream) {
    static int grid = 0;
    if (grid == 0) {
        if (n_in != 18 || out_size != NTOK * DM || ws_size < WS_END) { fprintf(stderr, "kernel_launch: unexpected shapes (n_in %d, out %d, ws %zu < %zu)\n", n_in, out_size, ws_size, (size_t)WS_END); grid = -1; return; }
        int dev = 0, cus = 0, per_cu = 0;
        if (hipGetDevice(&dev) != hipSuccess || hipDeviceGetAttribute(&cus, hipDeviceAttributeMultiprocessorCount, dev) != hipSuccess) { grid = -1; return; }
        if (hipFuncSetAttribute((const void*)fwd_kernel, hipFuncAttributeMaxDynamicSharedMemorySize, LDS_BYTES) != hipSuccess) { fprintf(stderr, "kernel_launch: hipFuncSetAttribute failed\n"); grid = -1; return; }
        if (hipOccupancyMaxActiveBlocksPerMultiprocessor(&per_cu, (const void*)fwd_kernel, NWAVES * 64, LDS_BYTES) != hipSuccess || per_cu < 1) fprintf(stderr, "kernel_launch: occupancy query says %d\n", per_cu);
        (void)hipGetLastError();
        grid = cus;
    }
    if (grid < 0) return;
    if (hipMemsetAsync((char*)d_ws + WS_CTL, 0, CTL_ZERO_BYTES, stream) != hipSuccess) return;
    Args a{};
    for (int i = 0; i < 18; ++i) a.in[i] = (const float*)d_in[i];
    a.out = (float*)d_out; a.ws = (unsigned char*)d_ws;
#if MK_N_LAUNCHES == 1
    a.ph_lo = 0; a.ph_hi = NPHASES;
    hipLaunchKernelGGL(fwd_kernel, dim3(grid), dim3(NWAVES * 64), LDS_BYTES, stream, a);
#else
    for (int p = 0; p < NPHASES; ++p) { a.ph_lo = p; a.ph_hi = p + 1; hipLaunchKernelGGL(fwd_kernel, dim3(grid), dim3(NWAVES * 64), LDS_BYTES, stream, a); }
#endif
}
```

```cpp
#include <hip/hip_runtime.h>
#include <cstdio>
#include <cstdint>

#ifndef MK_N_LAUNCHES
#define MK_N_LAUNCHES 1
#endif

#define LAS __attribute__((address_space(3)))
#define GAS __attribute__((address_space(1)))
typedef unsigned short bf16_t;
typedef short bf16x8 __attribute__((ext_vector_type(8)));
typedef short v4i16 __attribute__((ext_vector_type(4)));
typedef float f32x4 __attribute__((ext_vector_type(4)));
typedef float f32x16 __attribute__((ext_vector_type(16)));
typedef unsigned u32x4 __attribute__((ext_vector_type(4)));
typedef unsigned u32x2 __attribute__((ext_vector_type(2)));
typedef float f32x2_t __attribute__((ext_vector_type(2)));
typedef __bf16 bf16x2_t __attribute__((ext_vector_type(2)));
typedef GAS unsigned gu32;

constexpr int DM = 1024, BATCH = 8, SEQ = 4096, NTOK = BATCH * SEQ, DEPTH = 2;
constexpr int QKVW = 3072, NEXP = 32, DEXP = 512, ECAP = 32768;
constexpr int MAXROWS = 73728;
constexpr float EPS = 1e-6f;
constexpr float LOG2E = 1.4426950408889634f;
constexpr float QSCALE = 0.125f * LOG2E;
constexpr int NWAVES = 8;
constexpr int NPHASES = 1 + 7 * DEPTH;

constexpr size_t MiB = 1u << 20;
constexpr size_t WS_CTL = 0, CTL_ZERO_BYTES = 1 * MiB;
constexpr size_t WS_WIN = 1 * MiB;
constexpr size_t WS_WOUT = 13 * MiB;
constexpr size_t WS_WGU = 17 * MiB;
constexpr size_t WS_WD = 145 * MiB;
constexpr size_t WS_WRH = 209 * MiB;
constexpr size_t WS_WRL = WS_WRH + 256 * 1024;
constexpr size_t WS_RROW = 210 * MiB;
constexpr size_t WS_SLOT = WS_RROW + 256 * 1024;
constexpr size_t WS_TOK = 211 * MiB;
constexpr size_t WS_GATE = 215 * MiB;
constexpr size_t WS_RS = 219 * MiB;
constexpr size_t WS_HB = 223 * MiB;
constexpr size_t WS_R = 287 * MiB;
constexpr size_t WS_PROJ = WS_R, WS_MERGED = WS_R + 192 * MiB;
constexpr size_t WS_HID = WS_R;
constexpr size_t WS_YBUF = WS_R + 72 * MiB;
constexpr size_t WS_END = 543 * MiB;
constexpr int CW_BAR = 4096;
constexpr int CW_CNT = 16384;

constexpr int RING_BYTES = 131072;
constexpr int MISC_OFF = RING_BYTES;
constexpr int TB_OFF = RING_BYTES + 4096;
constexpr int LDS_BYTES = 147456;

__device__ __forceinline__ unsigned f2bf(float f) { unsigned u = __builtin_bit_cast(unsigned, f); return (u + 0x7fffu + ((u >> 16) & 1u)) >> 16; }
__device__ __forceinline__ unsigned pk2(float lo, float hi) { f32x2_t v = {lo, hi}; bf16x2_t b = __builtin_convertvector(v, bf16x2_t); return __builtin_bit_cast(unsigned, b); }
__device__ __forceinline__ float bflo(unsigned w) { return __builtin_bit_cast(float, w << 16); }
__device__ __forceinline__ float bfhi(unsigned w) { return __builtin_bit_cast(float, w & 0xffff0000u); }
__device__ __forceinline__ unsigned ld_agent(const unsigned* p) { return __hip_atomic_load(p, __ATOMIC_RELAXED, __HIP_MEMORY_SCOPE_AGENT); }
#define LDS_WAIT() asm volatile("s_waitcnt lgkmcnt(0)" ::: "memory")
__device__ __forceinline__ int tid_of(int wv) { int ln; asm volatile("v_mbcnt_lo_u32_b32 %0, -1, 0\n\tv_mbcnt_hi_u32_b32 %0, -1, %0" : "=v"(ln)); return wv * 64 + ln; }

template <int M> __device__ __forceinline__ float swz_xor(float v) { return __builtin_bit_cast(float, __builtin_amdgcn_ds_swizzle(__builtin_bit_cast(int, v), (M << 10) | 0x1f)); }
__device__ __forceinline__ void pl32_swap(unsigned& a, unsigned& b) { asm("s_nop 1\n\tv_permlane32_swap_b32 %0, %1" : "+v"(a), "+v"(b)); }
__device__ __forceinline__ float sum_x32(float v) { unsigned a = __builtin_bit_cast(unsigned, v), b = a; pl32_swap(a, b); return __builtin_bit_cast(float, a) + __builtin_bit_cast(float, b); }
__device__ __forceinline__ float max_x32(float v) { unsigned a = __builtin_bit_cast(unsigned, v), b = a; pl32_swap(a, b); return __builtin_fmaxf(__builtin_bit_cast(float, a), __builtin_bit_cast(float, b)); }
__device__ __forceinline__ float other_x32(float v, int hi) { unsigned a = __builtin_bit_cast(unsigned, v), b = a; pl32_swap(a, b); return __builtin_bit_cast(float, hi ? a : b); }
__device__ __forceinline__ float wave_sum(float v) { v += swz_xor<1>(v); v += swz_xor<2>(v); v += swz_xor<4>(v); v += swz_xor<8>(v); v += swz_xor<16>(v); return sum_x32(v); }

#define XB_TMO      128
#define XB_XCNT(j)  (256  + 64 * (j))
#define XB_XSUB(j)  (1280 + 64 * (j))
#define XB_XGEN(j)  (2304 + 64 * (j))
#define XB_TOP      3328
#define XB_TOPGEN   3392
#define XCD_BAR_WORDS 3456
#define XB_SPIN_CAP (1u << 18)
__device__ __forceinline__ unsigned xb_ld(unsigned* p)              { return __hip_atomic_load(p, __ATOMIC_RELAXED, __HIP_MEMORY_SCOPE_AGENT); }
__device__ __forceinline__ unsigned xb_add(unsigned* p, unsigned v) { return __hip_atomic_fetch_add(p, v, __ATOMIC_RELAXED, __HIP_MEMORY_SCOPE_AGENT); }
__device__ __forceinline__ unsigned xb_xcc_id() { return (unsigned)__builtin_amdgcn_s_getreg((3 << 11) | 20) & 0xFu; }
#define XB_SPIN(cond, bar) do { unsigned _sp = 0; while (cond) { __builtin_amdgcn_s_sleep(1); \
    if ((++_sp & 255u) == 0u) { if (xb_ld(&(bar)[XB_TMO])) break; if (_sp > XB_SPIN_CAP) { atomicAdd(&(bar)[XB_TMO], 1u); break; } } } } while (0)
struct XcdBarrier { unsigned* bar; unsigned x; volatile LAS unsigned* st; int wv; };
__device__ __forceinline__ XcdBarrier xcd_barrier_post(unsigned* bar, volatile LAS unsigned* st, int wv) {
    XcdBarrier b; b.bar = bar; b.x = xb_xcc_id(); b.st = st; b.wv = wv;
    if (tid_of(wv) == 0) (void)xb_add(&bar[XB_XCNT(b.x)], 1u);
    return b;
}
__device__ __forceinline__ void xcd_barrier_complete(unsigned* bar, unsigned x, unsigned& nloc, unsigned& nx) {
    const unsigned G = gridDim.x * gridDim.y * gridDim.z;
    unsigned sum, cnt, mine, sp = 0u;
    for (;;) {
        sum = 0u; cnt = 0u; mine = 0u;
#pragma unroll
        for (unsigned j = 0; j < 16; ++j) { const unsigned c = xb_ld(&bar[XB_XCNT(j)]); sum += c; cnt += (c > 0u) ? 1u : 0u; mine = (j == x) ? c : mine; }
        if (sum == G) break;
        __builtin_amdgcn_s_sleep(1);
        if ((++sp & 255u) == 0u) { if (xb_ld(&bar[XB_TMO])) break; if (sp > XB_SPIN_CAP) { atomicAdd(&bar[XB_TMO], 1u); break; } }
    }
    nloc = mine > 0u ? mine : 1u; nx = cnt > 0u ? cnt : 1u;
}
__device__ __forceinline__ void xcd_barrier(const XcdBarrier& b) {
    asm volatile("s_waitcnt vmcnt(0)" ::: "memory");
    __syncthreads();
    if (tid_of(b.wv) == 0) {
        unsigned* bar = b.bar;
        __builtin_amdgcn_s_waitcnt(0);
        unsigned nloc = b.st[0], nx = b.st[1];
        if (nloc == 0u) { xcd_barrier_complete(bar, b.x, nloc, nx); b.st[0] = nloc; b.st[1] = nx; }
        const unsigned old = xb_add(&bar[XB_XSUB(b.x)], 1u);
        const unsigned gen = old / nloc;
        if (old + 1u == (gen + 1u) * nloc) {
            __builtin_amdgcn_fence(__ATOMIC_RELEASE, "agent");
            asm volatile("s_waitcnt vmcnt(0)" ::: "memory");
            const unsigned og = xb_add(&bar[XB_TOP], 1u);
            const unsigned tg = og / nx;
            if (og + 1u == (tg + 1u) * nx) xb_add(&bar[XB_TOPGEN], 1u);
            else XB_SPIN(xb_ld(&bar[XB_TOPGEN]) == tg, bar);
            __builtin_amdgcn_fence(__ATOMIC_ACQUIRE, "agent");
            xb_add(&bar[XB_XGEN(b.x)], 1u);
            asm volatile("s_waitcnt vmcnt(0)" ::: "memory");
        } else {
            XB_SPIN(xb_ld(&bar[XB_XGEN(b.x)]) == gen, bar);
            __builtin_amdgcn_fence(__ATOMIC_ACQUIRE, "agent");
            asm volatile("s_waitcnt vmcnt(0)" ::: "memory");
        }
    }
    __syncthreads();
}

namespace pg8 {
constexpr int BM = 256, BK = 64, HALF = 128, HTB = HALF * BK * 2, STAGE_BYTES = 8 * HTB, NXCD = 8, WGM = 8;
__device__ __forceinline__ int lds_byte(int r, int c) { const int st = (r >> 4) * 2 + (c >> 5), rr = r & 15, cc = c & 31, ob = rr * 64 + cc * 2; return st * 1024 + (ob ^ (((ob >> 9) & 1) << 5)); }
__device__ __forceinline__ void stage_rc(int b, int& R, int& C) { const int st = b / 1024, sb = b % 1024, swz = sb ^ (((sb >> 9) & 1) << 5); R = (st >> 1) * 16 + swz / 64; C = (st & 1) * 32 + (swz % 64) / 2; }
__device__ __forceinline__ int perm32(int rho) { const int n = rho >> 4, i = rho & 15; return 8 * (i >> 2) + 4 * n + (i & 3); }

struct Unit { int pm, pn, e, t0, cnt; };

struct DenseSched {
    static constexpr bool GATHER = false;
    int nM, nN, nwg, G, c, K; const bf16_t* Bt;
    __device__ void init(int M, int N, int K_, const bf16_t* Bt_, int G_, int c_) { nM = M / BM; nN = N / BM; nwg = nM * nN; G = G_; c = c_; K = K_; Bt = Bt_; }
    __device__ __forceinline__ bool next(int i, Unit& u) const {
        const long L = (long)i * G + c; if (L >= nwg) return false;
        int wgid = (int)L; { const int q = nwg / NXCD, r = nwg % NXCD, xcd = wgid % NXCD, off = wgid / NXCD; wgid = (xcd < r ? xcd * (q + 1) : r * (q + 1) + (xcd - r) * q) + off; }
        const int nig = WGM * nN, gid = wgid / nig, fm = gid * WGM, gsz = (nM - fm) < WGM ? (nM - fm) : WGM;
        u.pm = fm + ((wgid % nig) % gsz); u.pn = (wgid % nig) / gsz; u.e = 0; u.t0 = 0; u.cnt = 0; return true;
    }
    __device__ __forceinline__ int arow(const Unit& u, int r) const { return u.pm * BM + r; }
    __device__ __forceinline__ const bf16_t* bptr(const Unit& u) const { return Bt + (size_t)u.pn * BM * K; }
};
template <bool GATHER_> struct MoeSched {
    static constexpr bool GATHER = GATHER_;
    const volatile LAS int* pre; const unsigned* cnt; const int* tok; const bf16_t* W; int K, G, c;
    __device__ __forceinline__ bool next(int i, Unit& u) const {
        const int L = i * G + c, T = L >> 2; const int ntile = __builtin_amdgcn_readfirstlane(pre[32]);
        if (T >= ntile) return false;
        const volatile LAS int* tt = pre + 64 + 2 * T;
        const int w0 = __builtin_amdgcn_readfirstlane(tt[0]), w1 = __builtin_amdgcn_readfirstlane(tt[1]);
        u.e = (int)((unsigned)w0 >> 24); u.pm = T; u.pn = L & 3; u.t0 = w0 & 0xffffff; u.cnt = w1; return true;
    }
    __device__ __forceinline__ int arow(const Unit& u, int r) const {
        if (GATHER_) { const int pos = u.t0 + r; return pos < u.cnt ? tok[u.e * ECAP + pos] : 0; }
        return u.pm * BM + r;
    }
    __device__ __forceinline__ const bf16_t* bptr(const Unit& u) const { return W + ((size_t)u.e * 1024 + (size_t)u.pn * BM) * K; }
};

template <class Epi, class Sched>
__device__ __forceinline__ void gemm_phase(LAS unsigned char* lds, const bf16_t* Abase_, int K, const Sched& S, const Epi& E, int wv) {
    int tid = tid_of(wv); asm volatile("" : "+v"(tid));
    const int wid = __builtin_amdgcn_readfirstlane(tid >> 6), lane = tid & 63, wr = wid >> 2, wc = wid & 3, fr = lane & 15, fq = lane >> 4;
    constexpr bool GATHER = Sched::GATHER;
    const int nt = K / BK;
    int Rs[2], Cs[2]; unsigned voffA[2], voffB[2];
#pragma unroll
    for (int i = 0; i < 2; ++i) { int R, C; stage_rc(tid * 16 + i * 8192, R, C); Rs[i] = R; Cs[i] = C; const int Rb = Epi::PERM ? ((R & ~31) + perm32(R & 31)) : R;
        voffA[i] = (unsigned)(R * K + C) * 2u; voffB[i] = (unsigned)(Rb * K + C) * 2u; }
    const size_t kstep = (size_t)(BK * 2);
    const size_t hstep = (size_t)HALF * K * 2;
    const unsigned ldsw = (unsigned)wid * 1024u;
    const char* Abase = (const char*)Abase_;
    const int aoff = lds_byte(wr * 64 + fr, fq * 8), boff = lds_byte(wc * 32 + fr, fq * 8);
#define PG8_SA(b, h) (((b) * 2 + (h)) * HTB)
#define PG8_SB(b, h) ((4 + (b) * 2 + (h)) * HTB)
#define PG8_STAGE(bufoff, gbase, v0, v1) do { \
        __builtin_amdgcn_global_load_lds((const unsigned*)((const char*)(gbase) + (v0)), (LAS unsigned*)(lds + (bufoff) + ldsw), 16, 0, 0); \
        __builtin_amdgcn_global_load_lds((const unsigned*)((const char*)(gbase) + (v1)), (LAS unsigned*)(lds + (bufoff) + ldsw + 8192), 16, 0, 0); } while (0)
#define PG8_STAGE_AC(bufoff, h, koff) do { if constexpr (GATHER) PG8_STAGE(bufoff, Abase + (koff), cA[h][0], cA[h][1]); else PG8_STAGE(bufoff, cAp + (h) * hstep + (koff), voffA[0], voffA[1]); } while (0)
#define PG8_STAGE_AX(bufoff, h, koff) do { if constexpr (GATHER) PG8_STAGE(bufoff, a2p + (koff), (h) ? x10 : x00, (h) ? x11 : x01); else PG8_STAGE(bufoff, a2p + (h) * hstep + (koff), voffA[0], voffA[1]); } while (0)
#define PG8_STAGE_B(bufoff, gbase) PG8_STAGE(bufoff, gbase, voffB[0], voffB[1])
#define PG8_LDA(dst, b, h) do { _Pragma("unroll") for (int m = 0; m < 4; ++m) _Pragma("unroll") for (int k = 0; k < 2; ++k) dst[m][k] = *(const LAS bf16x8*)(lds + PG8_SA(b, h) + aoff + m * 2048 + k * 1024); } while (0)
#define PG8_LDB(dst, b, h) do { _Pragma("unroll") for (int n = 0; n < 2; ++n) _Pragma("unroll") for (int k = 0; k < 2; ++k) dst[n][k] = *(const LAS bf16x8*)(lds + PG8_SB(b, h) + boff + n * 2048 + k * 1024); } while (0)
#define PG8_MMA(ai, bj, At, Bt) do { __builtin_amdgcn_s_setprio(1); _Pragma("unroll") for (int m = 0; m < 4; ++m) _Pragma("unroll") for (int n = 0; n < 2; ++n) _Pragma("unroll") for (int k = 0; k < 2; ++k) \
        acc[ai][bj][m][n] = __builtin_amdgcn_mfma_f32_16x16x32_bf16(Bt[n][k], At[m][k], acc[ai][bj][m][n], 0, 0, 0); __builtin_amdgcn_s_setprio(0); } while (0)
#define PG8_WAIT_V(n) asm volatile("s_waitcnt vmcnt(" #n ")" ::: "memory")
#define PG8_WAIT_L(n) asm volatile("s_waitcnt lgkmcnt(" #n ")" ::: "memory")
#define PG8_BAR __builtin_amdgcn_s_barrier()
#define PG8_SCHED __builtin_amdgcn_sched_barrier(0)
#define PG8_MKA(dst, u) do { _Pragma("unroll") for (int h_ = 0; h_ < 2; ++h_) _Pragma("unroll") for (int i_ = 0; i_ < 2; ++i_) dst[h_][i_] = ((unsigned)S.arow(u, h_ * HALF + Rs[i_]) * (unsigned)K + (unsigned)Cs[i_]) * 2u; } while (0)
    Unit cur, nxt; int ui = 0;
    if (!S.next(0, cur)) return;
    f32x4 acc[2][2][4][2];
#pragma unroll
    for (int a = 0; a < 2; ++a)
#pragma unroll
        for (int b = 0; b < 2; ++b)
#pragma unroll
            for (int m = 0; m < 4; ++m)
#pragma unroll
                for (int n = 0; n < 2; ++n) acc[a][b][m][n] = (f32x4){0.f, 0.f, 0.f, 0.f};
    bf16x8 At[4][2], B0[2][2], B1[2][2];
    unsigned cA[2][2] = {{0u, 0u}, {0u, 0u}}, nA[2][2] = {{0u, 0u}, {0u, 0u}};
    const char* cAp = Abase; const char* nAp = Abase;
    if constexpr (GATHER) { PG8_MKA(cA, cur); } else { cAp = Abase + (size_t)S.arow(cur, 0) * K * 2; }
    const char* cB = (const char*)S.bptr(cur);
    float rsc[8];
    E.prefetch(cur, wr, fr, rsc);
    PG8_STAGE_B(PG8_SB(0, 0), cB); PG8_STAGE_B(PG8_SB(0, 1), cB + hstep); PG8_STAGE_AC(PG8_SA(0, 0), 0, 0); PG8_STAGE_AC(PG8_SA(0, 1), 1, 0);
    if (wr == 1) PG8_BAR;
    PG8_WAIT_V(2); PG8_BAR;
    PG8_STAGE_B(PG8_SB(1, 0), cB + kstep); PG8_STAGE_AC(PG8_SA(1, 0), 0, kstep); PG8_STAGE_B(PG8_SB(1, 1), cB + hstep + kstep);
    PG8_WAIT_V(6); PG8_BAR;
    for (;;) {
        const bool has_next = S.next(ui + 1, nxt);
        const char* nB = cB; nAp = cAp;
        if (has_next) { nB = (const char*)S.bptr(nxt); if constexpr (GATHER) { PG8_MKA(nA, nxt); } else { nAp = Abase + (size_t)S.arow(nxt, 0) * K * 2; } }
        else { if constexpr (GATHER) {
#pragma unroll
            for (int h_ = 0; h_ < 2; ++h_)
#pragma unroll
                for (int i_ = 0; i_ < 2; ++i_) nA[h_][i_] = cA[h_][i_]; } }
        for (int t = 0; t < nt; t += 2) {
            const bool last = (t == nt - 2);
            const size_t k1 = (size_t)(t + 1) * kstep, k2 = last ? (size_t)0 : (size_t)(t + 2) * kstep;
            const char* a2p = (GATHER ? Abase : (last ? nAp : cAp)) + k2; const char* b2 = (last ? nB : cB) + k2;
            const char* b3 = b2 + kstep;
            const unsigned x00 = last ? nA[0][0] : cA[0][0], x01 = last ? nA[0][1] : cA[0][1], x10 = last ? nA[1][0] : cA[1][0], x11 = last ? nA[1][1] : cA[1][1];
            PG8_LDB(B0, 0, 0); PG8_LDB(B1, 0, 1); PG8_SCHED; PG8_LDA(At, 0, 0); PG8_STAGE_AC(PG8_SA(1, 1), 1, k1);
            PG8_WAIT_V(8); PG8_WAIT_L(0); PG8_BAR; PG8_MMA(0, 0, At, B0); PG8_MMA(0, 1, At, B1); PG8_BAR; PG8_SCHED;
            PG8_LDA(At, 0, 1); PG8_STAGE_B(PG8_SB(0, 0), b2); PG8_STAGE_B(PG8_SB(0, 1), b2 + hstep); PG8_STAGE_AX(PG8_SA(0, 0), 0, 0);
            PG8_WAIT_V(8); PG8_WAIT_L(0); PG8_BAR; PG8_MMA(1, 0, At, B0); PG8_MMA(1, 1, At, B1); PG8_BAR; PG8_SCHED;
            PG8_LDB(B0, 1, 0); PG8_LDB(B1, 1, 1); PG8_SCHED; PG8_LDA(At, 1, 0); PG8_STAGE_AX(PG8_SA(0, 1), 1, 0);
            PG8_WAIT_V(8); PG8_WAIT_L(0); PG8_BAR; PG8_MMA(0, 0, At, B0); PG8_MMA(0, 1, At, B1); PG8_BAR; PG8_SCHED;
            PG8_LDA(At, 1, 1); PG8_STAGE_B(PG8_SB(1, 0), b3); PG8_STAGE_B(PG8_SB(1, 1), b3 + hstep); PG8_STAGE_AX(PG8_SA(1, 0), 0, kstep);
            PG8_WAIT_V(8); PG8_WAIT_L(0); PG8_BAR; PG8_MMA(1, 0, At, B0); PG8_MMA(1, 1, At, B1); PG8_BAR; PG8_SCHED;
        }
        if (wr == 0) PG8_BAR;
        E(acc, cur, wr, wc, fr, fq, rsc);
        if (!has_next) break;
#pragma unroll
        for (int a = 0; a < 2; ++a)
#pragma unroll
            for (int b = 0; b < 2; ++b)
#pragma unroll
                for (int m = 0; m < 4; ++m)
#pragma unroll
                    for (int n = 0; n < 2; ++n) acc[a][b][m][n] = (f32x4){0.f, 0.f, 0.f, 0.f};
        cur = nxt; cB = nB; cAp = nAp; ++ui;
        E.prefetch(cur, wr, fr, rsc);
        if constexpr (GATHER) {
#pragma unroll
        for (int h_ = 0; h_ < 2; ++h_)
#pragma unroll
            for (int i_ = 0; i_ < 2; ++i_) cA[h_][i_] = nA[h_][i_]; }
        if (wr == 1) PG8_BAR;
    }
    PG8_WAIT_V(0);
    PG8_BAR;
#undef PG8_SA
#undef PG8_SB
#undef PG8_STAGE
#undef PG8_STAGE_AC
#undef PG8_STAGE_AX
#undef PG8_STAGE_B
#undef PG8_LDA
#undef PG8_LDB
#undef PG8_MMA
#undef PG8_WAIT_V
#undef PG8_WAIT_L
#undef PG8_BAR
#undef PG8_SCHED
#undef PG8_MKA
}

struct EpiWin {
    static constexpr bool PERM = true;
    bf16_t* proj; const float* rrow; const float* dqn; const float* cqn;
    __device__ __forceinline__ void prefetch(const Unit& u, int wr, int fr, float (&rsc)[8]) const {
#pragma unroll
        for (int ai = 0; ai < 2; ++ai)
#pragma unroll
            for (int m = 0; m < 4; ++m) rsc[ai * 4 + m] = rrow[u.pm * BM + ai * HALF + wr * 64 + m * 16 + fr];
    }
    __device__ __forceinline__ void operator()(const f32x4 (&acc)[2][2][4][2], const Unit& u, int wr, int wc, int fr, int fq, const float (&rsc)[8]) const {
        const int pn = u.pn;
        const float* g = nullptr;
        if (pn == 3 || pn == 4) g = dqn; else if (pn == 5 || pn == 6) g = dqn + 64; else if (pn == 9) g = cqn; else if (pn == 10) g = cqn + 64;
        const float qs = (pn == 0 || pn == 3 || pn == 4 || pn == 9) ? QSCALE : 1.0f;
        f32x4 gv[2][2];
#pragma unroll
        for (int bj = 0; bj < 2; ++bj)
#pragma unroll
            for (int n = 0; n < 2; ++n) { f32x4 t = g ? *(const f32x4*)(g + 32 * bj + 8 * fq + 4 * n) : (f32x4){1.f, 1.f, 1.f, 1.f}; gv[bj][n] = t * qs; }
        const bool donorm = (g != nullptr);
#pragma unroll
        for (int ai = 0; ai < 2; ++ai)
#pragma unroll
            for (int m = 0; m < 4; ++m) {
                const int row = u.pm * BM + ai * HALF + wr * 64 + m * 16 + fr;
                const float rs = rsc[ai * 4 + m];
                f32x4 v[2][2]; float ss = 0.f;
#pragma unroll
                for (int bj = 0; bj < 2; ++bj)
#pragma unroll
                    for (int n = 0; n < 2; ++n) { v[bj][n] = acc[ai][bj][m][n] * rs; const f32x4 q = v[bj][n] * v[bj][n]; ss += (q[0] + q[1]) + (q[2] + q[3]); }
                float rn = 1.0f;
                if (donorm) { ss += swz_xor<16>(ss); ss = sum_x32(ss); rn = __builtin_amdgcn_rsqf(ss * (1.0f / 64.0f) + EPS); }
                bf16_t* rowp = proj + (size_t)row * QKVW + pn * BM + 64 * wc + 8 * fq;
#pragma unroll
                for (int bj = 0; bj < 2; ++bj) { const f32x4 a = v[bj][0] * rn * gv[bj][0], b = v[bj][1] * rn * gv[bj][1];
                    u32x4 w; w.x = pk2(a[0], a[1]); w.y = pk2(a[2], a[3]); w.z = pk2(b[0], b[1]); w.w = pk2(b[2], b[3]);
                    *(u32x4*)(rowp + 32 * bj) = w; }
            }
    }
};
struct EpiWout {
    static constexpr bool PERM = true;
    bf16_t* h;
    __device__ __forceinline__ void prefetch(const Unit&, int, int, float (&)[8]) const {}
    __device__ __forceinline__ void operator()(const f32x4 (&acc)[2][2][4][2], const Unit& u, int wr, int wc, int fr, int fq, const float (&)[8]) const {
#pragma unroll
        for (int ai = 0; ai < 2; ++ai)
#pragma unroll
            for (int m = 0; m < 4; ++m) { bf16_t* rowp = h + (size_t)(u.pm * BM + ai * HALF + wr * 64 + m * 16 + fr) * DM + u.pn * BM + wc * 32 + 8 * fq;
#pragma unroll
                for (int bj = 0; bj < 2; ++bj) { const u32x4 b = *(const u32x4*)(rowp + bj * HALF); const f32x4 a0 = acc[ai][bj][m][0], a1 = acc[ai][bj][m][1];
                    u32x4 w; w.x = pk2(bflo(b.x) + a0[0], bfhi(b.x) + a0[1]); w.y = pk2(bflo(b.y) + a0[2], bfhi(b.y) + a0[3]); w.z = pk2(bflo(b.z) + a1[0], bfhi(b.z) + a1[1]); w.w = pk2(bflo(b.w) + a1[2], bfhi(b.w) + a1[3]);
                    *(u32x4*)(rowp + bj * HALF) = w; }
                if (m == 3) asm volatile("" ::: "memory"); }
    }
};
struct EpiGU {
    static constexpr bool PERM = true;
    bf16_t* hid; const float* rsl;
    __device__ __forceinline__ void prefetch(const Unit& u, int wr, int fr, float (&rsc)[8]) const {
#pragma unroll
        for (int ai = 0; ai < 2; ++ai)
#pragma unroll
            for (int m = 0; m < 4; ++m) { const int pos = u.t0 + ai * HALF + wr * 64 + m * 16 + fr; rsc[ai * 4 + m] = pos < u.cnt ? rsl[u.e * ECAP + pos] : 0.f; }
    }
    __device__ __forceinline__ void operator()(const f32x4 (&acc)[2][2][4][2], const Unit& u, int wr, int wc, int fr, int fq, const float (&rsc)[8]) const {
#pragma unroll
        for (int ai = 0; ai < 2; ++ai)
#pragma unroll
            for (int m = 0; m < 4; ++m) {
                const int rl = ai * HALF + wr * 64 + m * 16 + fr, pos = u.t0 + rl;
                const float rs = rsc[ai * 4 + m]; (void)pos;
                float o[8];
#pragma unroll
                for (int n = 0; n < 2; ++n)
#pragma unroll
                    for (int i = 0; i < 4; ++i) { const float gt = acc[ai][0][m][n][i] * rs, up = acc[ai][1][m][n][i] * rs;
                        const float sg = gt * __builtin_amdgcn_rcpf(1.0f + __builtin_amdgcn_exp2f(-gt * LOG2E)); o[n * 4 + i] = sg * up; }
                u32x4 w; w.x = pk2(o[0], o[1]); w.y = pk2(o[2], o[3]); w.z = pk2(o[4], o[5]); w.w = pk2(o[6], o[7]);
                *(u32x4*)(hid + (size_t)(u.pm * BM + rl) * DEXP + u.pn * HALF + 32 * wc + 8 * fq) = w;
            }
    }
};
struct EpiDown {
    static constexpr bool PERM = true;
    bf16_t* ybuf; const float* gl;
    __device__ __forceinline__ void prefetch(const Unit& u, int wr, int fr, float (&rsc)[8]) const {
#pragma unroll
        for (int ai = 0; ai < 2; ++ai)
#pragma unroll
            for (int m = 0; m < 4; ++m) { const int pos = u.t0 + ai * HALF + wr * 64 + m * 16 + fr; rsc[ai * 4 + m] = pos < u.cnt ? gl[u.e * ECAP + pos] : 0.f; }
    }
    __device__ __forceinline__ void operator()(const f32x4 (&acc)[2][2][4][2], const Unit& u, int wr, int wc, int fr, int fq, const float (&rsc)[8]) const {
#pragma unroll
        for (int ai = 0; ai < 2; ++ai)
#pragma unroll
            for (int m = 0; m < 4; ++m) {
                const int rl = ai * HALF + wr * 64 + m * 16 + fr, pos = u.t0 + rl;
                const float gt = rsc[ai * 4 + m]; (void)pos;
                bf16_t* rowp = ybuf + (size_t)(u.pm * BM + rl) * DM + u.pn * BM + wc * 32 + 8 * fq;
#pragma unroll
                for (int bj = 0; bj < 2; ++bj) { const f32x4 a = acc[ai][bj][m][0] * gt, b = acc[ai][bj][m][1] * gt;
                    u32x4 w; w.x = pk2(a[0], a[1]); w.y = pk2(a[2], a[3]); w.z = pk2(b[0], b[1]); w.w = pk2(b[2], b[3]);
                    *(u32x4*)(rowp + bj * HALF) = w; }
            }
    }
};
}

template <int IMM = 0> __device__ __forceinline__ void glds16_asm(const void* gsrc, unsigned lds_dst) {
    unsigned keep;
    asm volatile("s_mov_b32 %0, m0\n\ts_mov_b32 m0, %2\n\ts_nop 0\n\tglobal_load_lds_dwordx4 %1, off offset:%3\n\ts_mov_b32 m0, %0" : "=&s"(keep) : "v"(gsrc), "s"(lds_dst), "i"(IMM) : "memory");
}
__device__ __forceinline__ void glds16s_asm(const void* sbase, unsigned voff, unsigned lds_dst) {
    unsigned keep;
    asm volatile("s_mov_b32 %0, m0\n\ts_mov_b32 m0, %3\n\ts_nop 0\n\tglobal_load_lds_dwordx4 %1, %2\n\ts_mov_b32 m0, %0" : "=&s"(keep) : "v"(voff), "s"(sbase), "s"(lds_dst) : "memory");
}
__device__ __forceinline__ int crow(int r, int hi) { return (r & 3) + 8 * (r >> 2) + 4 * hi; }
__device__ __forceinline__ v4i16 vtr(const LAS unsigned char* p) { return __builtin_amdgcn_ds_read_tr16_b64_v4i16((LAS v4i16*)p); }
__device__ __forceinline__ bf16x8 mk8(v4i16 lo, v4i16 hi) { return (bf16x8){lo[0], lo[1], lo[2], lo[3], hi[0], hi[1], hi[2], hi[3]}; }
__device__ __forceinline__ void qk_tile(f32x16& p0, f32x16& p1, const LAS unsigned char* kt, const bf16x8* qr, int r32, int hi) {
    const int x = (r32 >> 1) & 7, y = x >> 1;
    const LAS unsigned char* kb = kt + r32 * 128 + ((hi ^ (x & 1)) << 4);
#pragma unroll
    for (int d0 = 0; d0 < 4; ++d0) {
        const bf16x8 a0 = *(const LAS bf16x8*)(kb + ((d0 ^ y) << 5)), a1 = *(const LAS bf16x8*)(kb + ((d0 ^ y) << 5) + 4096);
        p0 = __builtin_amdgcn_mfma_f32_32x32x16_bf16(a0, qr[d0], p0, 0, 0, 0);
        p1 = __builtin_amdgcn_mfma_f32_32x32x16_bf16(a1, qr[d0], p1, 0, 0, 0);
    }
}
template <int ND> __device__ __forceinline__ void pv_tile(f32x16* o, const LAS unsigned char* vt, const bf16x8* pa, int lane, int hi) {
    const LAS unsigned char* vb = vt + ((lane >> 4) & 1) * 32 + (lane & 3) * 8 + (4 * hi + ((lane & 15) >> 2)) * 64;
#pragma unroll
    for (int d0 = 0; d0 < ND; ++d0) {
        v4i16 lo[4], h2[4];
#pragma unroll
        for (int ks = 0; ks < 4; ++ks) { lo[ks] = vtr(vb + d0 * 4096 + ks * 1024); h2[ks] = vtr(vb + d0 * 4096 + ks * 1024 + 512); }
#pragma unroll
        for (int ks = 0; ks < 4; ++ks) o[d0] = __builtin_amdgcn_mfma_f32_32x32x16_bf16(mk8(lo[ks], h2[ks]), pa[ks], o[d0], 0, 0, 0);
        __builtin_amdgcn_sched_barrier(0);
    }
}
__device__ __forceinline__ void pack_p(bf16x8* pa, const f32x16& p0, const f32x16& p1) {
    u32x4 w;
    w.x = pk2(p0[0], p0[1]); w.y = pk2(p0[2], p0[3]); w.z = pk2(p0[4], p0[5]); w.w = pk2(p0[6], p0[7]); pa[0] = __builtin_bit_cast(bf16x8, w);
    w.x = pk2(p0[8], p0[9]); w.y = pk2(p0[10], p0[11]); w.z = pk2(p0[12], p0[13]); w.w = pk2(p0[14], p0[15]); pa[1] = __builtin_bit_cast(bf16x8, w);
    w.x = pk2(p1[0], p1[1]); w.y = pk2(p1[2], p1[3]); w.z = pk2(p1[4], p1[5]); w.w = pk2(p1[6], p1[7]); pa[2] = __builtin_bit_cast(bf16x8, w);
    w.x = pk2(p1[8], p1[9]); w.y = pk2(p1[10], p1[11]); w.z = pk2(p1[12], p1[13]); w.w = pk2(p1[14], p1[15]); pa[3] = __builtin_bit_cast(bf16x8, w);
}
#define SM_THR 8.0f
#ifndef PROBE_VAR
#define PROBE_VAR 0
#endif
template <int ND> __device__ __forceinline__ void sm_update(f32x16& p0, f32x16& p1, float& mref, float& l, f32x16* o, f32x16& cm, float cb, bool first, float& adj) {
    if (__any(adj != 0.f)) {
#pragma unroll
        for (int r = 0; r < 16; ++r) { p0[r] -= adj; p1[r] -= adj; }
    }
    adj = 0.f;
    float a = __builtin_fmaxf(__builtin_fmaxf(p0[0], p0[1]), p1[0]), b = __builtin_fmaxf(__builtin_fmaxf(p0[2], p0[3]), p1[1]); a = __builtin_fmaxf(__builtin_fmaxf(a, p1[2]), p1[3]);
#pragma unroll
    for (int r = 4; r < 16; r += 4) { a = __builtin_fmaxf(__builtin_fmaxf(a, p0[r]), p0[r + 1]); b = __builtin_fmaxf(__builtin_fmaxf(b, p0[r + 2]), p0[r + 3]);
        a = __builtin_fmaxf(__builtin_fmaxf(a, p1[r]), p1[r + 1]); b = __builtin_fmaxf(__builtin_fmaxf(b, p1[r + 2]), p1[r + 3]); }
    float mx = __builtin_fmaxf(a, b);
    if (first) {
        mx = max_x32(mx);
        mref = mx; adj = mx;
#pragma unroll
        for (int r = 0; r < 16; ++r) { p0[r] -= mx; p1[r] -= mx; cm[r] = cb - mx; }
    } else if (__any(mx > SM_THR)) {
        mx = max_x32(mx);
        const float d = __builtin_fmaxf(mx, 0.f);
        mref += d; adj = d;
        const float alpha = __builtin_amdgcn_exp2f(-d);
        l *= alpha;
#pragma unroll
        for (int r = 0; r < 16; ++r) { p0[r] -= d; p1[r] -= d; cm[r] = cb - mref; }
#pragma unroll
        for (int d0 = 0; d0 < ND; ++d0)
#pragma unroll
            for (int r = 0; r < 16; ++r) o[d0][r] *= alpha;
    }
    float s0 = 0.f, s1 = 0.f;
#pragma unroll
    for (int r = 0; r < 16; ++r) { p0[r] = __builtin_amdgcn_exp2f(p0[r]); p1[r] = __builtin_amdgcn_exp2f(p1[r]); s0 += p0[r]; s1 += p1[r]; }
    l += s0 + s1;
}
template <bool DUM = false> __device__ __forceinline__ void qk_tile_c(f32x16& p0, f32x16& p1, const LAS unsigned char* kt, const bf16x8* qr, const f32x16& cm, int r32, int hi) {
    if (DUM && PROBE_VAR == 3) { p0 = cm; p1 = cm;
#pragma unroll
        for (int d0 = 0; d0 < 4; ++d0) { p0 = __builtin_amdgcn_mfma_f32_32x32x16_bf16(qr[d0], qr[0], p0, 0, 0, 0); p1 = __builtin_amdgcn_mfma_f32_32x32x16_bf16(qr[d0], qr[1], p1, 0, 0, 0); }
        return; }
    const int x = (r32 >> 1) & 7;
    const LAS unsigned char* kb = kt + r32 * 128 + ((hi ^ (x & 1)) << 4);
    const int y = x >> 1;
#define K_PAIR(a_, b_, d0_) do { a_ = *(const LAS bf16x8*)(kb + (((d0_) ^ y) << 5)); b_ = *(const LAS bf16x8*)(kb + (((d0_) ^ y) << 5) + 4096); } while (0)
    bf16x8 ka0, kb0, ka1, kb1;
    K_PAIR(ka0, kb0, 0); K_PAIR(ka1, kb1, 1);
    __builtin_amdgcn_sched_barrier(0);
    if (DUM && PROBE_VAR == 2) { asm volatile("" :: "v"(ka0), "v"(kb0), "v"(ka1), "v"(kb1)); K_PAIR(ka0, kb0, 2); K_PAIR(ka1, kb1, 3); asm volatile("" :: "v"(ka0), "v"(kb0), "v"(ka1), "v"(kb1)); p0 = cm; p1 = cm; return; }
    p0 = __builtin_amdgcn_mfma_f32_32x32x16_bf16(ka0, qr[0], cm, 0, 0, 0); p1 = __builtin_amdgcn_mfma_f32_32x32x16_bf16(kb0, qr[0], cm, 0, 0, 0);
    __builtin_amdgcn_sched_barrier(0);
    K_PAIR(ka0, kb0, 2);
    __builtin_amdgcn_sched_barrier(0);
    p0 = __builtin_amdgcn_mfma_f32_32x32x16_bf16(ka1, qr[1], p0, 0, 0, 0); p1 = __builtin_amdgcn_mfma_f32_32x32x16_bf16(kb1, qr[1], p1, 0, 0, 0);
    __builtin_amdgcn_sched_barrier(0);
    K_PAIR(ka1, kb1, 3);
    __builtin_amdgcn_sched_barrier(0);
    p0 = __builtin_amdgcn_mfma_f32_32x32x16_bf16(ka0, qr[2], p0, 0, 0, 0); p1 = __builtin_amdgcn_mfma_f32_32x32x16_bf16(kb0, qr[2], p1, 0, 0, 0);
    p0 = __builtin_amdgcn_mfma_f32_32x32x16_bf16(ka1, qr[3], p0, 0, 0, 0); p1 = __builtin_amdgcn_mfma_f32_32x32x16_bf16(kb1, qr[3], p1, 0, 0, 0);
#undef K_PAIR
}
__device__ __forceinline__ void v_read8(v4i16* vf, const LAS unsigned char* vb, int d0) {
#pragma unroll
    for (int ks = 0; ks < 4; ++ks) { vf[2 * ks] = vtr(vb + d0 * 4096 + ks * 1024); vf[2 * ks + 1] = vtr(vb + d0 * 4096 + ks * 1024 + 512); }
}
__device__ __forceinline__ void pv_block(f32x16& o, const v4i16* vf, const bf16x8* pa) {
#pragma unroll
    for (int ks = 0; ks < 4; ++ks) o = __builtin_amdgcn_mfma_f32_32x32x16_bf16(mk8(vf[2 * ks], vf[2 * ks + 1]), pa[ks], o, 0, 0, 0);
}
template <int ND, bool DUM = false> __device__ __forceinline__ void attn_sm(f32x16& p0, f32x16& p1, f32x16& cm, float cb, const LAS float* tp, bool near, bool first,
                                                          float& mref, float& l, f32x16* o, bf16x8* pa, float& adj) {
    if (DUM && PROBE_VAR == 1) { asm volatile("" : "+v"(p0), "+v"(p1)); u32x4 w0 = {__builtin_bit_cast(unsigned, p0[0]), __builtin_bit_cast(unsigned, p0[1]), __builtin_bit_cast(unsigned, p0[2]), __builtin_bit_cast(unsigned, p0[3])}; pa[0] = pa[1] = pa[2] = pa[3] = __builtin_bit_cast(bf16x8, w0); return; }
    if (near) {
#pragma unroll
        for (int g = 0; g < 4; ++g) {
#pragma unroll
            for (int i = 0; i < 4; ++i) { const int r = 4 * g + i; p0[r] += tp[(r & 3) + 8 * (r >> 2)]; p1[r] += tp[(r & 3) + 8 * (r >> 2) + 32]; }
            __builtin_amdgcn_sched_barrier(0);
        }
    }
    sm_update<ND>(p0, p1, mref, l, o, cm, cb, first, adj);
    pack_p(pa, p0, p1);
}
template <int ND, bool DUM = false> __device__ __forceinline__ void attn_s2(const LAS unsigned char* vt, const bf16x8* pa, f32x16* o, int lane, int hi) {
    const LAS unsigned char* vb = vt + ((lane >> 4) & 1) * 32 + (lane & 3) * 8 + (4 * hi + ((lane & 15) >> 2)) * 64;
    if (DUM && PROBE_VAR == 3) {
#pragma unroll
        for (int d0 = 0; d0 < ND; ++d0)
#pragma unroll
            for (int ks = 0; ks < 4; ++ks) o[d0] = __builtin_amdgcn_mfma_f32_32x32x16_bf16(pa[(ks + 1) & 3], pa[ks], o[d0], 0, 0, 0);
        return; }
    v4i16 hA[4], hB[4];
#define PV_MFMA(X, Y, PA, O) do { if (DUM && PROBE_VAR == 2) { asm volatile("" :: "v"(X), "v"(Y)); } else O = __builtin_amdgcn_mfma_f32_32x32x16_bf16(mk8(X, Y), PA, O, 0, 0, 0); } while (0)
#define V_HALF(dst, d0_, half_) do { _Pragma("unroll") for (int q_ = 0; q_ < 2; ++q_) { dst[2 * q_] = vtr(vb + (d0_) * 4096 + (2 * (half_) + q_) * 1024); dst[2 * q_ + 1] = vtr(vb + (d0_) * 4096 + (2 * (half_) + q_) * 1024 + 512); } } while (0)
    V_HALF(hA, 0, 0); V_HALF(hB, 0, 1);
#pragma unroll
    for (int d0 = 0; d0 < ND; ++d0) {
        __builtin_amdgcn_sched_barrier(0);
        PV_MFMA(hA[0], hA[1], pa[0], o[d0]);
        PV_MFMA(hA[2], hA[3], pa[1], o[d0]);
        __builtin_amdgcn_sched_barrier(0);
        if (d0 + 1 < ND) V_HALF(hA, d0 + 1, 0);
        __builtin_amdgcn_sched_barrier(0);
        PV_MFMA(hB[0], hB[1], pa[2], o[d0]);
        PV_MFMA(hB[2], hB[3], pa[3], o[d0]);
        __builtin_amdgcn_sched_barrier(0);
        if (d0 + 1 < ND) V_HALF(hB, d0 + 1, 1);
    }
#undef V_HALF
#undef PV_MFMA
}
__device__ __forceinline__ float rowmax32(const f32x16& p0, const f32x16& p1) {
    float a = __builtin_fmaxf(__builtin_fmaxf(p0[0], p0[1]), p1[0]), b = __builtin_fmaxf(__builtin_fmaxf(p0[2], p0[3]), p1[1]); a = __builtin_fmaxf(__builtin_fmaxf(a, p1[2]), p1[3]);
#pragma unroll
    for (int r = 4; r < 16; r += 4) { a = __builtin_fmaxf(__builtin_fmaxf(a, p0[r]), p0[r + 1]); b = __builtin_fmaxf(__builtin_fmaxf(b, p0[r + 2]), p0[r + 3]);
        a = __builtin_fmaxf(__builtin_fmaxf(a, p1[r]), p1[r + 1]); b = __builtin_fmaxf(__builtin_fmaxf(b, p1[r + 2]), p1[r + 3]); }
    return __builtin_fmaxf(a, b);
}
template <int ND> __device__ __forceinline__ void attn_fast(const f32x16& p0, const f32x16& p1, float& l, f32x16* o, const LAS unsigned char* vt, bf16x8* pa, int lane, int hi) {
    const bf16x8* pa_prev = pa; bf16x8* pa_cur = pa;
    const LAS unsigned char* vb = vt + ((lane >> 4) & 1) * 32 + (lane & 3) * 8 + (4 * hi + ((lane & 15) >> 2)) * 64;
    v4i16 hA[4], hB[4];
    unsigned w[16]; float s0 = 0.f, s1 = 0.f;
#define V_HALF(dst, d0_, half_) do { _Pragma("unroll") for (int q_ = 0; q_ < 2; ++q_) { dst[2 * q_] = vtr(vb + (d0_) * 4096 + (2 * (half_) + q_) * 1024); dst[2 * q_ + 1] = vtr(vb + (d0_) * 4096 + (2 * (half_) + q_) * 1024 + 512); } } while (0)
#define PAIR(j_) do { const int j__ = (j_), i0_ = (2 * j__) & 15, i1_ = (2 * j__ + 1) & 15; float x0_ = j__ < 8 ? p0[i0_] : p1[i0_], x1_ = j__ < 8 ? p0[i1_] : p1[i1_]; \
        asm volatile("" : "+v"(x0_), "+v"(x1_));     \
        const float e0 = __builtin_amdgcn_exp2f(x0_), e1 = __builtin_amdgcn_exp2f(x1_); s0 += e0; s1 += e1; w[j__] = pk2(e0, e1); \
        asm volatile("" : "+v"(w[j__]), "+v"(s0), "+v"(s1)); } while (0)
#define GAPV(g_) do { if (ND == 4) { PAIR(g_); } else { PAIR(2 * (g_)); PAIR(2 * (g_) + 1); } } while (0)
    V_HALF(hA, 0, 0); V_HALF(hB, 0, 1);
#pragma unroll
    for (int d0 = 0; d0 < ND; ++d0) {
        __builtin_amdgcn_sched_barrier(0);
        o[d0] = __builtin_amdgcn_mfma_f32_32x32x16_bf16(mk8(hA[0], hA[1]), pa_prev[0], o[d0], 0, 0, 0); GAPV(4 * d0 + 0);
        __builtin_amdgcn_sched_barrier(0);
        o[d0] = __builtin_amdgcn_mfma_f32_32x32x16_bf16(mk8(hA[2], hA[3]), pa_prev[1], o[d0], 0, 0, 0); GAPV(4 * d0 + 1);
        __builtin_amdgcn_sched_barrier(0);
        if (d0 + 1 < ND) V_HALF(hA, d0 + 1, 0);
        o[d0] = __builtin_amdgcn_mfma_f32_32x32x16_bf16(mk8(hB[0], hB[1]), pa_prev[2], o[d0], 0, 0, 0); GAPV(4 * d0 + 2);
        __builtin_amdgcn_sched_barrier(0);
        o[d0] = __builtin_amdgcn_mfma_f32_32x32x16_bf16(mk8(hB[2], hB[3]), pa_prev[3], o[d0], 0, 0, 0); GAPV(4 * d0 + 3);
        __builtin_amdgcn_sched_barrier(0);
        if (d0 + 1 < ND) V_HALF(hB, d0 + 1, 1);
    }
#undef V_HALF
#undef PAIR
#undef GAPV
    l += s0 + s1;
#pragma unroll
    for (int k = 0; k < 4; ++k) { u32x4 t4; t4.x = w[4 * k]; t4.y = w[4 * k + 1]; t4.z = w[4 * k + 2]; t4.w = w[4 * k + 3]; pa_cur[k] = __builtin_bit_cast(bf16x8, t4); }
}
__device__ __forceinline__ int t5_bucket_past_or_future(int rel) {
    const int n = rel < 0 ? -rel : rel;
    int v;
    if (n < 8) v = n;
    else v = 8 + (n >= 13) + (n >= 20) + (n >= 30) + (n >= 46) + (n >= 70) + (n >= 108) + (n >= 166);
    return (rel > 0 ? 16 : 0) + v;
}

__device__ __forceinline__ void attn_tables(LAS unsigned char* lds, const float* t5_bias, const float* relb, const float* dlam, const float* subln, float lam_init, int wv) {
    const int tid = tid_of(wv), lane = tid & 63;
    LAS float* T = (LAS float*)(lds + TB_OFF);
    for (int i = tid; i < 4 * 324; i += NWAVES * 64) { const int h = i / 324, j = i % 324; T[i] = (t5_bias[t5_bucket_past_or_future(j - 260) * 4 + h] - t5_bias[15 * 4 + h]) * LOG2E; }
    for (int i = tid; i < 4 * 288; i += NWAVES * 64) { const int h = i / 288, j = i % 288; int rel = j - 224; rel = rel < -128 ? -128 : rel; T[4 * 324 + i] = (relb[(rel + 128) * 4 + h] - relb[h]) * LOG2E; }
    if (tid < 128) T[4 * 324 + 4 * 288 + tid] = subln[tid];
    { float a = dlam[lane] * dlam[64 + lane], c = dlam[128 + lane] * dlam[192 + lane];
      a = wave_sum(a); c = wave_sum(c);
      if (tid == 0) T[4 * 324 + 4 * 288 + 128] = __expf(a) - __expf(c) + lam_init; }
    __syncthreads();
}

template <bool DUM> __device__ __forceinline__ void attnB_unit(LAS unsigned char* lds, const bf16_t* proj, bf16_t* merged, const float* t5_bias, const float* dlam, const float* subln, float lam_init, float one_m_lam, int b, int h, int qb, int wv) {
    constexpr bool kvdummy = DUM;
    int tid = tid_of(wv); asm volatile("" : "+v"(tid)); const int lane = tid & 63, r32 = lane & 31, hi = lane >> 5; const int wid = __builtin_amdgcn_readfirstlane(tid >> 6);
    const int m = wid >> 2, s = wid & 3, q0w = qb * 128 + s * 32;
    const size_t tokbase = (size_t)b * SEQ;
    const LAS float* tb = (const LAS float*)(lds + TB_OFF) + h * 324;
    const float cb = t5_bias[15 * 4 + h] * LOG2E;
    const float lam = ((const LAS float*)(lds + TB_OFF))[4 * 324 + 4 * 288 + 128];
    bf16x8 qr[4];
    { const bf16_t* qp = proj + (tokbase + q0w + r32) * QKVW + 768 + h * 128 + m * 64 + hi * 8;
#pragma unroll
      for (int d0 = 0; d0 < 4; ++d0) qr[d0] = *(const bf16x8*)(qp + d0 * 16); }
    const int ntiles = 2 * qb + 2, mylast = q0w >> 6;
    const int pid0 = wid, pid1 = wid + 8;
    const int kkey = 8 * wid + (lane >> 3), kch = (lane & 7) ^ ((kkey >> 1) & 7);
    const size_t tokkv = kvdummy ? (size_t)0 : tokbase; const int hkv = kvdummy ? 0 : h;
    const unsigned offK = (unsigned)(((tokkv + kkey) * QKVW + 1280 + hkv * 128 + 8 * kch) * 2);
    const unsigned offV = (unsigned)(((tokkv + 16 * (pid0 & 3) + (lane >> 2)) * QKVW + 1792 + hkv * 128 + 32 * (pid0 >> 2) + 8 * (lane & 3)) * 2);
    const size_t tstep = (size_t)64 * QKVW;
#define GLDS16(src, dstoff) glds16_asm<0>((const void*)(src), (unsigned)__builtin_amdgcn_readfirstlane((int)(ldsbase + (unsigned)(dstoff))))
#define GLDS16S(sbase, voff, dstoff) glds16s_asm((const void*)(sbase), (unsigned)(voff), (unsigned)__builtin_amdgcn_readfirstlane((int)(ldsbase + (unsigned)(dstoff))))
#define WAIT_BAR() asm volatile("s_waitcnt vmcnt(0) lgkmcnt(0)\n\ts_barrier" ::: "memory")
    const unsigned ldsbase = (unsigned)(size_t)lds;
    const int uK1 = wid * 1024, uK2 = 8192 + uK1, uV0 = 16384 + pid0 * 1024, uV1 = 16384 + pid1 * 1024;
#define B_ISSUE(t_, boff) do { const char* sb_ = (const char*)proj + (size_t)(t_) * tstep * 2; GLDS16S(sb_, offK, (boff) + uK1); GLDS16S(sb_ + 128, offK, (boff) + uK2); GLDS16S(sb_, offV, (boff) + uV0); GLDS16S(sb_ + 128, offV, (boff) + uV1); } while (0)
#define B_ISSUE_C(u_) do { const int u__ = (u_); if (u__ < ntiles && !(kvdummy && u__ >= 4)) B_ISSUE(u__, (u__ & 3) * 32768); } while (0)
    B_ISSUE_C(0); B_ISSUE_C(1);
    asm volatile("s_waitcnt vmcnt(4) lgkmcnt(0)\n\ts_barrier" ::: "memory");
    float mref = 0.f, l = 0.f, adj = 0.f; f32x16 o[4]; f32x16 cm;
#pragma unroll
    for (int d0 = 0; d0 < 4; ++d0) o[d0] = f32x16{};
#pragma unroll
    for (int r = 0; r < 16; ++r) cm[r] = cb;
    bf16x8 pa[4];
    f32x16 pA0, pA1;
    qk_tile_c<DUM>(pA0, pA1, lds + m * 8192, qr, cm, r32, hi);
#define STEP_PRE(tt) do { if ((tt) + 1 < ntiles) asm volatile("s_waitcnt vmcnt(0) lgkmcnt(0)\n\ts_barrier" ::: "memory"); B_ISSUE_C((tt) + 2); } while (0)
#define VPREV(tt) (lds + (((tt) - 1) & 3) * 32768 + 16384)
#define QK_NEXT(tt) do { __builtin_amdgcn_sched_barrier(0); if ((tt) + 1 <= mylast) qk_tile_c<DUM>(pA0, pA1, lds + (((tt) + 1) & 3) * 32768 + m * 8192, qr, cm, r32, hi); } while (0)
    const int tnear = (q0w < 229) ? 0 : ((q0w - 229) >> 6) + 1;
    const int tF = tnear < mylast + 1 ? tnear : mylast + 1;
    STEP_PRE(0);
    adj = 0.f; attn_sm<4, DUM>(pA0, pA1, cm, cb, tb + (0 - (q0w + r32) + 260 + 4 * hi), tnear == 0, true, mref, l, o, pa, adj);
    QK_NEXT(0);
    int t = 1;
    for (; t < tF; ++t) {
        if (__any(rowmax32(pA0, pA1) > SM_THR)) break;
        STEP_PRE(t);
        attn_fast<4>(pA0, pA1, l, o, VPREV(t), pa, lane, hi);
        QK_NEXT(t);
    }
    for (; t < tF; ++t) {
        STEP_PRE(t);
        attn_s2<4, DUM>(VPREV(t), pa, o, lane, hi);
        adj = 0.f; attn_sm<4, DUM>(pA0, pA1, cm, cb, tb, false, false, mref, l, o, pa, adj);
        QK_NEXT(t);
    }
    for (; t <= mylast; ++t) {
        STEP_PRE(t);
        attn_s2<4, DUM>(VPREV(t), pa, o, lane, hi);
        adj = 0.f; attn_sm<4, DUM>(pA0, pA1, cm, cb, tb + (64 * t - (q0w + r32) + 260 + 4 * hi), true, false, mref, l, o, pa, adj);
        QK_NEXT(t);
    }
    if (t < ntiles) { STEP_PRE(t); attn_s2<4, DUM>(VPREV(t), pa, o, lane, hi); for (++t; t < ntiles; ++t) STEP_PRE(t); }
    else attn_s2<4, DUM>(VPREV(t), pa, o, lane, hi);
    asm volatile("s_waitcnt lgkmcnt(0)\n\ts_barrier" ::: "memory");
#undef STEP_PRE
#undef VPREV
#undef QK_NEXT
#undef B_ISSUE_C
#undef B_ISSUE
    const float lt = sum_x32(l), inv = 1.0f / lt;
    LAS float* X = (LAS float*)lds;
    if (m == 1) {
#pragma unroll
        for (int d0 = 0; d0 < 4; ++d0)
#pragma unroll
            for (int r = 0; r < 16; ++r) X[((s * 64 + d0 * 16 + r) * 64) + lane] = o[d0][r] * inv;
    }
    __syncthreads();
    if (m == 0) {
        float ss = 0.f;
#pragma unroll
        for (int d0 = 0; d0 < 4; ++d0)
#pragma unroll
            for (int r = 0; r < 16; ++r) { const float y = o[d0][r] * inv - lam * X[((s * 64 + d0 * 16 + r) * 64) + lane]; o[d0][r] = y; ss += y * y; }
        ss = sum_x32(ss);
        const float rn = __builtin_amdgcn_rsqf(ss * (1.0f / 128.0f) + EPS) * one_m_lam;
        bf16_t* op = merged + (tokbase + q0w + r32) * DM + 256 + h * 128 + 4 * hi;
#pragma unroll
        for (int d0 = 0; d0 < 4; ++d0)
#pragma unroll
            for (int a = 0; a < 4; ++a) { const f32x4 g = *(const LAS f32x4*)((const LAS float*)(lds + TB_OFF) + 4 * 324 + 4 * 288 + 32 * d0 + 8 * a + 4 * hi);
                u32x2 w; w.x = pk2(o[d0][4 * a] * rn * g[0], o[d0][4 * a + 1] * rn * g[1]); w.y = pk2(o[d0][4 * a + 2] * rn * g[2], o[d0][4 * a + 3] * rn * g[3]);
                *(u32x2*)(op + 32 * d0 + 8 * a) = w; }
    }
    __syncthreads();
}

__device__ __forceinline__ void attnC_unit(LAS unsigned char* lds, const bf16_t* proj, bf16_t* merged, const float* relb  , int b, int h, int qb, int wv) {
    int tid = tid_of(wv); asm volatile("" : "+v"(tid)); const int lane = tid & 63, r32 = lane & 31, hi = lane >> 5; const int wid = __builtin_amdgcn_readfirstlane(tid >> 6);
    const int c0 = 4 * qb, cw = c0 + (wid >> 1), q0w = 64 * cw + 32 * (wid & 1);
    const size_t tokbase = (size_t)b * SEQ;
    const LAS float* tb = (const LAS float*)(lds + TB_OFF) + 4 * 324 + h * 288;
    const float cb = relb[h] * LOG2E;
    bf16x8 qr[4];
    { const bf16_t* qp = proj + (tokbase + q0w + r32) * QKVW + 2304 + h * 64 + hi * 8;
#pragma unroll
      for (int d0 = 0; d0 < 4; ++d0) qr[d0] = *(const bf16x8*)(qp + d0 * 16); }
    const int tlo = c0 - 8 < 0 ? 0 : c0 - 8, thi = c0 + 3;
    const int kkey = 8 * wid + (lane >> 3), kch = (lane & 7) ^ ((kkey >> 1) & 7);
    const bf16_t* srcK = proj + (tokbase + kkey) * QKVW + 2560 + h * 64 + 8 * kch;
    const bf16_t* srcV = proj + (tokbase + 16 * (wid & 3) + (lane >> 2)) * QKVW + 2816 + h * 64 + 32 * (wid >> 2) + 8 * (lane & 3);
    const int uK = wid * 1024, uV = 8192 + uK;
    const unsigned ldsbase = (unsigned)(size_t)lds;
    const size_t tstep = (size_t)64 * QKVW;
#define C_ISSUE(t_, boff) do { const size_t off_ = (size_t)(t_) * tstep; GLDS16(srcK + off_, (boff) + uK); GLDS16(srcV + off_, (boff) + uV); } while (0)
    C_ISSUE(tlo, 0); C_ISSUE(tlo + 1, 16384);
    asm volatile("s_waitcnt vmcnt(2) lgkmcnt(0)\n\ts_barrier" ::: "memory");
    float mref = 0.f, l = 0.f, adj = 0.f; f32x16 o[2]; o[0] = f32x16{}; o[1] = f32x16{}; f32x16 cm;
#pragma unroll
    for (int r = 0; r < 16; ++r) cm[r] = cb;
    const int myfirst = cw - 8 < 0 ? 0 : cw - 8;
    int bc = 0, bn = 16384, bnn = 32768;
    bf16x8 pa[4];
    f32x16 pA0, pA1, pB0, pB1;
    if (tlo >= myfirst && tlo <= cw) qk_tile_c(pA0, pA1, lds, qr, cm, r32, hi);
#define C_STEP(PC0, PC1, PN0, PN1, t_) do { const int tt = (t_); const bool hasn = (tt + 1 <= thi); \
        if (hasn) asm volatile("s_waitcnt vmcnt(0) lgkmcnt(0)\n\ts_barrier" ::: "memory"); \
        if (tt + 2 <= thi) C_ISSUE(tt + 2, bnn); \
        if (hasn && tt + 1 >= myfirst && tt + 1 <= cw) qk_tile_c(PN0, PN1, lds + bn, qr, cm, r32, hi); \
        __builtin_amdgcn_sched_barrier(0); \
        if (tt >= myfirst && tt <= cw) { const bool near = (64 * tt + 63 - q0w > -128); \
            attn_sm<2>(PC0, PC1, cm, cb, tb + (64 * tt - (q0w + r32) + 224 + 4 * hi), near, tt == myfirst, mref, l, o, pa, adj); \
            attn_s2<2>(lds + bc + 8192, pa, o, lane, hi); } \
        const int tmp_ = bc; bc = bn; bn = bnn; bnn = tmp_; } while (0)
    for (int t = tlo; t <= thi; t += 2) { C_STEP(pA0, pA1, pB0, pB1, t); C_STEP(pB0, pB1, pA0, pA1, t + 1); }
#undef C_STEP
    asm volatile("s_waitcnt lgkmcnt(0)\n\ts_barrier" ::: "memory");
#undef C_ISSUE
    const float lt = sum_x32(l), inv = 1.0f / lt;
    bf16_t* op = merged + (tokbase + q0w + r32) * DM + 768 + h * 64 + 4 * hi;
#pragma unroll
    for (int d0 = 0; d0 < 2; ++d0)
#pragma unroll
        for (int a = 0; a < 4; ++a) { u32x2 w; w.x = pk2(o[d0][4 * a] * inv, o[d0][4 * a + 1] * inv); w.y = pk2(o[d0][4 * a + 2] * inv, o[d0][4 * a + 3] * inv); *(u32x2*)(op + 32 * d0 + 8 * a) = w; }
}

__device__ __forceinline__ void attnA_unit(LAS unsigned char* lds, const bf16_t* proj, bf16_t* merged, int b, int h, int qb, int wv) {
    int tid = tid_of(wv); asm volatile("" : "+v"(tid)); const int lane = tid & 63, r32 = lane & 31, hi = lane >> 5; const int wid = __builtin_amdgcn_readfirstlane(tid >> 6);
    const int q0w = 256 * qb + 32 * wid, td = q0w >> 6;
    const size_t tokbase = (size_t)b * SEQ;
    LAS unsigned char* wl = lds + wid * 16384;
    const unsigned ldsbase = (unsigned)(size_t)lds;
    bf16x8 qr[4];
    { const bf16_t* qp = proj + (tokbase + q0w + r32) * QKVW + h * 64 + hi * 8;
#pragma unroll
      for (int d0 = 0; d0 < 4; ++d0) qr[d0] = *(const bf16x8*)(qp + d0 * 16); }
    float carry = 1.0f; f32x16 o[2]; o[0] = f32x16{}; o[1] = f32x16{};
    const int qpos = q0w + r32;
    const int wbase = wid * 16384;
    const bf16_t* kp0 = proj + (tokbase + (lane >> 3)) * QKVW + 256 + h * 64;
    const bf16_t* vp0 = proj + (tokbase + (lane >> 2)) * QKVW + 512 + h * 64 + 8 * (lane & 3);
#define A_ISSUE_K(t_) do { const bf16_t* kp = kp0 + (size_t)(64 * (t_)) * QKVW; _Pragma("unroll") for (int j = 0; j < 8; ++j) GLDS16(kp + (size_t)(8 * j) * QKVW + 8 * ((lane & 7) ^ (((8 * j + (lane >> 3)) >> 1) & 7)), wbase + j * 1024); } while (0)
#define A_ISSUE_V(t_) do { const bf16_t* vp = vp0 + (size_t)(64 * (t_)) * QKVW; _Pragma("unroll") for (int j = 0; j < 8; ++j) GLDS16(vp + (size_t)(16 * (j & 3)) * QKVW + 32 * (j >> 2), wbase + 8192 + j * 1024); } while (0)
    A_ISSUE_K(td); A_ISSUE_V(td);
    for (int t = td; t >= 0; --t) {
        asm volatile("s_waitcnt vmcnt(8)" ::: "memory");
        f32x16 p0 = f32x16{}, p1 = f32x16{};
        qk_tile(p0, p1, wl, qr, r32, hi);
        f32x16 k0, k1;
        const bool diag = (t == td);
#pragma unroll
        for (int r = 0; r < 16; ++r) {
            const float z0 = p0[r], z1 = p1[r];
            const float u0 = __builtin_amdgcn_exp2f(-fabsf(z0)), u1 = __builtin_amdgcn_exp2f(-fabsf(z1));
            const float r0 = __builtin_amdgcn_rcpf(1.0f + u0), r1 = __builtin_amdgcn_rcpf(1.0f + u1);
            const float ur0 = u0 * r0, ur1 = u1 * r1;
            float b0 = z0 >= 0.f ? r0 : ur0, a0 = z0 >= 0.f ? ur0 : r0;
            float b1 = z1 >= 0.f ? r1 : ur1, a1 = z1 >= 0.f ? ur1 : r1;
            if (diag) { const int key = 64 * t + crow(r, hi); if (key >= qpos) { a0 = 1.f; b0 = 0.f; } if (key + 32 >= qpos) { a1 = 1.f; b1 = 0.f; } }
            k0[r] = a0; k1[r] = a1; p0[r] = b0; p1[r] = b1;
        }
        float G[2][4], Go[2][4];
#pragma unroll
        for (int a = 0; a < 4; ++a) { G[0][a] = (k0[4 * a] * k0[4 * a + 1]) * (k0[4 * a + 2] * k0[4 * a + 3]); G[1][a] = (k1[4 * a] * k1[4 * a + 1]) * (k1[4 * a + 2] * k1[4 * a + 3]); }
#pragma unroll
        for (int P = 0; P < 2; ++P)
#pragma unroll
            for (int a = 0; a < 4; ++a) Go[P][a] = other_x32(G[P][a], hi);
        float total = carry;
#pragma unroll
        for (int P = 1; P >= 0; --P)
#pragma unroll
            for (int a = 3; a >= 0; --a) total *= G[P][a] * Go[P][a];
        const bool cont = (t > 0) && !__all(total < 1e-41f);
        if (cont) A_ISSUE_K(t - 1);
        float accs = carry;
#pragma unroll
        for (int P = 1; P >= 0; --P)
#pragma unroll
            for (int a = 3; a >= 0; --a) {
                f32x16& kk_ = P ? k1 : k0; f32x16& pp = P ? p1 : p0;
                float bt = accs * (hi == 0 ? Go[P][a] : 1.0f);
#pragma unroll
                for (int i = 3; i >= 0; --i) { const int r = 4 * a + i; pp[r] = pp[r] * bt; bt *= kk_[r]; }
                accs *= G[P][a] * Go[P][a];
            }
        carry = accs;
        bf16x8 pa[4]; pack_p(pa, p0, p1);
        if (cont) asm volatile("s_waitcnt vmcnt(8)" ::: "memory"); else asm volatile("s_waitcnt vmcnt(0)" ::: "memory");
        pv_tile<2>(o, wl + 8192, pa, lane, hi);
        asm volatile("s_waitcnt lgkmcnt(0)" ::: "memory");
        if (!cont) break;
        A_ISSUE_V(t - 1);
    }
#undef A_ISSUE_K
#undef A_ISSUE_V
    bf16_t* op = merged + (tokbase + q0w + r32) * DM + h * 64 + 4 * hi;
#pragma unroll
    for (int d0 = 0; d0 < 2; ++d0)
#pragma unroll
        for (int a = 0; a < 4; ++a) { u32x2 w; w.x = pk2(o[d0][4 * a], o[d0][4 * a + 1]); w.y = pk2(o[d0][4 * a + 2], o[d0][4 * a + 3]); *(u32x2*)(op + 32 * d0 + 8 * a) = w; }
}

struct Args { const float* in[18]; float* out; unsigned char* ws; int ph_lo, ph_hi; };
enum { I_X = 0, I_T5, I_ANORM, I_WIN, I_DQN, I_DLAM, I_DSUB, I_CQN, I_CRB, I_WOUT, I_FNORM, I_RGW, I_RGB, I_REW, I_REB, I_WG, I_WU, I_WD };

__device__ __forceinline__ int rowmap(int kind, int n) {
    if (kind == 1) return (n & ~255) + 128 * ((n & 63) >> 5) + 32 * ((n >> 6) & 3) + (n & 31);
    if (kind == 2) return 256 * (n >> 7) + (n & 127);
    if (kind == 3) return 256 * (n >> 7) + 128 + (n & 127);
    return n;
}
__device__ __forceinline__ void transpose_item(const float* W, int K, int N, const float* gain, bf16_t* WT, int kind, LAS unsigned char* scr, int item, int lane) {
    const int nblk = N / 64, kb = item / nblk, nb = item % nblk, k0 = 64 * kb, n0 = 64 * nb;
    const float* src = W + (size_t)k0 * N + n0 + lane;
    float v[64];
#pragma unroll
    for (int k = 0; k < 64; ++k) v[k] = src[(size_t)k * N];
    if (gain) {
#pragma unroll
        for (int k = 0; k < 64; ++k) v[k] *= gain[k0 + k];
    }
#pragma unroll
    for (int j = 0; j < 8; ++j) { u32x4 o; o.x = pk2(v[8 * j], v[8 * j + 1]); o.y = pk2(v[8 * j + 2], v[8 * j + 3]); o.z = pk2(v[8 * j + 4], v[8 * j + 5]); o.w = pk2(v[8 * j + 6], v[8 * j + 7]);
        *(LAS u32x4*)(scr + lane * 144 + 16 * j) = o; }
    LDS_WAIT();
#pragma unroll
    for (int i = 0; i < 8; ++i) { const int n = 8 * i + (lane >> 3); const u32x4 o = *(const LAS u32x4*)(scr + n * 144 + 16 * (lane & 7));
        *(u32x4*)(WT + (size_t)rowmap(kind, n0 + n) * K + k0 + 8 * (lane & 7)) = o; }
    LDS_WAIT();
}

__global__ void __launch_bounds__(NWAVES * 64, 2) fwd_kernel(Args args) {
    extern __shared__ __attribute__((aligned(16))) unsigned char lds_raw[];
    LAS unsigned char* lds = (LAS unsigned char*)lds_raw;
    volatile LAS unsigned* MISC = (volatile LAS unsigned*)(lds + MISC_OFF);
    const int G = gridDim.x, bx = blockIdx.x;
    const int vcu = (G % 8 == 0) ? (bx % 8) * (G / 8) + bx / 8 : bx;
    unsigned char* ws0 = args.ws;
    gu32* ctl = (gu32*)(ws0 + WS_CTL);
#define PHASE_LOCALS() \
    unsigned long long zero_ = 0ull; asm volatile("" : "+s"(zero_)); unsigned char* ws = ws0 + zero_; \
    int tid = tid_of(wv0); asm volatile("" : "+v"(tid)); \
    const int lane = tid & 63, wave = __builtin_amdgcn_readfirstlane(tid >> 6); \
    const int gw = vcu * NWAVES + wave, NGW = G * NWAVES; \
    float* out = args.out; \
    bf16_t* hb = (bf16_t*)(ws + WS_HB); bf16_t* proj = (bf16_t*)(ws + WS_PROJ); bf16_t* merged = (bf16_t*)(ws + WS_MERGED); \
    bf16_t* hid = (bf16_t*)(ws + WS_HID); bf16_t* ybuf = (bf16_t*)(ws + WS_YBUF); float* rrow = (float*)(ws + WS_RROW); \
    unsigned* slot_of = (unsigned*)(ws + WS_SLOT); int* tok_list = (int*)(ws + WS_TOK); float* gate_list = (float*)(ws + WS_GATE); float* rs_list = (float*)(ws + WS_RS); \
    (void)lane; (void)wave; (void)gw; (void)NGW; (void)out; (void)hb; (void)proj; (void)merged; (void)hid; (void)ybuf; (void)rrow; (void)slot_of; (void)tok_list; (void)gate_list; (void)rs_list;

    const int wv0 = __builtin_amdgcn_readfirstlane((int)threadIdx.x >> 6);
    if (wv0 == 0) MISC[tid_of(0)] = 0u;
    __syncthreads();
#if MK_N_LAUNCHES == 1
    XcdBarrier bar = xcd_barrier_post((unsigned*)(ctl + CW_BAR), MISC + 40, wv0);
#define GRID_BAR() xcd_barrier(bar)
#else
#define GRID_BAR() do {} while (0)
#endif
    const int lo = args.ph_lo, hi_ph = args.ph_hi;
#ifndef PH_MASK
#define PH_MASK 0xff
#endif
#define IN(k) (lo <= (k) && (k) < hi_ph && ((PH_MASK >> ((k) == 0 ? 0 : (((k) - 1) % 7) + 1)) & 1))
#define BOTH(k) (IN(k) && IN((k) + 1))
#ifndef DUP_MASK
#define DUP_MASK 0
#endif
#define REPS(kind) (((DUP_MASK >> (kind)) & 1) ? 2 : 1)

    if (IN(0)) for (int rep_ = 0; rep_ < REPS(0); ++rep_) {
        PHASE_LOCALS();
        LAS unsigned char* scr = lds + wave * 9216;
        constexpr int I_IN = 16 * 48, I_OUT = 16 * 16, I_E = 128;
        constexpr int N_A = DEPTH * I_IN, N_B = DEPTH * I_OUT, N_C = DEPTH * NEXP * I_E;
        constexpr int NITEMS = N_A + N_B + 3 * N_C;
        for (int it = gw; it < NITEMS; it += NGW) {
            int r = it;
            if (r < N_A) { const int l = r / I_IN; transpose_item(args.in[I_WIN] + (size_t)l * DM * QKVW, DM, QKVW, args.in[I_ANORM] + l * DM, (bf16_t*)(ws + WS_WIN) + (size_t)l * QKVW * DM, 1, scr, r % I_IN, lane); continue; } r -= N_A;
            if (r < N_B) { const int l = r / I_OUT; transpose_item(args.in[I_WOUT] + (size_t)l * DM * DM, DM, DM, nullptr, (bf16_t*)(ws + WS_WOUT) + (size_t)l * DM * DM, 0, scr, r % I_OUT, lane); continue; } r -= N_B;
            const int which = r / N_C, r2 = r % N_C, le = r2 / I_E, item = r2 % I_E, l = le / NEXP;
            if (which == 0) transpose_item(args.in[I_WG] + (size_t)le * DM * DEXP, DM, DEXP, args.in[I_FNORM] + l * DM, (bf16_t*)(ws + WS_WGU) + (size_t)le * 1024 * DM, 2, scr, item, lane);
            else if (which == 1) transpose_item(args.in[I_WU] + (size_t)le * DM * DEXP, DM, DEXP, args.in[I_FNORM] + l * DM, (bf16_t*)(ws + WS_WGU) + (size_t)le * 1024 * DM, 3, scr, item, lane);
            else transpose_item(args.in[I_WD] + (size_t)le * DEXP * DM, DEXP, DM, nullptr, (bf16_t*)(ws + WS_WD) + (size_t)le * DM * DEXP, 0, scr, item, lane);
        }
        for (int i = (vcu * NWAVES * 64 + tid); i < DEPTH * 48 * 1024; i += G * NWAVES * 64) {
            const int l = i / (48 * 1024), n = (i / 1024) % 48, k = i % 1024;
            float w = 0.f;
            if (n < 4) w = args.in[I_RGW][((size_t)l * DM + k) * 4 + n]; else if (n < 36) w = args.in[I_REW][((size_t)l * DM + k) * 32 + (n - 4)];
            w *= args.in[I_FNORM][l * DM + k];
            const unsigned hb_ = f2bf(w); const float wl = w - __builtin_bit_cast(float, hb_ << 16);
            ((bf16_t*)(ws + WS_WRH))[i] = (bf16_t)hb_; ((bf16_t*)(ws + WS_WRL))[i] = (bf16_t)f2bf(wl);
        }
        const float* x = args.in[I_X];
        for (int row = gw; row < NTOK; row += NGW) {
            const f32x4* xr = (const f32x4*)(x + (size_t)row * DM) + lane; float ss = 0.f; u32x2* o8 = (u32x2*)(hb + (size_t)row * DM) + lane;
#pragma unroll
            for (int j = 0; j < 4; ++j) { const f32x4 v = xr[64 * j]; ss += (v[0] * v[0] + v[1] * v[1]) + (v[2] * v[2] + v[3] * v[3]); u32x2 w; w.x = pk2(v[0], v[1]); w.y = pk2(v[2], v[3]); o8[64 * j] = w; }
            ss = wave_sum(ss);
            if (lane == 0) rrow[row] = __builtin_amdgcn_rsqf(ss * (1.0f / DM) + EPS);
        }
        if (rep_ == REPS(0) - 1) { if (BOTH(0)) GRID_BAR(); } else __syncthreads();
    }

    for (int l = 0; l < DEPTH; ++l) {
        const int pb = 1 + 7 * l;
        const float lam_init = __builtin_bit_cast(float, __builtin_amdgcn_readfirstlane(l == 0 ? 0x3e4ccccd : 0x3eb60549));
        const float one_m_lam = __builtin_bit_cast(float, __builtin_amdgcn_readfirstlane(l == 0 ? 0x3f4ccccd : 0x3f24fd5c));
        const unsigned* cntl = (const unsigned*)(ctl + CW_CNT) + l * 32 * 64;
        if (IN(pb + 0)) for (int rep_ = 0; rep_ < ((1 == 3 && l != 0) ? 1 : REPS(1)); ++rep_) {
            PHASE_LOCALS();
            pg8::DenseSched S; S.init(NTOK, QKVW, DM, (const bf16_t*)(ws + WS_WIN) + (size_t)l * QKVW * DM, G, bx);
            pg8::EpiWin E{proj, rrow, args.in[I_DQN] + l * 128, args.in[I_CQN] + l * 128};
            pg8::gemm_phase<pg8::EpiWin, pg8::DenseSched>(lds, hb, DM, S, E, wv0);
            if (rep_ == ((1 == 3 && l != 0) ? 1 : REPS(1)) - 1) { if (BOTH(pb + 0)) GRID_BAR(); } else __syncthreads();
        }
        if (IN(pb + 1)) for (int rep_ = 0; rep_ < ((2 == 3 && l != 0) ? 1 : REPS(2)); ++rep_) {
            PHASE_LOCALS();
            attn_tables(lds, args.in[I_T5], args.in[I_CRB] + l * 257 * 4, args.in[I_DLAM] + l * 256, args.in[I_DSUB] + l * 128, lam_init, wv0);
#if (DUP_MASK >> 11) & 1
            for (int P = vcu; P < 512; P += G) {
                const int bh = P >> 4, s = P & 15;
                attnB_unit<true>(lds, proj, merged, args.in[I_T5], args.in[I_DLAM] + l * 256, args.in[I_DSUB] + l * 128, lam_init, one_m_lam, bh >> 2, bh & 3, 31 - s, wv0);
                attnB_unit<true>(lds, proj, merged, args.in[I_T5], args.in[I_DLAM] + l * 256, args.in[I_DSUB] + l * 128, lam_init, one_m_lam, bh >> 2, bh & 3, s, wv0);
            }
#endif
            for (int rb_ = 0; rb_ < REPS(8); ++rb_)
            for (int P = vcu; P < 512; P += G) {
                const int bh = P >> 4, s = P & 15;
                attnB_unit<false>(lds, proj, merged, args.in[I_T5], args.in[I_DLAM] + l * 256, args.in[I_DSUB] + l * 128, lam_init, one_m_lam, bh >> 2, bh & 3, 31 - s, wv0);
                attnB_unit<false>(lds, proj, merged, args.in[I_T5], args.in[I_DLAM] + l * 256, args.in[I_DSUB] + l * 128, lam_init, one_m_lam, bh >> 2, bh & 3, s, wv0);
            }
            for (int rc_ = 0; rc_ < REPS(9); ++rc_)
            for (int U = vcu; U < 512; U += G) { const int bh = U >> 4; attnC_unit(lds, proj, merged, args.in[I_CRB] + l * 257 * 4, bh >> 2, bh & 3, U & 15, wv0); __syncthreads(); }
            for (int ra_ = 0; ra_ < REPS(10); ++ra_)
            for (int U = vcu; U < 512; U += G) { const int bh = U >> 4; attnA_unit(lds, proj, merged, bh >> 2, bh & 3, U & 15, wv0); }
            __syncthreads();
            if (rep_ == ((2 == 3 && l != 0) ? 1 : REPS(2)) - 1) { if (BOTH(pb + 1)) GRID_BAR(); } else __syncthreads();
        }
        if (IN(pb + 2)) for (int rep_ = 0; rep_ < ((3 == 3 && l != 0) ? 1 : REPS(3)); ++rep_) {
            PHASE_LOCALS();
            pg8::DenseSched S; S.init(NTOK, DM, DM, (const bf16_t*)(ws + WS_WOUT) + (size_t)l * DM * DM, G, bx);
            pg8::EpiWout E{hb};
            pg8::gemm_phase<pg8::EpiWout, pg8::DenseSched>(lds, merged, DM, S, E, wv0);
            if (rep_ == ((3 == 3 && l != 0) ? 1 : REPS(3)) - 1) { if (BOTH(pb + 2)) GRID_BAR(); } else __syncthreads();
        }
        if (IN(pb + 3)) {
            PHASE_LOCALS();
            LAS float* lg = (LAS float*)lds;
            LAS float* rrl = (LAS float*)(lds + 128 * 49 * 4);
            LAS int* hist = (LAS int*)(lds + 128 * 49 * 4 + 512);
            const bf16_t* wrh = (const bf16_t*)(ws + WS_WRH) + (size_t)l * 48 * 1024;
            const bf16_t* wrl = (const bf16_t*)(ws + WS_WRL) + (size_t)l * 48 * 1024;
            const float* rgb = args.in[I_RGB] + l * 4; const float* reb = args.in[I_REB] + l * 32;
            const int fr = lane & 15, fq = lane >> 4;
            for (int chunk = vcu; chunk < NTOK / 128; chunk += G) {
                if (tid < 32) hist[tid] = 0;
                const int row = chunk * 128 + wave * 16 + fr;
                const bf16_t* hp = hb + (size_t)row * DM + 8 * fq;
                f32x4 acc[3]; acc[0] = acc[1] = acc[2] = (f32x4){0.f, 0.f, 0.f, 0.f};
                float ss = 0.f;
#pragma unroll 4
                for (int k0 = 0; k0 < DM; k0 += 32) {
                    const u32x4 ah = *(const u32x4*)(hp + k0);
                    { const float x0 = bflo(ah.x), x1 = bfhi(ah.x), x2 = bflo(ah.y), x3 = bfhi(ah.y), x4 = bflo(ah.z), x5 = bfhi(ah.z), x6 = bflo(ah.w), x7 = bfhi(ah.w);
                      ss += (x0 * x0 + x1 * x1) + (x2 * x2 + x3 * x3) + (x4 * x4 + x5 * x5) + (x6 * x6 + x7 * x7); }
                    const bf16x8 aH = __builtin_bit_cast(bf16x8, ah);
#pragma unroll
                    for (int cbk = 0; cbk < 3; ++cbk) {
                        const bf16x8 bH = *(const bf16x8*)(wrh + (size_t)(cbk * 16 + fr) * DM + k0 + 8 * fq), bL = *(const bf16x8*)(wrl + (size_t)(cbk * 16 + fr) * DM + k0 + 8 * fq);
                        acc[cbk] = __builtin_amdgcn_mfma_f32_16x16x32_bf16(aH, bH, acc[cbk], 0, 0, 0);
                        acc[cbk] = __builtin_amdgcn_mfma_f32_16x16x32_bf16(aH, bL, acc[cbk], 0, 0, 0);
                    }
                }
                ss += swz_xor<16>(ss); ss = sum_x32(ss);
                if (fq == 0) rrl[wave * 16 + fr] = __builtin_amdgcn_rsqf(ss * (1.0f / DM) + EPS);
#pragma unroll
                for (int cbk = 0; cbk < 3; ++cbk)
#pragma unroll
                    for (int rg = 0; rg < 4; ++rg) lg[(wave * 16 + 4 * fq + rg) * 49 + cbk * 16 + fr] = acc[cbk][rg];
                __syncthreads();
                int e1 = 0, e2 = 0, lr1 = 0, lr2 = 0; float g1 = 0.f, g2 = 0.f, rr = 0.f;
                if (tid < 128) {
                    rr = rrl[tid];
                    const LAS float* lp = lg + tid * 49;
                    float gl[4]; int gs = 0; float gmax = -3.0e38f;
#pragma unroll
                    for (int i = 0; i < 4; ++i) { gl[i] = lp[i] * rr + rgb[i]; if (gl[i] > gmax) { gmax = gl[i]; gs = i; } }
                    float den = 0.f;
#pragma unroll
                    for (int i = 0; i < 4; ++i) den += __expf(gl[i] - gmax);
                    const float gwt = 1.0f / den;
                    float el[8]; int i1 = 0; float m1 = -3.0e38f;
#pragma unroll
                    for (int i = 0; i < 8; ++i) { el[i] = lp[4 + gs * 8 + i] * rr + reb[gs * 8 + i]; if (el[i] > m1) { m1 = el[i]; i1 = i; } }
                    int i2 = 0; float m2 = -3.0e38f;
#pragma unroll
                    for (int i = 0; i < 8; ++i) { if (i != i1 && el[i] > m2) { m2 = el[i]; i2 = i; } }
                    const float ex = __expf(m2 - m1), p1 = 1.0f / (1.0f + ex), p2 = ex * p1;
                    g1 = gwt * p1; g2 = gwt * p2; e1 = gs * 8 + i1; e2 = gs * 8 + i2;
                    lr1 = __hip_atomic_fetch_add(&hist[e1], 1, __ATOMIC_RELAXED, __HIP_MEMORY_SCOPE_WORKGROUP); lr2 = __hip_atomic_fetch_add(&hist[e2], 1, __ATOMIC_RELAXED, __HIP_MEMORY_SCOPE_WORKGROUP);
                }
                __syncthreads();
                if (tid < 32) { const int c_ = hist[tid]; hist[32 + tid] = c_ ? (int)__hip_atomic_fetch_add((unsigned*)cntl + 64 * tid, (unsigned)c_, __ATOMIC_RELAXED, __HIP_MEMORY_SCOPE_AGENT) : 0; }
                __syncthreads();
                if (tid < 128) {
                    const int tok = chunk * 128 + tid;
                    const int pos1 = hist[32 + e1] + lr1, pos2 = hist[32 + e2] + lr2;
                    tok_list[e1 * ECAP + pos1] = tok; gate_list[e1 * ECAP + pos1] = g1; rs_list[e1 * ECAP + pos1] = rr;
                    tok_list[e2 * ECAP + pos2] = tok; gate_list[e2 * ECAP + pos2] = g2; rs_list[e2 * ECAP + pos2] = rr;
                    slot_of[tok * 2] = ((unsigned)e1 << 16) | (unsigned)pos1; slot_of[tok * 2 + 1] = ((unsigned)e2 << 16) | (unsigned)pos2;
                }
                __syncthreads();
            }
            if (BOTH(pb + 3)) GRID_BAR();
        }
        if (IN(pb + 4) || IN(pb + 5) || IN(pb + 6)) {
            { const int t_ = tid_of(wv0);
              if (t_ < 32) MISC[704 + t_] = ld_agent(cntl + 64 * t_);
              __syncthreads();
              if (t_ == 0) { int s_ = 0;
                for (int e = 0; e < 32; ++e) { const int ce = (int)MISC[704 + e], nte = (ce + 255) >> 8; MISC[e] = (unsigned)s_;
                    for (int j = 0; j < nte; ++j) { MISC[64 + 2 * (s_ + j)] = ((unsigned)e << 24) | (unsigned)(j * 256); MISC[64 + 2 * (s_ + j) + 1] = (unsigned)ce; }
                    s_ += nte; }
                MISC[32] = (unsigned)s_; }
              __syncthreads(); }
        }
        if (IN(pb + 4)) for (int rep_ = 0; rep_ < ((5 == 3 && l != 0) ? 1 : REPS(5)); ++rep_) {
            PHASE_LOCALS();
            pg8::MoeSched<true> S{(const volatile LAS int*)MISC, cntl, tok_list, (const bf16_t*)(ws + WS_WGU) + (size_t)l * NEXP * 1024 * DM, DM, G, bx};
            pg8::EpiGU E{hid, rs_list};
            pg8::gemm_phase<pg8::EpiGU, pg8::MoeSched<true>>(lds, hb, DM, S, E, wv0);
            if (rep_ == ((5 == 3 && l != 0) ? 1 : REPS(5)) - 1) { if (BOTH(pb + 4)) GRID_BAR(); } else __syncthreads();
        }
        if (IN(pb + 5)) for (int rep_ = 0; rep_ < ((6 == 3 && l != 0) ? 1 : REPS(6)); ++rep_) {
            PHASE_LOCALS();
            pg8::MoeSched<false> S{(const volatile LAS int*)MISC, cntl, tok_list, (const bf16_t*)(ws + WS_WD) + (size_t)l * NEXP * DM * DEXP, DEXP, G, bx};
            pg8::EpiDown E{ybuf, gate_list};
            pg8::gemm_phase<pg8::EpiDown, pg8::MoeSched<false>>(lds, hid, DEXP, S, E, wv0);
            if (rep_ == ((6 == 3 && l != 0) ? 1 : REPS(6)) - 1) { if (BOTH(pb + 5)) GRID_BAR(); } else __syncthreads();
        }
        if (IN(pb + 6)) {
            PHASE_LOCALS();
            for (int row = gw; row < NTOK; row += NGW) {
                const unsigned s0 = ld_agent(slot_of + row * 2), s1 = ld_agent(slot_of + row * 2 + 1);
                const size_t y0 = (size_t)(MISC[s0 >> 16] * 256u + (s0 & 0xffffu)), y1 = (size_t)(MISC[s1 >> 16] * 256u + (s1 & 0xffffu));
                const u32x2* ya = (const u32x2*)(ybuf + y0 * DM) + lane; const u32x2* yb = (const u32x2*)(ybuf + y1 * DM) + lane;
                u32x2* o8 = (u32x2*)(hb + (size_t)row * DM) + lane;
                f32x4* of = (f32x4*)(out + (size_t)row * DM) + lane;
                float ss = 0.f;
#pragma unroll
                for (int j = 0; j < 4; ++j) { const u32x2 hv = o8[64 * j], a = ya[64 * j], b2 = yb[64 * j]; f32x4 v;
                    v[0] = bflo(hv.x) + (bflo(a.x) + bflo(b2.x)); v[1] = bfhi(hv.x) + (bfhi(a.x) + bfhi(b2.x)); v[2] = bflo(hv.y) + (bflo(a.y) + bflo(b2.y)); v[3] = bfhi(hv.y) + (bfhi(a.y) + bfhi(b2.y));
                    if (l == DEPTH - 1) of[64 * j] = v;
                    else { ss += (v[0] * v[0] + v[1] * v[1]) + (v[2] * v[2] + v[3] * v[3]); u32x2 w; w.x = pk2(v[0], v[1]); w.y = pk2(v[2], v[3]); o8[64 * j] = w; } }
                if (l != DEPTH - 1) { ss = wave_sum(ss); if (lane == 0) rrow[row] = __builtin_amdgcn_rsqf(ss * (1.0f / DM) + EPS); }
            }
            if (BOTH(pb + 6)) GRID_BAR();
        }
    }
#undef IN
#undef BOTH
}

extern "C" void kernel_launch(void* const* d_in, const int* in_sizes, int n_in, void* d_out, int out_size, void* d_ws, size_t ws_size, hipStream_t stream) {
    static int grid = 0;
    if (grid == 0) {
        if (n_in != 18 || out_size != NTOK * DM || ws_size < WS_END) { fprintf(stderr, "kernel_launch: unexpected shapes (n_in %d, out %d, ws %zu < %zu)\n", n_in, out_size, ws_size, (size_t)WS_END); grid = -1; return; }
        int dev = 0, cus = 0, per_cu = 0;
        if (hipGetDevice(&dev) != hipSuccess || hipDeviceGetAttribute(&cus, hipDeviceAttributeMultiprocessorCount, dev) != hipSuccess) { grid = -1; return; }
        if (hipFuncSetAttribute((const void*)fwd_kernel, hipFuncAttributeMaxDynamicSharedMemorySize, LDS_BYTES) != hipSuccess) { fprintf(stderr, "kernel_launch: hipFuncSetAttribute failed\n"); grid = -1; return; }
        if (hipOccupancyMaxActiveBlocksPerMultiprocessor(&per_cu, (const void*)fwd_kernel, NWAVES * 64, LDS_BYTES) != hipSuccess || per_cu < 1) fprintf(stderr, "kernel_launch: occupancy query says %d\n", per_cu);
        (void)hipGetLastError();
        grid = cus;
    }
    if (grid < 0) return;
    if (hipMemsetAsync((char*)d_ws + WS_CTL, 0, CTL_ZERO_BYTES, stream) != hipSuccess) return;
    Args a{};
    for (int i = 0; i < 18; ++i) a.in[i] = (const float*)d_in[i];
    a.out = (float*)d_out; a.ws = (unsigned char*)d_ws;
#if MK_N_LAUNCHES == 1
    a.ph_lo = 0; a.ph_hi = NPHASES;
    hipLaunchKernelGGL(fwd_kernel, dim3(grid), dim3(NWAVES * 64), LDS_BYTES, stream, a);
#else
    for (int p = 0; p < NPHASES; ++p) { a.ph_lo = p; a.ph_hi = p + 1; hipLaunchKernelGGL(fwd_kernel, dim3(grid), dim3(NWAVES * 64), LDS_BYTES, stream, a); }
#endif
}
```
